# Optimizing an MI355X kernel written in HIP

```python
import math
import jax, jax.numpy as jnp
from jax import lax
import numpy as np

D_MODEL = 1024
BATCH = 16
SEQ = 4096
DEPTH = 1

N_META = 16
ROPE_THETA = 10000.0
NORM_EPS = 1e-5
DIFF_HEADS = 4
DIFF_HEAD_DIM = 64
DIFF_WIDTH = DIFF_HEADS * 2 * DIFF_HEAD_DIM
Q_BLOCK = 128
RET_HEADS = 4
RET_KEY_DIM = 64
RET_VALUE_DIM = 2 * RET_KEY_DIM
RET_WIDTH = RET_HEADS * RET_VALUE_DIM
RET_CHUNK = 128
MIX_WIDTH = DIFF_WIDTH + RET_WIDTH
IN_PROJ_SIZES = (2 * DIFF_HEADS * DIFF_HEAD_DIM, 2 * DIFF_HEADS * DIFF_HEAD_DIM, DIFF_WIDTH,
                 RET_HEADS * RET_KEY_DIM, RET_HEADS * RET_KEY_DIM, RET_WIDTH, RET_WIDTH)
IN_PROJ_WIDTH = sum(IN_PROJ_SIZES)
N_EXPERTS = 32
TOP_K = 4
D_FF = D_MODEL
SWIGLU_ALPHA = 1.702
SWIGLU_LIMIT = 7.0
MOE_BLOCK = 512

kernel_name = "hymba_diffattn_retnet_gptoss_moe"


def rms_norm(x, g=None, eps=NORM_EPS):
    x32 = x.astype(jnp.float32)
    y = (x32 * lax.rsqrt(jnp.mean(x32 * x32, axis=-1, keepdims=True) + eps)).astype(x.dtype)
    return y if g is None else y * g


def rope(t, pos, inv_freq):
    ang = pos[:, None] * inv_freq[None, :]
    cos = jnp.cos(ang)[None, :, None, :].astype(t.dtype)
    sin = jnp.sin(ang)[None, :, None, :].astype(t.dtype)
    t1, t2 = jnp.split(t, 2, axis=-1)
    return jnp.concatenate([t1 * cos - t2 * sin, t2 * cos + t1 * sin], axis=-1)


def diff_attention(q, k, v, lam, subln_g, lambda_init):
    B_, L_ = q.shape[0], q.shape[1]
    q = jnp.swapaxes(q, 1, 2) * (DIFF_HEAD_DIM ** -0.5)
    k = jnp.swapaxes(k, 1, 2)
    v = jnp.swapaxes(v, 1, 2)
    bounds = [0, N_META] + list(range(N_META + Q_BLOCK, L_, Q_BLOCK)) + [L_]
    outs = []
    for s, e in zip(bounds[:-1], bounds[1:]):
        scores = jnp.einsum('bhqd,bhkd->bhqk', q[:, :, s:e], k[:, :, :e]).astype(jnp.float32)
        causal = jnp.arange(e)[None, :] <= jnp.arange(s, e)[:, None]
        probs = jax.nn.softmax(jnp.where(causal, scores, -jnp.inf), axis=-1)
        probs = probs.reshape(B_, DIFF_HEADS, 2, e - s, e)
        diff = (probs[:, :, 0] - lam * probs[:, :, 1]).astype(v.dtype)
        outs.append(jnp.einsum('bhqk,bhkd->bhqd', diff, v[:, :, :e]))
    o = jnp.concatenate(outs, axis=2)
    o = rms_norm(o, subln_g) * (1.0 - lambda_init)
    return jnp.swapaxes(o, 1, 2).reshape(B_, L_, DIFF_WIDTH)


def retention(q, k, v, gate):
    B_, L_ = q.shape[0], q.shape[1]
    pad = (-L_) % RET_CHUNK
    n_chunks = (L_ + pad) // RET_CHUNK
    k = k * (RET_KEY_DIM ** -0.5)

    def to_chunks(t):
        t = jnp.pad(t, ((0, 0), (pad, 0), (0, 0), (0, 0)))
        return t.reshape(B_, n_chunks, RET_CHUNK, RET_HEADS, t.shape[-1]).transpose(0, 3, 1, 2, 4)

    qc, kc, vc = to_chunks(q), to_chunks(k), to_chunks(v)
    log_gamma = jnp.log1p(-jnp.exp2(-5.0 - jnp.arange(RET_HEADS, dtype=jnp.float32)))
    pos = jnp.arange(RET_CHUNK, dtype=jnp.float32)
    rel = pos[:, None] - pos[None, :]
    decay_intra = jnp.where(rel >= 0, jnp.exp(log_gamma[:, None, None] * jnp.maximum(rel, 0.0)), 0.0)
    key_decay = jnp.exp(log_gamma[:, None] * (RET_CHUNK - 1 - pos)[None, :])
    query_decay = jnp.exp(log_gamma[:, None] * (pos + 1.0)[None, :])
    chunk_decay = jnp.exp(log_gamma * RET_CHUNK)
    decay_intra, key_decay, query_decay, chunk_decay = (
        t.astype(q.dtype) for t in (decay_intra, key_decay, query_decay, chunk_decay))

    scores = jnp.einsum('bhnid,bhnjd->bhnij', qc, kc) * decay_intra[:, None]
    y_intra = jnp.einsum('bhnij,bhnje->bhnie', scores, vc)
    kv = jnp.einsum('bhnjd,hj,bhnje->nbhde', kc, key_decay, vc)

    def step(state, kv_n):
        return chunk_decay[None, :, None, None] * state + kv_n, state

    _, s_prev = lax.scan(step, jnp.zeros(kv.shape[1:], kv.dtype), kv)
    y_cross = jnp.einsum('bhnid,hi,nbhde->bhnie', qc, query_decay, s_prev)
    y = (y_intra + y_cross).transpose(0, 2, 3, 1, 4).reshape(B_, L_ + pad, RET_HEADS, RET_VALUE_DIM)
    y = rms_norm(y[:, pad:]).reshape(B_, L_, RET_WIDTH)
    return y * jax.nn.silu(gate)


def clamped_swiglu(h):
    glu, lin = h[..., ::2], h[..., 1::2]
    glu = jnp.minimum(glu, SWIGLU_LIMIT)
    lin = jnp.clip(lin, -SWIGLU_LIMIT, SWIGLU_LIMIT)
    return glu * jax.nn.sigmoid(SWIGLU_ALPHA * glu) * (lin + 1.0)


def moe_ffn(h, w_router, b_router, w_up, b_up, w_down, b_down):
    B_, L_, D_ = h.shape
    T = B_ * L_
    xt = h.reshape(T, D_)
    logits = (xt @ w_router + b_router).astype(jnp.float32)
    top_val, top_idx = lax.top_k(logits, TOP_K)
    gates = jax.nn.softmax(top_val, axis=-1).astype(h.dtype)
    n_assign = T * TOP_K
    flat_e = top_idx.reshape(-1)
    flat_tok = jnp.arange(n_assign, dtype=jnp.int32) // TOP_K
    order = jnp.argsort(flat_e)
    sorted_e = flat_e[order]
    counts = jnp.bincount(flat_e, length=N_EXPERTS)
    padded = (counts + MOE_BLOCK - 1) // MOE_BLOCK * MOE_BLOCK
    pad_end = jnp.cumsum(padded)
    pad_start = pad_end - padded
    grp_start = jnp.cumsum(counts) - counts
    dest = pad_start[sorted_e] + (jnp.arange(n_assign) - grp_start[sorted_e])
    n_blocks = -(-(n_assign + N_EXPERTS * (MOE_BLOCK - 1)) // MOE_BLOCK)
    n_rows = n_blocks * MOE_BLOCK
    row_tok = jnp.zeros((n_rows,), jnp.int32).at[dest].set(flat_tok[order])
    row_gate = jnp.zeros((n_rows,), h.dtype).at[dest].set(gates.reshape(-1)[order])
    block_e = jnp.minimum(jnp.searchsorted(pad_end, jnp.arange(n_blocks) * MOE_BLOCK, side='right'),
                          N_EXPERTS - 1)

    def block_ffn(args):
        tok, g, e = args
        hb = clamped_swiglu(xt[tok] @ w_up[e] + b_up[e])
        return (hb @ w_down[e] + b_down[e]) * g[:, None]

    ys = lax.map(block_ffn, (row_tok.reshape(n_blocks, MOE_BLOCK),
                             row_gate.reshape(n_blocks, MOE_BLOCK), block_e))
    out = jax.ops.segment_sum(ys.reshape(n_rows, D_), row_tok, num_segments=T)
    return out.reshape(B_, L_, D_)


def setup_inputs(seed: int = 0) -> dict:
    key = jax.random.key(seed)
    ks = jax.random.split(key, 15)
    nrm = jax.random.normal
    return {
        "x": nrm(ks[0], (BATCH, SEQ, D_MODEL), jnp.float32),
        "meta_tokens": nrm(ks[1], (N_META, D_MODEL), jnp.float32),
        "attn_norm_g": 1.0 + 0.02 * nrm(ks[2], (DEPTH, D_MODEL), jnp.float32),
        "w_in": nrm(ks[3], (DEPTH, D_MODEL, IN_PROJ_WIDTH), jnp.float32) * D_MODEL ** -0.5,
        "diff_lambda": 0.1 * nrm(ks[4], (DEPTH, 4, DIFF_HEAD_DIM), jnp.float32),
        "diff_subln_g": 1.0 + 0.02 * nrm(ks[5], (DEPTH, 2 * DIFF_HEAD_DIM), jnp.float32),
        "w_out": nrm(ks[6], (DEPTH, MIX_WIDTH, D_MODEL), jnp.float32) * MIX_WIDTH ** -0.5,
        "ffn_norm_g": 1.0 + 0.02 * nrm(ks[7], (DEPTH, D_MODEL), jnp.float32),
        "w_router": nrm(ks[8], (DEPTH, D_MODEL, N_EXPERTS), jnp.float32) * D_MODEL ** -0.5,
        "b_router": 0.01 * nrm(ks[9], (DEPTH, N_EXPERTS), jnp.float32),
        "w_up": nrm(ks[10], (DEPTH, N_EXPERTS, D_MODEL, 2 * D_FF), jnp.float32) * D_MODEL ** -0.5,
        "b_up": 0.01 * nrm(ks[11], (DEPTH, N_EXPERTS, 2 * D_FF), jnp.float32),
        "w_down": nrm(ks[12], (DEPTH, N_EXPERTS, D_FF, D_MODEL), jnp.float32) * D_FF ** -0.5,
        "b_down": 0.01 * nrm(ks[13], (DEPTH, N_EXPERTS, D_MODEL), jnp.float32),
        "final_norm_g": 1.0 + 0.02 * nrm(ks[14], (D_MODEL,), jnp.float32),
    }


def reference(x, meta_tokens, attn_norm_g, w_in, diff_lambda, diff_subln_g, w_out, ffn_norm_g,
              w_router, b_router, w_up, b_up, w_down, b_down, final_norm_g):
    B_ = x.shape[0]
    h = jnp.concatenate([jnp.broadcast_to(meta_tokens[None].astype(x.dtype), (B_, N_META, D_MODEL)), x], axis=1)
    L_ = h.shape[1]
    pos = jnp.arange(L_, dtype=jnp.float32)
    diff_inv_freq = ROPE_THETA ** (-jnp.arange(0, DIFF_HEAD_DIM, 2, dtype=jnp.float32) / DIFF_HEAD_DIM)
    ret_inv_freq = ROPE_THETA ** (-jnp.linspace(0.0, 1.0, RET_KEY_DIM // 2, dtype=jnp.float32))
    split_at = np.cumsum(IN_PROJ_SIZES)[:-1].tolist()
    for l in range(DEPTH):
        hn = rms_norm(h, attn_norm_g[l])
        proj = hn @ w_in[l]
        dq, dk, dv, rq, rk, rv, rg = jnp.split(proj, split_at, axis=-1)
        dq = rope(dq.reshape(B_, L_, 2 * DIFF_HEADS, DIFF_HEAD_DIM), pos, diff_inv_freq)
        dk = rope(dk.reshape(B_, L_, 2 * DIFF_HEADS, DIFF_HEAD_DIM), pos, diff_inv_freq)
        dv = dv.reshape(B_, L_, DIFF_HEADS, 2 * DIFF_HEAD_DIM)
        lambda_init = 0.8 - 0.6 * math.exp(-0.3 * l)
        lp = diff_lambda[l].astype(jnp.float32)
        lam = jnp.exp(jnp.sum(lp[0] * lp[1])) - jnp.exp(jnp.sum(lp[2] * lp[3])) + lambda_init
        diff_out = diff_attention(dq, dk, dv, lam, diff_subln_g[l], lambda_init)
        rq = rope(rq.reshape(B_, L_, RET_HEADS, RET_KEY_DIM), pos, ret_inv_freq)
        rk = rope(rk.reshape(B_, L_, RET_HEADS, RET_KEY_DIM), pos, ret_inv_freq)
        rv = rv.reshape(B_, L_, RET_HEADS, RET_VALUE_DIM)
        ret_out = retention(rq, rk, rv, rg)
        h = h + jnp.concatenate([diff_out, ret_out], axis=-1) @ w_out[l]
        h = h + moe_ffn(rms_norm(h, ffn_norm_g[l]), w_router[l], b_router[l],
                        w_up[l], b_up[l], w_down[l], b_down[l])
    return rms_norm(h, final_norm_g)[:, N_META:]
```

```cpp
#include <hip/hip_runtime.h>
#include <cstdint>
#include <cstdio>

typedef unsigned short bf16;
constexpr int D = 1024, NB = 16, SEQ = 4096, NMETA = 16, LTOT = SEQ + NMETA, T = NB * SEQ;
constexpr int NPROJ = 3072;
constexpr int KROWS = 64 + SEQ;
constexpr int RROWS = 128 + SEQ;
constexpr int NE = 32, TOPK = 4;
constexpr int NASSIGN = T * TOPK;
constexpr int NROWS_MAX = NASSIGN + NE * 256;
constexpr int NTILES_MAX = NROWS_MAX / 256;
constexpr float EPS = 1e-5f;
constexpr float C2 = 0.125f * 1.4426950408889634f;
constexpr float LAMBDA_INIT = 0.2f;
constexpr float SLOT_SCALE = 16.f;
constexpr float WSCALE = 32.f, WDESCALE = 1.f / 32.f;

constexpr size_t MiB = 1u << 20;
constexpr size_t WS_CTL = 0;
constexpr size_t WS_ROPE_D = 1 * MiB;
constexpr size_t WS_ROPE_R = 2 * MiB + 64 * 1024;
constexpr size_t WS_TOPE = 3 * MiB + 128 * 1024;
constexpr size_t WS_TOPG = 4 * MiB + 128 * 1024;
constexpr size_t WS_RANK = 5 * MiB + 128 * 1024;
constexpr size_t WS_ROWTOK = 6 * MiB + 128 * 1024;
constexpr size_t WS_MISC = 7 * MiB + 512 * 1024;
constexpr size_t WS_WDN = 8 * MiB;
constexpr size_t WS_WUP = 72 * MiB;
constexpr size_t WS_WIN = 200 * MiB;
constexpr size_t WS_WOUT = 206 * MiB;
constexpr size_t WS_HN = 208 * MiB;
constexpr size_t WS_XN2 = 208 * MiB;
constexpr size_t WS_HB = 336 * MiB;
constexpr size_t WS_DQ = 336 * MiB;
constexpr size_t WS_DK = 400 * MiB;
constexpr size_t WS_DV = 466 * MiB;
constexpr size_t WS_RQ = 532 * MiB;
constexpr size_t WS_RK = 564 * MiB;
constexpr size_t WS_RV = 598 * MiB;
constexpr size_t WS_RG = 664 * MiB;
constexpr size_t WS_KVC = 728 * MiB;
constexpr size_t WS_ST = 796 * MiB;
constexpr size_t WS_MIX = 864 * MiB;
constexpr size_t WS_SLOT0 = 600 * MiB, WS_SLOT1 = 72 * MiB, WS_SLOT2 = 208 * MiB, WS_SLOT3 = 864 * MiB;
constexpr size_t WS_WRF = 7 * MiB + 640 * 1024;
constexpr size_t WS_RSTD = 7 * MiB + 768 * 1024;
constexpr size_t WS_ROWRSTD = 992 * MiB;
constexpr size_t WS_ROWGATE = 994 * MiB;
constexpr size_t WS_H1 = 728 * MiB;
constexpr int CAP = 65536;
constexpr size_t WS_ROWTOK_S = 1000 * MiB;
constexpr size_t WS_ROWRSTD_S = 1008 * MiB;
constexpr size_t WS_ROWGATE_S = 1016 * MiB;
constexpr size_t WS_END = 1024 * MiB;


__device__ __forceinline__ unsigned f2bf(float f) { unsigned u = __builtin_bit_cast(unsigned, f); return (u + 0x7fffu + ((u >> 16) & 1u)) >> 16; }
__device__ __forceinline__ unsigned pk2(float lo, float hi) { return f2bf(lo) | (f2bf(hi) << 16); }
__device__ __forceinline__ float bf2f(bf16 h) { return __builtin_bit_cast(float, (unsigned)h << 16); }
__device__ __forceinline__ float wave_sum(float v) {
#pragma unroll
    for (int o = 1; o < 64; o <<= 1) v += __shfl_xor(v, o);
    return v;
}
namespace pg8 {
#define PG8_LAS __attribute__((address_space(3)))
typedef unsigned short bf16_t;
typedef short bf16x8 __attribute__((ext_vector_type(8)));
typedef float f32x4 __attribute__((ext_vector_type(4)));
typedef unsigned u32x4 __attribute__((ext_vector_type(4)));
typedef unsigned u32x2 __attribute__((ext_vector_type(2)));
constexpr int EPI_TAB_OFF = 138 * 1024, EPI_TAB_BYTES = 3072;
constexpr int BM = 256, BK = 64, HALF = 128, HTB = HALF * BK * 2  , STAGE_BYTES = 8 * HTB, NXCD = 8, WGM = 8;

__host__ __device__ __forceinline__ int lds_byte(int r, int c) { const int st = (r >> 4) * 2 + (c >> 5), rr = r & 15, cc = c & 31, ob = rr * 64 + cc * 2; return st * 1024 + (ob ^ (((ob >> 9) & 1) << 5)); }
__host__ __device__ __forceinline__ void stage_rc(int b, int& R, int& C) { const int st = b / 1024, sb = b % 1024, swz = sb ^ (((sb >> 9) & 1) << 5); R = (st >> 1) * 16 + swz / 64; C = (st & 1) * 32 + (swz % 64) / 2; }
__host__ __device__ __forceinline__ int perm32(int rho) { const int n = rho >> 4, i = rho & 15; return 8 * (i >> 2) + 4 * n + (i & 3); }

struct Unit { int pm, pn, e, sb; };
struct Gemm { const bf16_t* A; const bf16_t* Bt; int M, N, K; size_t estride; };

struct StaticOrder {
    int nM, nN, nwg, G, c;
    __host__ __device__ __forceinline__ void init(int M, int N, int G_, int c_) { nM = M / BM; nN = N / BM; nwg = nM * nN; G = G_; c = c_; }
    __host__ __device__ __forceinline__ bool next(int i, Unit& u) const {
        const long L = (long)i * G + c; if (L >= nwg) return false;
        int wgid = (int)L; { const int q = nwg / NXCD, r = nwg % NXCD, xcd = wgid % NXCD, off = wgid / NXCD; wgid = (xcd < r ? xcd * (q + 1) : r * (q + 1) + (xcd - r) * q) + off; }
        const int nig = WGM * nN, gid = wgid / nig, fm = gid * WGM, gsz = (nM - fm) < WGM ? (nM - fm) : WGM;
        u.pm = fm + ((wgid % nig) % gsz); u.pn = (wgid % nig) / gsz; u.e = 0; u.sb = 0; return true;
    }
    __device__ __forceinline__ unsigned rowoff(const Unit&, int) const { return 0u; }
};

__device__ __forceinline__ unsigned cvt_pk_bf16(float lo, float hi) { unsigned r; asm volatile("v_cvt_pk_bf16_f32 %0, %1, %2" : "=v"(r) : "v"(lo), "v"(hi)); return r; }

typedef int v8i_t __attribute__((ext_vector_type(8)));
typedef int v4i_t __attribute__((ext_vector_type(4)));
template <class Epi, class Sched, bool ALIGN_EPI, bool GATHER, bool FP8 = false>
__device__ __forceinline__ void gemm_phase(PG8_LAS unsigned char* lds, const Gemm g, const Sched& S, const Epi& E) {
    const int tid = threadIdx.x, wid = __builtin_amdgcn_readfirstlane(tid >> 6), lane = tid & 63, wr = wid >> 2, wc = wid & 3, fr = lane & 15, fq = lane >> 4;
    const int K = g.K, nt = K / BK;
    unsigned voffA[2], voffB[2];
#pragma unroll
    for (int i = 0; i < 2; ++i) { int R, C; stage_rc(tid * 16 + i * 8192, R, C); const int Rb = Epi::PERM ? ((R & ~31) + perm32(R & 31)) : R;
        voffA[i] = (unsigned)(R * K + C) * 2u; voffB[i] = (unsigned)(Rb * K + C) * 2u; }
    const size_t kstep = (size_t)(BK * 2);
    const size_t hstep = (size_t)HALF * K * 2;
    const size_t tstep = 2 * hstep;
    const unsigned ldsw = (unsigned)wid * 1024u;
    const int aoff = lds_byte(wr * 64 + fr, fq * 8), boff = lds_byte(wc * 32 + fr, fq * 8);
#define PG8_SA(b, h) (((b) * 2 + (h)) * HTB)
#define PG8_SB(b, h) ((4 + (b) * 2 + (h)) * HTB)
#define PG8_STAGE(bufoff, gbase, voff) do { _Pragma("unroll") for (int _i = 0; _i < 2; ++_i) \
        __builtin_amdgcn_global_load_lds((const unsigned*)((const char*)(gbase) + (voff)[_i]), (PG8_LAS unsigned*)(lds + (bufoff) + ldsw + _i * 8192), 16, 0, 0); } while (0)
#define PG8_STAGE_A(bufoff, gbase, h, V) do { if constexpr (GATHER) { PG8_STAGE(bufoff, gbase, V[h]); } else { PG8_STAGE(bufoff, (gbase) + (h) * hstep, voffA); } } while (0)
#define PG8_LDA(dst, b, h) do { _Pragma("unroll") for (int m = 0; m < 4; ++m) _Pragma("unroll") for (int k = 0; k < 2; ++k) dst[m][k] = *(const PG8_LAS bf16x8*)(lds + PG8_SA(b, h) + aoff + m * 2048 + k * 1024); } while (0)
#define PG8_LDB(dst, b, h) do { _Pragma("unroll") for (int n = 0; n < 2; ++n) _Pragma("unroll") for (int k = 0; k < 2; ++k) dst[n][k] = *(const PG8_LAS bf16x8*)(lds + PG8_SB(b, h) + boff + n * 2048 + k * 1024); } while (0)
#define PG8_MMA(ai, bj, At, Bt) do { if constexpr (FP8) __builtin_amdgcn_sched_barrier(0); __builtin_amdgcn_s_setprio(1); _Pragma("unroll") for (int m = 0; m < 4; ++m) _Pragma("unroll") for (int n = 0; n < 2; ++n) { \
        if constexpr (FP8) { const v8i_t a8 = __builtin_shufflevector(__builtin_bit_cast(v4i_t, At[m][0]), __builtin_bit_cast(v4i_t, At[m][1]), 0, 1, 2, 3, 4, 5, 6, 7); \
            const v8i_t b8 = __builtin_shufflevector(__builtin_bit_cast(v4i_t, Bt[n][0]), __builtin_bit_cast(v4i_t, Bt[n][1]), 0, 1, 2, 3, 4, 5, 6, 7); \
            asm volatile("v_mfma_f32_16x16x128_f8f6f4 %0, %1, %2, %0" : "+v"(acc[ai][bj][m][n]) : "v"(b8), "v"(a8)); } \
        else { _Pragma("unroll") for (int k = 0; k < 2; ++k) acc[ai][bj][m][n] = __builtin_amdgcn_mfma_f32_16x16x32_bf16(Bt[n][k], At[m][k], acc[ai][bj][m][n], 0, 0, 0); } } \
        __builtin_amdgcn_s_setprio(0); if constexpr (FP8) __builtin_amdgcn_sched_barrier(0); } while (0)
#define PG8_WAIT_V(n) asm volatile("s_waitcnt vmcnt(" #n ")" ::: "memory")
#define PG8_WAIT_L(n) asm volatile("s_waitcnt lgkmcnt(" #n ")" ::: "memory")
#define PG8_BAR __builtin_amdgcn_s_barrier()
#define PG8_SCHED __builtin_amdgcn_sched_barrier(0)
#define PG8_ROWOFFS(V, u) do { _Pragma("unroll") for (int _i = 0; _i < 2; ++_i) { int _R, _C; stage_rc(tid * 16 + _i * 8192, _R, _C); _Pragma("unroll") for (int _h = 0; _h < 2; ++_h) V[_h][_i] = S.rowoff(u, _h * HALF + _R) + (unsigned)_C * 2u; } } while (0)
    Unit cur, nxt, nn; int ui = 0;
    if (!S.next(0, cur)) return;
    bool has_next = S.next(1, nxt);
    unsigned vc[2][2], vn[2][2], vnn[2][2];
    if constexpr (GATHER) { PG8_ROWOFFS(vc, cur); if (has_next) { PG8_ROWOFFS(vn, nxt); } else { PG8_ROWOFFS(vn, cur); } }
    f32x4 acc[2][2][4][2];
#pragma unroll
    for (int a = 0; a < 2; ++a)
#pragma unroll
        for (int b = 0; b < 2; ++b)
#pragma unroll
            for (int m = 0; m < 4; ++m)
#pragma unroll
                for (int n = 0; n < 2; ++n) acc[a][b][m][n] = (f32x4){0.f, 0.f, 0.f, 0.f};
    bf16x8 At[4][2], B0[2][2], B1[2][2];
    const char* cA = (const char*)g.A + (GATHER ? (size_t)0 : (size_t)cur.pm * tstep); const char* cB = (const char*)g.Bt + (size_t)cur.e * g.estride + (size_t)cur.pn * tstep;
    PG8_STAGE(PG8_SB(0, 0), cB, voffB); PG8_STAGE(PG8_SB(0, 1), cB + hstep, voffB); PG8_STAGE_A(PG8_SA(0, 0), cA, 0, vc); PG8_STAGE_A(PG8_SA(0, 1), cA, 1, vc);
    if (wr == 1) PG8_BAR;
    PG8_WAIT_V(2); PG8_BAR;
    PG8_STAGE(PG8_SB(1, 0), cB + kstep, voffB); PG8_STAGE_A(PG8_SA(1, 0), cA + kstep, 0, vc); PG8_STAGE(PG8_SB(1, 1), cB + hstep + kstep, voffB);
    PG8_WAIT_V(6); PG8_BAR;
    for (;;) {
        const char* nA = GATHER ? cA : (has_next ? (const char*)g.A + (size_t)nxt.pm * tstep : cA);
        const char* nB = has_next ? (const char*)g.Bt + (size_t)nxt.e * g.estride + (size_t)nxt.pn * tstep : cB;
#pragma unroll 1
        for (int t = 0; t < nt; t += 2) {
            const bool last = (t == nt - 2);
            if (t == 0) E.prefetch(cur, lds + EPI_TAB_OFF + (ui & 1) * EPI_TAB_BYTES, wid, lane);
            const char* a1 = cA + (size_t)(t + 1) * kstep;
            const char* a2 = last ? nA : cA + (size_t)(t + 2) * kstep; const char* b2 = last ? nB : cB + (size_t)(t + 2) * kstep;
            const char* a3 = a2 + kstep; const char* b3 = b2 + kstep;
            unsigned w2[2][2];
            if constexpr (GATHER) {
#pragma unroll
                for (int h = 0; h < 2; ++h)
#pragma unroll
                    for (int i = 0; i < 2; ++i) w2[h][i] = last ? vn[h][i] : vc[h][i];
            }
            PG8_LDB(B0, 0, 0); PG8_LDB(B1, 0, 1); PG8_SCHED; PG8_LDA(At, 0, 0); PG8_STAGE_A(PG8_SA(1, 1), a1, 1, vc);
            PG8_WAIT_V(8); PG8_WAIT_L(0); PG8_BAR; PG8_MMA(0, 0, At, B0); PG8_MMA(0, 1, At, B1); PG8_BAR; PG8_SCHED;
            PG8_LDA(At, 0, 1); PG8_STAGE(PG8_SB(0, 0), b2, voffB); PG8_STAGE(PG8_SB(0, 1), b2 + hstep, voffB); PG8_STAGE_A(PG8_SA(0, 0), a2, 0, w2);
            PG8_WAIT_V(8); PG8_WAIT_L(0); PG8_BAR; PG8_MMA(1, 0, At, B0); PG8_MMA(1, 1, At, B1); PG8_BAR; PG8_SCHED;
            PG8_LDB(B0, 1, 0); PG8_LDB(B1, 1, 1); PG8_SCHED; PG8_LDA(At, 1, 0); PG8_STAGE_A(PG8_SA(0, 1), a2, 1, w2);
            PG8_WAIT_V(8); PG8_WAIT_L(0); PG8_BAR; PG8_MMA(0, 0, At, B0); PG8_MMA(0, 1, At, B1); PG8_BAR; PG8_SCHED;
            PG8_LDA(At, 1, 1); PG8_STAGE(PG8_SB(1, 0), b3, voffB); PG8_STAGE(PG8_SB(1, 1), b3 + hstep, voffB); PG8_STAGE_A(PG8_SA(1, 0), a3, 0, w2);
            PG8_WAIT_V(8); PG8_WAIT_L(0); PG8_BAR; PG8_MMA(1, 0, At, B0); PG8_MMA(1, 1, At, B1); PG8_BAR; PG8_SCHED;
        }
        if constexpr (ALIGN_EPI) { if (wr == 0) PG8_BAR; }
        bool has_nn = false;
        if constexpr (GATHER) { has_nn = has_next && S.next(ui + 2, nn); if (has_nn) { PG8_ROWOFFS(vnn, nn); } else { PG8_ROWOFFS(vnn, cur); } }
        else { has_nn = has_next && S.next(ui + 2, nn); }
        if constexpr (FP8) asm volatile("s_nop 15\n\ts_nop 15" ::: "memory");
        E(acc, cur, wr, wc, fr, fq, lds + EPI_TAB_OFF + (ui & 1) * EPI_TAB_BYTES);
        if constexpr (GATHER) { asm volatile("" : "+v"(vnn[0][0]), "+v"(vnn[0][1]), "+v"(vnn[1][0]), "+v"(vnn[1][1])); }
        if (!has_next) break;
#pragma unroll
        for (int a = 0; a < 2; ++a)
#pragma unroll
            for (int b = 0; b < 2; ++b)
#pragma unroll
                for (int m = 0; m < 4; ++m)
#pragma unroll
                    for (int n = 0; n < 2; ++n) acc[a][b][m][n] = (f32x4){0.f, 0.f, 0.f, 0.f};
        cur = nxt; cA = nA; cB = nB; ++ui; nxt = nn; has_next = has_nn;
        if constexpr (GATHER) {
#pragma unroll
            for (int h = 0; h < 2; ++h)
#pragma unroll
                for (int i = 0; i < 2; ++i) { vc[h][i] = vn[h][i]; vn[h][i] = vnn[h][i]; }
        }
        if constexpr (ALIGN_EPI) { if (wr == 1) PG8_BAR; }
    }
    PG8_WAIT_V(0);
    if constexpr (!ALIGN_EPI) { if (wr == 0) PG8_BAR; }
    PG8_BAR;
#undef PG8_SA
#undef PG8_SB
#undef PG8_STAGE
#undef PG8_STAGE_A
#undef PG8_LDA
#undef PG8_LDB
#undef PG8_MMA
#undef PG8_WAIT_V
#undef PG8_WAIT_L
#undef PG8_BAR
#undef PG8_SCHED
#undef PG8_ROWOFFS
}
}
#define GAS __attribute__((address_space(1)))
#define LAS __attribute__((address_space(3)))
typedef unsigned v4u __attribute__((ext_vector_type(4)));
typedef unsigned v2u __attribute__((ext_vector_type(2)));
typedef float f32x4 __attribute__((ext_vector_type(4)));
typedef float f32x16 __attribute__((ext_vector_type(16)));
#define LDS_WAIT() asm volatile("s_waitcnt lgkmcnt(0)" ::: "memory")
#define VM_WAIT() asm volatile("s_waitcnt vmcnt(0)" ::: "memory")
constexpr int NWAVES = 8;
constexpr int RING_BYTES = 131072;
constexpr int LDSCTL_OFF = RING_BYTES, MISC_OFF = LDSCTL_OFF + 320;
constexpr int TILE_E_OFF = RING_BYTES + 1024;
constexpr int LDS_BYTES = 147456;
static_assert(TILE_E_OFF + (NTILES_MAX + 8) * 4 <= LDS_BYTES, "LDS map");
constexpr int CW_GCNT = 32768;
constexpr int TILE_S_OFF = TILE_E_OFF + (NTILES_MAX + 8) * 4;
static_assert(TILE_S_OFF + NTILES_MAX * 4 <= 138 * 1024, "LDS map");
constexpr int CW_BAR = 4096;

#define XB_TMO      128
#define XB_XCNT(j)  (256  + 64 * (j))
#define XB_XSUB(j)  (1280 + 64 * (j))
#define XB_XGEN(j)  (2304 + 64 * (j))
#define XB_TOP      3328
#define XB_TOPGEN   3392
#define XCD_BAR_WORDS 3456
#define XB_SPIN_CAP (1u << 18)
__device__ __forceinline__ unsigned xb_ld(unsigned* p)              { return __hip_atomic_load(p, __ATOMIC_RELAXED, __HIP_MEMORY_SCOPE_AGENT); }
__device__ __forceinline__ unsigned xb_add(unsigned* p, unsigned v) { return __hip_atomic_fetch_add(p, v, __ATOMIC_RELAXED, __HIP_MEMORY_SCOPE_AGENT); }
__device__ __forceinline__ unsigned xb_xcc_id() { return (unsigned)__builtin_amdgcn_s_getreg((3 << 11) | 20) & 0xFu; }
#define XB_SPIN(cond, bar) do { unsigned _sp = 0; while (cond) { __builtin_amdgcn_s_sleep(1); \
    if ((++_sp & 255u) == 0u) { if (xb_ld(&(bar)[XB_TMO])) break; if (_sp > XB_SPIN_CAP) { atomicAdd(&(bar)[XB_TMO], 1u); break; } } } } while (0)
struct XcdBarrier { unsigned* bar; unsigned x; volatile LAS unsigned* st; };
__device__ __forceinline__ XcdBarrier xcd_barrier_post(unsigned* bar, volatile LAS unsigned* st) {
    XcdBarrier b; b.bar = bar; b.x = xb_xcc_id(); b.st = st;
    if (threadIdx.x == 0) (void)xb_add(&bar[XB_XCNT(b.x)], 1u);
    return b;
}
__device__ __forceinline__ void xcd_barrier_complete(unsigned* bar, unsigned x, unsigned& nloc, unsigned& nx) {
    const unsigned G = gridDim.x * gridDim.y * gridDim.z;
    unsigned sum, cnt, mine, sp = 0u;
    for (;;) {
        sum = 0u; cnt = 0u; mine = 0u;
#pragma unroll
        for (unsigned j = 0; j < 16; ++j) { const unsigned c = xb_ld(&bar[XB_XCNT(j)]); sum += c; cnt += (c > 0u) ? 1u : 0u; mine = (j == x) ? c : mine; }
        if (sum == G) break;
        __builtin_amdgcn_s_sleep(1);
        if ((++sp & 255u) == 0u) { if (xb_ld(&bar[XB_TMO])) break; if (sp > XB_SPIN_CAP) { atomicAdd(&bar[XB_TMO], 1u); break; } }
    }
    nloc = mine > 0u ? mine : 1u; nx = cnt > 0u ? cnt : 1u;
}
__device__ __forceinline__ void xcd_barrier(const XcdBarrier& b) {
    asm volatile("s_waitcnt vmcnt(0)" ::: "memory");
    __syncthreads();
    if (threadIdx.x == 0) {
        unsigned* bar = b.bar;
        __builtin_amdgcn_s_waitcnt(0);
        unsigned nloc = b.st[0], nx = b.st[1];
        if (nloc == 0u) { xcd_barrier_complete(bar, b.x, nloc, nx); b.st[0] = nloc; b.st[1] = nx; }
        const unsigned old = xb_add(&bar[XB_XSUB(b.x)], 1u);
        const unsigned gen = old / nloc;
        if (old + 1u == (gen + 1u) * nloc) {
            __builtin_amdgcn_fence(__ATOMIC_RELEASE, "agent");
            asm volatile("s_waitcnt vmcnt(0)" ::: "memory");
            const unsigned og = xb_add(&bar[XB_TOP], 1u);
            const unsigned tg = og / nx;
            if (og + 1u == (tg + 1u) * nx) xb_add(&bar[XB_TOPGEN], 1u);
            else XB_SPIN(xb_ld(&bar[XB_TOPGEN]) == tg, bar);
            __builtin_amdgcn_fence(__ATOMIC_ACQUIRE, "agent");
            xb_add(&bar[XB_XGEN(b.x)], 1u);
            asm volatile("s_waitcnt vmcnt(0)" ::: "memory");
        } else {
            XB_SPIN(xb_ld(&bar[XB_XGEN(b.x)]) == gen, bar);
            __builtin_amdgcn_fence(__ATOMIC_ACQUIRE, "agent");
            asm volatile("s_waitcnt vmcnt(0)" ::: "memory");
        }
    }
    __syncthreads();
}

__device__ __forceinline__ void glds16_raw(const void* gsrc, unsigned lds_dst) { unsigned keep;
    asm volatile("s_mov_b32 %0, m0\n\ts_mov_b32 m0, %2\n\ts_nop 0\n\tglobal_load_lds_dwordx4 %1, off\n\ts_mov_b32 m0, %0" : "=&s"(keep) : "v"(gsrc), "s"(lds_dst) : "memory"); }
#define GLDS16R(gp, lp) glds16_raw((const void*)(gp), (unsigned)__builtin_amdgcn_readfirstlane((int)(unsigned)(size_t)(lp)))
struct Args { const float* in[15]; float* out; unsigned char* ws; int ph_lo, ph_hi, li, pad; };
struct Frame {
    LAS unsigned char* lds;
    int tid, lane, wave, vcu, G;
    const float *x, *meta, *attn_g, *w_in, *dlam, *subln, *w_out, *ffn_g, *w_router, *b_router, *w_up, *b_up, *w_down, *b_down, *final_g;
    float* out; unsigned char* ws;
};

template <class DestRow>
__device__ __forceinline__ void p0_transpose_item(const float* __restrict__ W, int K, int N, bf16* __restrict__ WT, LAS float* scr, int item, int lane, DestRow dest) {
    const int nblk = N / 32, kb = item / nblk, nb = item % nblk, k0 = 64 * kb, n0 = 32 * nb;
#pragma unroll 8
    for (int i = 0; i < 32; ++i) { const int kk = 2 * i + (lane >> 5); scr[kk * 33 + (lane & 31)] = __builtin_nontemporal_load(W + (size_t)(k0 + kk) * N + n0 + (lane & 31)); }
    LDS_WAIT(); asm volatile("" ::: "memory");
    const int c = lane & 7;
#pragma unroll
    for (int j = 0; j < 4; ++j) { const int n = (lane >> 3) + 8 * j; const LAS float* s = scr + (8 * c) * 33 + n;
        v4u o; o.x = pk2(s[0 * 33], s[1 * 33]); o.y = pk2(s[2 * 33], s[3 * 33]); o.z = pk2(s[4 * 33], s[5 * 33]); o.w = pk2(s[6 * 33], s[7 * 33]);
        *(v4u*)(WT + (size_t)dest(n0 + n) * K + k0 + 8 * c) = o; }
    LDS_WAIT(); asm volatile("" ::: "memory");
}

__device__ __forceinline__ unsigned pk_fp8x4(float a, float b, float c, float d) { int w = __builtin_amdgcn_cvt_pk_fp8_f32(a, b, 0, false); w = __builtin_amdgcn_cvt_pk_fp8_f32(c, d, w, true); return (unsigned)w; }
template <class DestRow>
__device__ __forceinline__ void p0_transpose_item_fp8(const float* __restrict__ W, int K, int N, unsigned char* __restrict__ WT, LAS float* scr, int item, int lane, DestRow dest, float scale) {
    const int nblk = N / 32, kb = item / nblk, nb = item % nblk, k0 = 64 * kb, n0 = 32 * nb;
#pragma unroll 8
    for (int i = 0; i < 32; ++i) { const int kk = 2 * i + (lane >> 5); scr[kk * 33 + (lane & 31)] = __builtin_nontemporal_load(W + (size_t)(k0 + kk) * N + n0 + (lane & 31)); }
    LDS_WAIT(); asm volatile("" ::: "memory");
    const int c = lane & 7;
#pragma unroll
    for (int j = 0; j < 4; ++j) { const int n = (lane >> 3) + 8 * j; const LAS float* s = scr + (8 * c) * 33 + n;
        v2u o; o.x = pk_fp8x4(s[0 * 33] * scale, s[1 * 33] * scale, s[2 * 33] * scale, s[3 * 33] * scale); o.y = pk_fp8x4(s[4 * 33] * scale, s[5 * 33] * scale, s[6 * 33] * scale, s[7 * 33] * scale);
        *(v2u*)(WT + (size_t)dest(n0 + n) * K + k0 + 8 * c) = o; }
    LDS_WAIT(); asm volatile("" ::: "memory");
}
struct DestId { __device__ __forceinline__ int operator()(int n) const { return n; } };
struct DestIn {
    __device__ __forceinline__ int operator()(int n) const { const int pn = n >> 8; const bool rope = (pn < 4) || pn == 6 || pn == 7; if (!rope) return n;
        const int w = n & 255, hh = w >> 6, bj = (w >> 5) & 1, dd = w & 31; return (pn << 8) + 128 * bj + 32 * hh + dd; }
};
struct DestUp {
    __device__ __forceinline__ int operator()(int c) const { return ((c >> 8) << 8) + 128 * (c & 1) + ((c >> 1) & 127); }
};

__device__ __forceinline__ float inv_freq_d(int i) { return exp2f(-(float)i / 32.0f * 13.287712379549449f); }
__device__ __forceinline__ float inv_freq_r(int i) { return exp2f(-(float)i / 31.0f * 13.287712379549449f); }

__device__ __forceinline__ void p0_meta(Frame& F, int j) {
    LAS float* hn = (LAS float*)F.lds;
    LAS float* part = (LAS float*)(F.lds + 65536);
    LAS float* fin = (LAS float*)(F.lds + 98304);
    for (int r = F.wave * 2; r < F.wave * 2 + 2; ++r) {
        const float* src = F.meta + (size_t)r * D;
        float4 v[4]; float ss = 0.f;
#pragma unroll
        for (int q = 0; q < 4; ++q) { v[q] = ((const float4*)src)[F.lane + 64 * q]; ss += v[q].x * v[q].x + v[q].y * v[q].y + v[q].z * v[q].z + v[q].w * v[q].w; }
        const float rs = rsqrtf(wave_sum(ss) * (1.f / D) + EPS);
#pragma unroll
        for (int q = 0; q < 4; ++q) { const float4 gg = ((const float4*)F.attn_g)[F.lane + 64 * q]; const int k = 4 * (F.lane + 64 * q);
            hn[r * D + k] = v[q].x * rs * gg.x; hn[r * D + k + 1] = v[q].y * rs * gg.y; hn[r * D + k + 2] = v[q].z * rs * gg.z; hn[r * D + k + 3] = v[q].w * rs * gg.w; }
    }
    __syncthreads();
    float acc[16];
#pragma unroll
    for (int r = 0; r < 16; ++r) acc[r] = 0.f;
    for (int k = 128 * F.wave; k < 128 * F.wave + 128; k += 4) {
        float wv[4];
#pragma unroll
        for (int q = 0; q < 4; ++q) wv[q] = F.w_in[(size_t)(k + q) * NPROJ + 64 * j + F.lane];
#pragma unroll
        for (int r = 0; r < 16; ++r) { const f32x4 h4 = *(const LAS f32x4*)(hn + r * D + k); acc[r] += h4[0] * wv[0] + h4[1] * wv[1] + h4[2] * wv[2] + h4[3] * wv[3]; }
    }
#pragma unroll
    for (int r = 0; r < 16; ++r) part[(F.wave * 16 + r) * 64 + F.lane] = acc[r];
    __syncthreads();
    for (int idx = F.tid; idx < 1024; idx += 512) { float s = 0.f;
#pragma unroll
        for (int w = 0; w < 8; ++w) s += part[w * 1024 + idx];
        fin[idx] = s; }
    __syncthreads();
    bf16* DK = (bf16*)(F.ws + WS_DK); bf16* DV = (bf16*)(F.ws + WS_DV); bf16* RK = (bf16*)(F.ws + WS_RK); bf16* RV = (bf16*)(F.ws + WS_RV);
    for (int idx = F.tid; idx < 1024; idx += 512) {
        const int r = idx >> 6, c = idx & 63; float val = fin[idx];
        const bool isdk = j >= 8 && j < 16, isrk = j >= 28 && j < 32;
        if (isdk || isrk) {
            const int i = c & 31; const float ang = (float)r * (isdk ? inv_freq_d(i) : inv_freq_r(i)); const float cs = cosf(ang), sn = sinf(ang);
            const float other = fin[idx ^ 32];
            val = c < 32 ? val * cs - other * sn : val * cs + other * sn;
            if (isrk) val *= 0.125f * exp2f(-(float)(112 + r) * log2f(1.f - exp2f(-5.f - (float)(j - 28))));
        }
        const bf16 o = (bf16)f2bf(val);
        for (int bb = 0; bb < NB; ++bb) {
            if (isdk) DK[((size_t)bb * KROWS + r) * 512 + 64 * (j - 8) + c] = o;
            else if (j >= 16 && j < 24) DV[((size_t)bb * KROWS + r) * 512 + 64 * (j - 16) + c] = o;
            else if (isrk) RK[((size_t)bb * RROWS + 112 + r) * 256 + 64 * (j - 28) + c] = o;
            else RV[((size_t)bb * RROWS + 112 + r) * 512 + 64 * (j - 32) + c] = o;
        }
    }
    __syncthreads();
}

__device__ __forceinline__ void p0_prologue(Frame& F) {
    if (F.vcu < 48) { const int j = F.vcu; const bool need = (j >= 8 && j < 24) || (j >= 28 && j < 40); if (need) p0_meta(F, j); }
    LAS float* scr = (LAS float*)(F.lds + F.wave * 16384);
    const int gw = F.vcu * NWAVES + F.wave, NGW = F.G * NWAVES;
    bf16* WinT = (bf16*)(F.ws + WS_WIN); bf16* WoutT = (bf16*)(F.ws + WS_WOUT); bf16* WupT = (bf16*)(F.ws + WS_WUP); bf16* WdnT = (bf16*)(F.ws + WS_WDN);
    constexpr int I_IN = (D / 64) * (NPROJ / 32), I_OUT = (D / 64) * (D / 32), I_UP = (D / 64) * (2048 / 32), I_DN = (D / 64) * (D / 32);
    constexpr int NITEMS = I_IN + I_OUT + NE * I_UP + NE * I_DN;
    for (int it = gw; it < NITEMS; it += NGW) {
        int r = it;
        if (r < I_IN) { p0_transpose_item(F.w_in, D, NPROJ, WinT, scr, r, F.lane, DestIn{}); continue; } r -= I_IN;
        if (r < I_OUT) { p0_transpose_item(F.w_out, D, D, WoutT, scr, r, F.lane, DestId{}); continue; } r -= I_OUT;
        if (r < NE * I_UP) { const int e = r / I_UP; p0_transpose_item_fp8(F.w_up + (size_t)e * D * 2048, D, 2048, (unsigned char*)WupT + (size_t)e * 2048 * D, scr, r % I_UP, F.lane, DestUp{}, WSCALE); continue; } r -= NE * I_UP;
        { const int e = r / I_DN; p0_transpose_item_fp8(F.w_down + (size_t)e * D * D, D, D, (unsigned char*)WdnT + (size_t)e * D * D, scr, r % I_DN, F.lane, DestId{}, WSCALE); }
    }
    bf16* HN = (bf16*)(F.ws + WS_HN);
#pragma unroll 2
    for (int m = gw; m < T; m += NGW) {
        const float* __restrict__ src = F.x + (size_t)m * D;
        float4 v[4]; float ss = 0.f;
#pragma unroll
        for (int q = 0; q < 4; ++q) { const f32x4 t4 = __builtin_nontemporal_load((const f32x4*)src + F.lane + 64 * q); v[q] = make_float4(t4[0], t4[1], t4[2], t4[3]); ss += v[q].x * v[q].x + v[q].y * v[q].y + v[q].z * v[q].z + v[q].w * v[q].w; }
        const float rs = rsqrtf(wave_sum(ss) * (1.f / D) + EPS);
#pragma unroll
        for (int q = 0; q < 4; ++q) { const float4 gg = ((const float4*)F.attn_g)[F.lane + 64 * q];
            uint2 o; o.x = pk2(v[q].x * rs * gg.x, v[q].y * rs * gg.y); o.y = pk2(v[q].z * rs * gg.z, v[q].w * rs * gg.w);
            ((uint2*)(HN + (size_t)m * D))[F.lane + 64 * q] = o; }
    }
    float2* tabD = (float2*)(F.ws + WS_ROPE_D); float2* tabR = (float2*)(F.ws + WS_ROPE_R);
    for (int idx = F.vcu * 512 + F.tid; idx < LTOT * 32; idx += F.G * 512) {
        const int pos = idx >> 5, i = idx & 31; const float aD = (float)pos * inv_freq_d(i), aR = (float)pos * inv_freq_r(i);
        tabD[idx] = make_float2(cosf(aD), sinf(aD)); tabR[idx] = make_float2(cosf(aR), sinf(aR));
    }
    { bf16* wrf = (bf16*)(F.ws + WS_WRF);
      for (int idx = F.vcu * 512 + F.tid; idx < 64 * 64; idx += F.G * 512) { const int s_ = idx >> 6, ln = idx & 63, n = ln & 31, hi = ln >> 5; unsigned h[4], l[4];
#pragma unroll
          for (int j = 0; j < 4; ++j) { const float w0 = F.w_router[(16 * s_ + 8 * hi + 2 * j) * NE + n], w1 = F.w_router[(16 * s_ + 8 * hi + 2 * j + 1) * NE + n];
              const unsigned h0 = f2bf(w0), h1 = f2bf(w1); h[j] = h0 | (h1 << 16); l[j] = f2bf(w0 - bf2f((bf16)h0)) | (f2bf(w1 - bf2f((bf16)h1)) << 16); }
          *(v4u*)(wrf + (size_t)idx * 8) = (v4u){h[0], h[1], h[2], h[3]}; *(v4u*)(wrf + (size_t)(4096 + idx) * 8) = (v4u){l[0], l[1], l[2], l[3]}; } }
    { v4u* rt = (v4u*)(F.ws + WS_ROWTOK_S); const v4u m1 = {0xffffffffu, 0xffffffffu, 0xffffffffu, 0xffffffffu};
      for (int idx = F.vcu * 512 + F.tid; idx < NE * CAP / 4; idx += F.G * 512) rt[idx] = m1; }
    { v4u* DK = (v4u*)(F.ws + WS_DK); v4u* DV = (v4u*)(F.ws + WS_DV); v4u* RK = (v4u*)(F.ws + WS_RK); v4u* RV = (v4u*)(F.ws + WS_RV); const v4u z = {0u, 0u, 0u, 0u};
      constexpr int nA = NB * 48 * 64, nB = NB * 112 * 32, nC = NB * 112 * 64;
      for (int idx = F.vcu * 512 + F.tid; idx < nC; idx += F.G * 512) {
          if (idx < nA) { const int b = idx / (48 * 64), r = idx % (48 * 64); DK[((size_t)b * KROWS + 16) * 64 + r] = z; DV[((size_t)b * KROWS + 16) * 64 + r] = z; }
          if (idx < nB) { const int b = idx / (112 * 32), r = idx % (112 * 32); RK[(size_t)b * RROWS * 32 + r] = z; }
          { const int b = idx / (112 * 64), r = idx % (112 * 64); RV[(size_t)b * RROWS * 64 + r] = z; }
      } }
}

struct EpiInProj {
    static constexpr bool PERM = true;
    bf16 *__restrict__ DQ, *__restrict__ DK, *__restrict__ DV, *__restrict__ RQ, *__restrict__ RK, *__restrict__ RV, *__restrict__ RG; const float2 *__restrict__ tabD;
    __device__ __forceinline__ void prefetch(const pg8::Unit&, LAS unsigned char*, int, int) const {}
    __device__ __forceinline__ void operator()(const pg8::f32x4 (&acc)[2][2][4][2], const pg8::Unit& u, int wr, int wc, int fr, int fq, const LAS unsigned char* tab) const {
        const int pn = u.pn;
        bf16* __restrict__ base; int ld, colb, rk, rope; float sc = 1.f;
        float dsgn = 0.f;
        if (pn < 2) { base = DQ; ld = 512; colb = 256 * pn; rk = 0; rope = 1; sc = C2; }
        else if (pn < 4) { base = DK; ld = 512; colb = 256 * (pn - 2); rk = 1; rope = 1; }
        else if (pn < 6) { base = DV; ld = 512; colb = 256 * (pn - 4); rk = 1; rope = 0; }
        else if (pn == 6) { base = RQ; ld = 256; colb = 0; rk = 0; rope = 2; dsgn = 1.f; }
        else if (pn == 7) { base = RK; ld = 256; colb = 0; rk = 2; rope = 2; sc = 0.125f; dsgn = -1.f; }
        else if (pn < 10) { base = RV; ld = 512; colb = 256 * (pn - 8); rk = 2; rope = 0; }
        else { base = RG; ld = 512; colb = 256 * (pn - 10); rk = 0; rope = 0; }
        const float l2g = dsgn * log2f(1.f - exp2f(-5.f - (float)wc));
        float fr8[8];
        { const LAS float* ft = (const LAS float*)tab + (rope == 2 ? 32 : 0) + 8 * fq; const pg8::f32x4 f0 = *(const LAS pg8::f32x4*)ft, f1 = *(const LAS pg8::f32x4*)(ft + 4);
#pragma unroll
          for (int p = 0; p < 4; ++p) { fr8[p] = f0[p]; fr8[4 + p] = f1[p]; } }
#pragma unroll
        for (int ai = 0; ai < 2; ++ai)
#pragma unroll
            for (int m = 0; m < 4; ++m) {
                const int tr = u.pm * 256 + ai * 128 + wr * 64 + m * 16 + fr; const int b = tr >> 12, t = tr & 4095;
                const size_t drow = rk == 0 ? (size_t)tr : rk == 1 ? ((size_t)b * KROWS + 64 + t) : ((size_t)b * RROWS + 128 + t);
                bf16* __restrict__ rowp = base + drow * ld + colb;
                if (rope) {
                    const float pos = (float)(t + NMETA);
                    pg8::f32x4 cs[4];
#pragma unroll
                    for (int p = 0; p < 8; ++p) { const float rev = __builtin_amdgcn_fractf(pos * fr8[p]); cs[p >> 1][2 * (p & 1)] = __builtin_amdgcn_cosf(rev); cs[p >> 1][2 * (p & 1) + 1] = __builtin_amdgcn_sinf(rev); }
                    pg8::u32x4 w1, w2;
                    const float scr_ = sc * __builtin_amdgcn_exp2f((float)(t & 127) * l2g);
#pragma unroll
                    for (int n = 0; n < 2; ++n) {
                        const pg8::f32x4 x1 = acc[ai][0][m][n], x2 = acc[ai][1][m][n]; float o1[4], o2[4];
#pragma unroll
                        for (int i = 0; i < 4; ++i) { const float c = cs[2 * n + (i >> 1)][2 * (i & 1)], s = cs[2 * n + (i >> 1)][2 * (i & 1) + 1];
                            o1[i] = (x1[i] * c - x2[i] * s) * scr_; o2[i] = (x2[i] * c + x1[i] * s) * scr_; }
                        w1[2 * n] = pg8::cvt_pk_bf16(o1[0], o1[1]); w1[2 * n + 1] = pg8::cvt_pk_bf16(o1[2], o1[3]);
                        w2[2 * n] = pg8::cvt_pk_bf16(o2[0], o2[1]); w2[2 * n + 1] = pg8::cvt_pk_bf16(o2[2], o2[3]);
                    }
                    *(pg8::u32x4*)(rowp + 64 * wc + 8 * fq) = w1; *(pg8::u32x4*)(rowp + 64 * wc + 32 + 8 * fq) = w2;
                } else {
#pragma unroll
                    for (int bj = 0; bj < 2; ++bj) { const pg8::f32x4 v0 = acc[ai][bj][m][0], v1 = acc[ai][bj][m][1]; pg8::u32x4 w;
                        w.x = pg8::cvt_pk_bf16(v0[0], v0[1]); w.y = pg8::cvt_pk_bf16(v0[2], v0[3]); w.z = pg8::cvt_pk_bf16(v1[0], v1[1]); w.w = pg8::cvt_pk_bf16(v1[2], v1[3]);
                        *(pg8::u32x4*)(rowp + 128 * bj + 32 * wc + 8 * fq) = w; }
                }
            }
    }
};


typedef short bf16x8_t __attribute__((ext_vector_type(8)));
typedef short s16x4_t __attribute__((ext_vector_type(4)));
typedef float f32x2_t __attribute__((ext_vector_type(2)));
typedef __bf16 bf16x2_t __attribute__((ext_vector_type(2)));
#define MFMA32(a, b, c) __builtin_amdgcn_mfma_f32_32x32x16_bf16((a), (b), (c), 0, 0, 0)
__device__ __forceinline__ int crow(int i, int hh) { return (i & 3) + 8 * (i >> 2) + 4 * hh; }
__device__ __forceinline__ unsigned cvtpk(float lo, float hi) { f32x2_t v = {lo, hi}; bf16x2_t b = __builtin_convertvector(v, bf16x2_t); return __builtin_bit_cast(unsigned, b); }
__device__ __forceinline__ s16x4_t vtr(const LAS unsigned char* p) { typedef short v4i16_t __attribute__((ext_vector_type(4))); return __builtin_bit_cast(s16x4_t, __builtin_amdgcn_ds_read_tr16_b64_v4i16((LAS v4i16_t*)p)); }
__device__ __forceinline__ bf16x8_t pack8(const f32x16& x, int s8) {
    v4u w; w.x = cvtpk(x[s8], x[s8 + 1]); w.y = cvtpk(x[s8 + 2], x[s8 + 3]); w.z = cvtpk(x[s8 + 4], x[s8 + 5]); w.w = cvtpk(x[s8 + 6], x[s8 + 7]); return __builtin_bit_cast(bf16x8_t, w);
}
__device__ __forceinline__ float vmax3(float a, float b, float c) { float r; asm("v_max3_f32 %0, %1, %2, %3" : "=v"(r) : "v"(a), "v"(b), "v"(c)); return r; }
__device__ __forceinline__ float vmax2(float a, float b) { float r; asm("v_max_f32 %0, %1, %2" : "=v"(r) : "v"(a), "v"(b)); return r; }
__device__ __forceinline__ float half_max(float v) { float a = v, b = v; asm("s_nop 1\n\tv_permlane32_swap_b32 %0, %1\n\ts_nop 1" : "+v"(a), "+v"(b)); return vmax2(a, b); }
__device__ __forceinline__ void swap32(unsigned& a, unsigned& b) { asm volatile("s_nop 1\n\tv_permlane32_swap_b32 %0, %1\n\ts_nop 1" : "+v"(a), "+v"(b)); }
__device__ __forceinline__ float half_swap(float v) { return __shfl_xor(v, 32); }
constexpr int AT_K = 0, AT_V = 3 * 8192, AT_ST = AT_V + 3 * 16384, AT_ST7 = RING_BYTES + 1024, AT_SCR = AT_ST7 + 8192;
static_assert(AT_ST + 7 * 8192 <= RING_BYTES && AT_SCR + 1024 <= 147456, "attention LDS map");
__device__ __forceinline__ LAS unsigned char* at_stage(LAS unsigned char* lds, int wave) { return lds + (wave < 7 ? AT_ST + wave * 8192 : AT_ST7); }
#define GLDS16(gp, lp) __builtin_amdgcn_global_load_lds((const unsigned*)(gp), (LAS unsigned*)(lp), 16, 0, 0)
__device__ __forceinline__ void glds16_asm(const void* gsrc, unsigned lds_dst) { unsigned keep;
    asm volatile("s_mov_b32 %0, m0\n\ts_mov_b32 m0, %2\n\ts_nop 0\n\tglobal_load_lds_dwordx4 %1, off\n\ts_mov_b32 m0, %0" : "=&s"(keep) : "v"(gsrc), "s"(lds_dst) : "memory"); }
__device__ __forceinline__ void glds16_sbase(const void* sbase, unsigned voff, const LAS unsigned char* lp) { unsigned keep;
    asm volatile("s_mov_b32 %0, m0\n\ts_mov_b32 m0, %3\n\ts_nop 0\n\tglobal_load_lds_dwordx4 %1, %2\n\ts_mov_b32 m0, %0" : "=&s"(keep) : "v"(voff), "s"(sbase), "s"((unsigned)(size_t)lp) : "memory"); }
#define GLDS16A(gp, lp) glds16_asm((const void*)(gp), (unsigned)__builtin_amdgcn_readfirstlane((int)(unsigned)(size_t)(lp)))

constexpr float AT_THR = 8.f;
constexpr int AT_SLOT = 8192;
#define SBAR() __builtin_amdgcn_sched_barrier(0)
#define PIN(x) asm volatile("" : "+v"(x))
#define WAIT_BAR(N) asm volatile("s_waitcnt vmcnt(" #N ") lgkmcnt(0)\n\ts_barrier" ::: "memory")
#define MX3(a, b, c) __builtin_elementwise_maximum(__builtin_elementwise_maximum((a), (b)), (c))
__device__ __forceinline__ float at_rowmax(const f32x16& p0, const f32x16& p1) {
    float a = MX3(p0[0], p0[1], p1[0]), b = MX3(p0[2], p0[3], p1[1]); a = MX3(a, p1[2], p1[3]);
#pragma unroll
    for (int r = 4; r < 16; r += 4) { a = MX3(a, p0[r], p0[r + 1]); b = MX3(b, p0[r + 2], p0[r + 3]); a = MX3(a, p1[r], p1[r + 1]); b = MX3(b, p1[r + 2], p1[r + 3]); }
    return half_max(__builtin_elementwise_maximum(a, b)); }
__device__ __forceinline__ void at_cmask(f32x16& p0, f32x16& p1, int jb, int qrel, int hi) {
    const int kb = 64 * jb + 4 * hi;
#pragma unroll
    for (int r = 0; r < 16; ++r) { const int kv = kb + (r & 3) + 8 * (r >> 2); if (kv > qrel) p0[r] = -INFINITY; if (kv + 32 > qrel) p1[r] = -INFINITY; } }
template <int MP, int VAR>
__device__ __forceinline__ void attn_pass(Frame& F, f32x16 (&o)[4], int b, int h, int qb, float lam) {
    int lane = F.lane; asm volatile("" : "+v"(lane));
    const int r = lane & 31, hh = lane >> 5, wave = F.wave;
    const bf16* DQ = (const bf16*)(F.ws + WS_DQ); const bf16* DK = (const bf16*)(F.ws + WS_DK); const bf16* DV = (const bf16*)(F.ws + WS_DV);
    const int tq = 32 * wave + r;
    const size_t trow = (size_t)b * SEQ + 256 * qb + tq;
    const int NT = 4 * qb + 5;
    const LAS unsigned char* kp0 = F.lds + AT_K + hh * 1024 + r * 16;
    const LAS unsigned char* vp0 = F.lds + AT_V + (4 * hh + ((lane & 15) >> 2)) * 64 + ((lane >> 4) & 1) * 32 + (lane & 3) * 8;
    const int kh = 2 * h + MP;
    bf16x8_t qr[4];
#pragma unroll
    for (int s_ = 0; s_ < 4; ++s_) qr[s_] = *(const bf16x8_t*)(DQ + trow * 512 + 64 * kh + 16 * s_ + 8 * hh);
    const int pc0 = 2 * wave, pc1 = 2 * wave + 1;
    const bf16* kbase = DK + (size_t)b * KROWS * 512 + 64 * kh + 8 * wave;
    const bf16* vbase0 = DV + ((size_t)b * KROWS + 16 * (pc0 & 3)) * 512 + 128 * h + 32 * (pc0 >> 2);
    const bf16* vbase1 = DV + ((size_t)b * KROWS + 16 * (pc1 & 3)) * 512 + 128 * h + 32 * (pc1 >> 2);
    const unsigned koff = (unsigned)lane * 1024u, voff = (unsigned)(lane >> 2) * 1024u + (unsigned)(lane & 3) * 16u;
    const int vd0 = (pc0 >> 2) * 4096 + (pc0 & 3) * 1024, vd1 = (pc1 >> 2) * 4096 + (pc1 & 3) * 1024;
#define DMA_K(t, sl) do { const int t_ = (t); const bool ex_ = t_ < NT; glds16_sbase(kbase + (size_t)(ex_ ? t_ : 0) * 64 * 512, koff, F.lds + (ex_ ? AT_K + (sl) + wave * 1024 : AT_SCR)); } while (0)
#define DMA_V0(t, sl) glds16_sbase(vbase0 + (size_t)(t) * 64 * 512, voff, F.lds + AT_V + 2 * (sl) + vd0)
#define DMA_V1(t, sl) glds16_sbase(vbase1 + (size_t)(t) * 64 * 512, voff, F.lds + AT_V + 2 * (sl) + vd1)
#define DMA_V(t, sl) do { DMA_V0(t, sl); DMA_V1(t, sl); } while (0)
    asm volatile("s_waitcnt lgkmcnt(0)\n\ts_barrier" ::: "memory");
    DMA_K(0, 0); DMA_V(0, 0); DMA_K(1, AT_SLOT); DMA_K(2, 2 * AT_SLOT);
    float mref = 0.f, l = 0.f, alpha = 1.f; bool resc = false;
    f32x16 negm;
#pragma unroll
    for (int i = 0; i < 16; ++i) negm[i] = 0.f;
    PIN(negm);
#pragma unroll
    for (int k = 0; k < 4; ++k)
#pragma unroll
        for (int i = 0; i < 16; ++i) o[k][i] = 0.f;
    f32x16 pA0, pA1, pB0, pB1; bf16x8_t kf[8]; s16x4_t vlo[16], vhi[16]; v4u pw0, pw1, pw2, pw3;
    int sl_prev = 0, sl_cur = 0, sl_next = AT_SLOT;
#define ROT() do { sl_prev = sl_cur; sl_cur = sl_next; sl_next = (sl_next == 2 * AT_SLOT) ? 0 : sl_next + AT_SLOT; } while (0)
#define KLOAD(i, base) kf[i] = *(const LAS bf16x8_t*)((base) + ((i) >> 1) * 2048 + ((i) & 1) * 512)
#define EX(v) __builtin_amdgcn_exp2f(v)
#define RESC() do { if (resc) { _Pragma("unroll") for (int k_ = 0; k_ < 4; ++k_) _Pragma("unroll") for (int i_ = 0; i_ < 16; ++i_) o[k_][i_] *= alpha; } } while (0)
    WAIT_BAR(0);
    _Pragma("unroll") for (int i = 0; i < 8; ++i) KLOAD(i, kp0);
    pA0 = MFMA32(kf[0], qr[0], negm); pA1 = MFMA32(kf[1], qr[0], negm); pA0 = MFMA32(kf[2], qr[1], pA0); pA1 = MFMA32(kf[3], qr[1], pA1);
    pA0 = MFMA32(kf[4], qr[2], pA0); pA1 = MFMA32(kf[5], qr[2], pA1); pA0 = MFMA32(kf[6], qr[3], pA0); pA1 = MFMA32(kf[7], qr[3], pA1);
#pragma unroll
    for (int i = 0; i < 16; ++i) { if (i >= 8) pA0[i] = -INFINITY; pA1[i] = -INFINITY; }
    { mref = at_rowmax(pA0, pA1);
#pragma unroll
      for (int i = 0; i < 16; ++i) { negm[i] = -mref; pA0[i] = EX(pA0[i] - mref); pA1[i] = EX(pA1[i] - mref); } }
    WAIT_BAR(0);
    DMA_K(3, 0); DMA_V(1, AT_SLOT); ROT();
    _Pragma("unroll") for (int i = 0; i < 8; ++i) KLOAD(i, kp0 + sl_cur);
    WAIT_BAR(3);
#define PKW(P, i) cvtpk(P[i], P[i + 1])
#define PAF(k) __builtin_bit_cast(bf16x8_t, pw##k)
#define VFR(j) __builtin_shufflevector(vlo[j], vhi[j], 0, 1, 2, 3, 4, 5, 6, 7)
#define VRD(j) do { vlo[j] = vtr(vp_ + (((j) & 3) * 4096 + ((j) >> 2) * 1024)); vhi[j] = vtr(vp_ + (((j) & 3) * 4096 + ((j) >> 2) * 1024 + 512)); } while (0)
#define KRD(G, i) do { if (G) { KLOAD(i, kp0 + sl_next); } } while (0)
#define GAPA(MF, a0, a1, a2, a3, W0, W1, PW) do { MF; sacc += a0; sacc += a1; sacc += a2; sacc += a3; W0; W1; PIN(PW); PIN(sacc); SBAR(); } while (0)
#define GAPB(MF, X, i) do { MF; X[i] = EX(X[i]); X[i + 1] = EX(X[i + 1]); PIN(X); SBAR(); } while (0)
#define GAPX(MF, R, X, i) do { MF; R = MX3(R, X[i], X[i + 1]); X[i] = EX(X[i]); X[i + 1] = EX(X[i + 1]); PIN(X); PIN(R); SBAR(); } while (0)
#define STEP(C0, C1, P0, P1, t, MASK, GK, GV, GL) do { SBAR(); \
    const LAS unsigned char* vp_ = vp0 + 2 * sl_prev; \
    float sacc = P0[0] + P0[1]; \
    if (GK) DMA_K((t) + 3, sl_cur);                                                                                      \
                    GAPA(C0 = MFMA32(kf[0], qr[0], negm), P0[2], P0[3], P0[4], P0[5],     pw0[0] = PKW(P0, 0),  pw0[1] = PKW(P0, 2),  pw0); \
    if (GV) DMA_V0((t) + 1, sl_next); \
                    GAPA(C1 = MFMA32(kf[1], qr[0], negm), P0[6], P0[7], P0[8], P0[9],     pw0[2] = PKW(P0, 4),  pw0[3] = PKW(P0, 6),  pw0); \
    if (GV) DMA_V1((t) + 1, sl_next); \
                    GAPA(C0 = MFMA32(kf[2], qr[1], C0),   P0[10], P0[11], P0[12], P0[13], pw1[0] = PKW(P0, 8),  pw1[1] = PKW(P0, 10), pw1); \
                    GAPA(C1 = MFMA32(kf[3], qr[1], C1),   P0[14], P0[15], P1[0], P1[1],   pw1[2] = PKW(P0, 12), pw1[3] = PKW(P0, 14), pw1); \
    VRD(0); SBAR(); GAPA(C0 = MFMA32(kf[4], qr[2], C0),   P1[2], P1[3], P1[4], P1[5],     pw2[0] = PKW(P1, 0),  pw2[1] = PKW(P1, 2),  pw2); \
    VRD(1); SBAR(); GAPA(C1 = MFMA32(kf[5], qr[2], C1),   P1[6], P1[7], P1[8], P1[9],     pw2[2] = PKW(P1, 4),  pw2[3] = PKW(P1, 6),  pw2); \
    VRD(2); SBAR(); GAPA(C0 = MFMA32(kf[6], qr[3], C0),   P1[10], P1[11], P1[12], P1[13], pw3[0] = PKW(P1, 8),  pw3[1] = PKW(P1, 10), pw3); \
    VRD(3); SBAR(); GAPA(C1 = MFMA32(kf[7], qr[3], C1),   P1[14], P1[15], 0.f, 0.f,       pw3[2] = PKW(P1, 12), pw3[3] = PKW(P1, 14), pw3); \
    l += sacc; \
    if (MASK) { int q_ = tq; asm volatile("" : "+v"(q_)); at_cmask(C0, C1, (t) - (NT - 4), q_, hh); }        \
      \
    float ra_ = C0[0], rb_ = C0[2]; \
    VRD(4);  KRD(GL, 0); SBAR();  GAPX(o[0] = MFMA32(VFR(0),  PAF(0), o[0]), ra_, C0, 0); \
    VRD(5);  SBAR();              GAPX(o[1] = MFMA32(VFR(1),  PAF(0), o[1]), rb_, C0, 2); \
    VRD(6);  KRD(GL, 1); SBAR();  GAPX(o[2] = MFMA32(VFR(2),  PAF(0), o[2]), ra_, C0, 4); \
    VRD(7);  SBAR();              GAPX(o[3] = MFMA32(VFR(3),  PAF(0), o[3]), rb_, C0, 6); \
    VRD(8);  KRD(GL, 2); SBAR();  GAPX(o[0] = MFMA32(VFR(4),  PAF(1), o[0]), ra_, C0, 8); \
    VRD(9);  SBAR();              GAPX(o[1] = MFMA32(VFR(5),  PAF(1), o[1]), rb_, C0, 10); \
    VRD(10); KRD(GL, 3); SBAR();  GAPX(o[2] = MFMA32(VFR(6),  PAF(1), o[2]), ra_, C0, 12); \
    VRD(11); SBAR();              GAPX(o[3] = MFMA32(VFR(7),  PAF(1), o[3]), rb_, C0, 14); \
    VRD(12); KRD(GL, 4); SBAR();  GAPX(o[0] = MFMA32(VFR(8),  PAF(2), o[0]), ra_, C1, 0); \
    VRD(13); SBAR();              GAPX(o[1] = MFMA32(VFR(9),  PAF(2), o[1]), rb_, C1, 2); \
    VRD(14); KRD(GL, 5); SBAR();  GAPX(o[2] = MFMA32(VFR(10), PAF(2), o[2]), ra_, C1, 4); \
    VRD(15); SBAR();              GAPX(o[3] = MFMA32(VFR(11), PAF(2), o[3]), rb_, C1, 6); \
             KRD(GL, 6); SBAR();  GAPX(o[0] = MFMA32(VFR(12), PAF(3), o[0]), ra_, C1, 8); \
                                  GAPX(o[1] = MFMA32(VFR(13), PAF(3), o[1]), rb_, C1, 10); \
             KRD(GL, 7); SBAR();  GAPX(o[2] = MFMA32(VFR(14), PAF(3), o[2]), ra_, C1, 12); \
                                  GAPX(o[3] = MFMA32(VFR(15), PAF(3), o[3]), rb_, C1, 14); \
    { const float rm = half_max(__builtin_elementwise_maximum(ra_, rb_));                                                 \
      if (__builtin_expect(__any(rm > AT_THR), 0)) { const float dl = fmaxf(rm, 0.f); mref += dl;                          \
          const float al_ = __builtin_amdgcn_exp2f(-dl), nm_ = -mref; l *= al_; \
          _Pragma("unroll") for (int i_ = 0; i_ < 16; ++i_) { float a_ = C0[i_], b_ = C1[i_], c_ = negm[i_];                \
              asm volatile("v_mul_f32 %0, %0, %3\n\tv_mul_f32 %1, %1, %3\n\tv_mov_b32 %2, %4" : "+v"(a_), "+v"(b_), "+v"(c_) : "v"(al_), "v"(nm_)); C0[i_] = a_; C1[i_] = b_; negm[i_] = c_; } \
          _Pragma("unroll") for (int k_ = 0; k_ < 4; ++k_) _Pragma("unroll") for (int i_ = 0; i_ < 16; ++i_) { float a_ = o[k_][i_]; asm volatile("v_mul_f32 %0, %0, %1" : "+v"(a_) : "v"(al_)); o[k_][i_] = a_; } } } \
    } while (0)
    int t = 1;
#pragma unroll 1
    do {
        STEP(pB0, pB1, pA0, pA1, t, (t >= NT - 4), true, true, true);         WAIT_BAR(3); ROT();
        STEP(pA0, pA1, pB0, pB1, t + 1, (t + 1 >= NT - 4), true, true, true); WAIT_BAR(3); ROT();
        t += 2;
    } while (t + 2 < NT);
    STEP(pB0, pB1, pA0, pA1, NT - 2, true, false, true, true); WAIT_BAR(0); ROT();
    STEP(pA0, pA1, pB0, pB1, NT - 1, true, false, false, false);
    { float sacc = pA0[0] + pA0[1];
#pragma unroll
      for (int i = 2; i < 16; ++i) sacc += pA0[i];
#pragma unroll
      for (int i = 0; i < 16; ++i) sacc += pA1[i];
      l += sacc;
      pw0 = (v4u){PKW(pA0, 0), PKW(pA0, 2), PKW(pA0, 4), PKW(pA0, 6)}; pw1 = (v4u){PKW(pA0, 8), PKW(pA0, 10), PKW(pA0, 12), PKW(pA0, 14)};
      pw2 = (v4u){PKW(pA1, 0), PKW(pA1, 2), PKW(pA1, 4), PKW(pA1, 6)}; pw3 = (v4u){PKW(pA1, 8), PKW(pA1, 10), PKW(pA1, 12), PKW(pA1, 14)};
      const LAS unsigned char* vp_ = vp0 + 2 * sl_cur;
#pragma unroll
      for (int ks = 0; ks < 4; ++ks)
#pragma unroll
          for (int k = 0; k < 4; ++k) { const s16x4_t lo = vtr(vp_ + k * 4096 + ks * 1024), hi = vtr(vp_ + k * 4096 + ks * 1024 + 512);
              const bf16x8_t vf = __builtin_shufflevector(lo, hi, 0, 1, 2, 3, 4, 5, 6, 7);
              o[k] = MFMA32(vf, ks == 0 ? PAF(0) : ks == 1 ? PAF(1) : ks == 2 ? PAF(2) : PAF(3), o[k]); } }
#undef DMA_K
#undef DMA_V
#undef DMA_V0
#undef DMA_V1
#undef ROT
#undef KLOAD
#undef EX
#undef RESC
#undef PKW
#undef PAF
#undef VFR
#undef VRD
#undef KRD
#undef GAPA
#undef GAPB
#undef GAPX
#undef STEP
    l += half_swap(l);
    const float linv = (MP == 1 ? lam : 1.f) / l;
    int lz_ = F.lane; asm volatile("" : "+v"(lz_));
    LAS v4u* st = (LAS v4u*)at_stage(F.lds, wave) + lz_;
#pragma unroll
    for (int q = 0; q < 8; ++q) { const int k = q >> 1, i0 = 8 * (q & 1);
        if constexpr (MP == 1) { v4u w; w.x = cvtpk(o[k][i0] * linv, o[k][i0 + 1] * linv); w.y = cvtpk(o[k][i0 + 2] * linv, o[k][i0 + 3] * linv);
            w.z = cvtpk(o[k][i0 + 4] * linv, o[k][i0 + 5] * linv); w.w = cvtpk(o[k][i0 + 6] * linv, o[k][i0 + 7] * linv); st[q * 64] = w; }
        else { const v4u w = st[q * 64];
#pragma unroll
            for (int j = 0; j < 4; ++j) { const unsigned u = w[j];
                o[k][i0 + 2 * j] = o[k][i0 + 2 * j] * linv - __builtin_bit_cast(float, u << 16); o[k][i0 + 2 * j + 1] = o[k][i0 + 2 * j + 1] * linv - __builtin_bit_cast(float, u & 0xffff0000u); } }
    }
}
template <int VAR>
__device__ __forceinline__ void attn_unit(Frame& F, int b, int h, int qb, float lam) {
    const int lane = F.lane, wave = F.wave;
    bf16* MIX = (bf16*)(F.ws + (VAR == 0 ? WS_MIX : WS_HN));
    f32x16 o[4];
    attn_pass<1, VAR>(F, o, b, h, qb, lam);
    attn_pass<0, VAR>(F, o, b, h, qb, lam);
    int lz = F.lane; asm volatile("" : "+v"(lz));
    const int r = lz & 31, hh = lz >> 5;
    float ss = 0.f;
#pragma unroll
    for (int k = 0; k < 4; ++k)
#pragma unroll
        for (int i = 0; i < 16; ++i) ss += o[k][i] * o[k][i];
    ss += half_swap(ss);
    const float rinv = rsqrtf(ss * (1.f / 128.f) + EPS) * (1.f - LAMBDA_INIT);
    LAS unsigned char* sg = at_stage(F.lds, wave);
    const float* __restrict__ gsub = F.subln + 4 * hh;
#pragma unroll
    for (int k = 0; k < 4; ++k)
#pragma unroll
        for (int g = 0; g < 4; ++g) { const f32x4 g4 = *(const f32x4*)(gsub + 32 * k + 8 * g); v2u w;
            w.x = cvtpk(o[k][4 * g] * rinv * g4[0], o[k][4 * g + 1] * rinv * g4[1]); w.y = cvtpk(o[k][4 * g + 2] * rinv * g4[2], o[k][4 * g + 3] * rinv * g4[3]);
            *(LAS v2u*)(sg + r * 256 + ((64 * k + 16 * g + 8 * hh) ^ ((r & 15) << 4))) = w; }
    bf16* __restrict__ obase = MIX + ((size_t)b * SEQ + 256 * qb + 32 * wave + (lz >> 4)) * 1024 + 128 * h + (lz & 15) * 8;
#pragma unroll
    for (int j = 0; j < 8; ++j) { const int row = 4 * j + (lz >> 4); const v4u x = *(const LAS v4u*)(sg + row * 256 + (((lz & 15) ^ (row & 15)) << 4)); *(v4u*)(obase + (size_t)(4 * j) * 1024) = x; }
}
template <int VAR>
__device__ __forceinline__ void p4_attention(Frame& F) {
    float lam;
    { float s01 = 0.f, s23 = 0.f; for (int i = 0; i < 64; ++i) { s01 += F.dlam[i] * F.dlam[64 + i]; s23 += F.dlam[128 + i] * F.dlam[192 + i]; } lam = __expf(s01) - __expf(s23) + LAMBDA_INIT; }
    for (int v = F.vcu; v < 256; v += F.G) {
        const int bh = v >> 2, j = v & 3;
#pragma unroll 1
        for (int u = 0; u < 4; ++u) { const int qb = u == 0 ? j : u == 1 ? 15 - j : u == 2 ? 7 - j : 8 + j; attn_unit<VAR>(F, bh >> 2, bh & 3, qb, lam); }
    }
}

__device__ __forceinline__ void p2_ret_kv(Frame& F) {
    const int lane = F.lane, r = lane & 31, hh = lane >> 5, wave = F.wave;
    const bf16* RK = (const bf16*)(F.ws + WS_RK); const bf16* RV = (const bf16*)(F.ws + WS_RV); float* KVC = (float*)(F.ws + WS_KVC);
    const int eblk = wave & 3, dblk = wave >> 2;
    const int trl = (8 * hh + ((lane & 15) >> 2)) * 64 + ((lane >> 4) & 1) * 32 + (lane & 3) * 8;
    int buf = 0; bool first = true;
    for (int u = F.vcu; u < 64 * 32; u += F.G) {
        const int bh = u >> 5, n = u & 31, b = bh >> 2, h = bh & 3;
        if (first) {
            const size_t row0 = (size_t)b * RROWS + 128 * n;
#pragma unroll
            for (int i = 0; i < 2; ++i) { const int p = 2 * wave + i; GLDS16R(RK + (row0 + 16 * (p & 7) + (lane >> 2)) * 256 + 64 * h + 32 * (p >> 3) + 8 * (lane & 3), F.lds + (p >> 3) * 8192 + (p & 7) * 1024); }
#pragma unroll
            for (int i = 0; i < 4; ++i) { const int p = 4 * wave + i; GLDS16R(RV + (row0 + 16 * (p & 7) + (lane >> 2)) * 512 + 128 * h + 32 * (p >> 3) + 8 * (lane & 3), F.lds + 16384 + (p >> 3) * 8192 + (p & 7) * 1024); }
            first = false;
        }
        asm volatile("s_waitcnt vmcnt(0) lgkmcnt(0)" ::: "memory"); __builtin_amdgcn_s_barrier(); asm volatile("" ::: "memory");
        const int un = u + F.G;
        if (un < 64 * 32) {
            const int bh2 = un >> 5, n2 = un & 31, b2 = bh2 >> 2, h2 = bh2 & 3; const size_t row0 = (size_t)b2 * RROWS + 128 * n2; LAS unsigned char* nb = F.lds + (buf ^ 1) * 49152;
#pragma unroll
            for (int i = 0; i < 2; ++i) { const int p = 2 * wave + i; GLDS16R(RK + (row0 + 16 * (p & 7) + (lane >> 2)) * 256 + 64 * h2 + 32 * (p >> 3) + 8 * (lane & 3), nb + (p >> 3) * 8192 + (p & 7) * 1024); }
#pragma unroll
            for (int i = 0; i < 4; ++i) { const int p = 4 * wave + i; GLDS16R(RV + (row0 + 16 * (p & 7) + (lane >> 2)) * 512 + 128 * h2 + 32 * (p >> 3) + 8 * (lane & 3), nb + 16384 + (p >> 3) * 8192 + (p & 7) * 1024); }
        }
        const LAS unsigned char* cb = F.lds + buf * 49152;
        const LAS unsigned char* ap = cb + 16384 + eblk * 8192 + trl; const LAS unsigned char* bp = cb + dblk * 8192 + trl;
        f32x16 acc;
#pragma unroll
        for (int i = 0; i < 16; ++i) acc[i] = 0.f;
#pragma unroll
        for (int s_ = 0; s_ < 8; ++s_) {
            const s16x4_t al = vtr(ap + s_ * 1024), ah = vtr(ap + s_ * 1024 + 256), bl = vtr(bp + s_ * 1024), bhh = vtr(bp + s_ * 1024 + 256);
            acc = MFMA32(__builtin_shufflevector(al, ah, 0, 1, 2, 3, 4, 5, 6, 7), __builtin_shufflevector(bl, bhh, 0, 1, 2, 3, 4, 5, 6, 7), acc);
        }
        float* dst = KVC + ((size_t)u * 128 + 32 * eblk + 4 * hh) * 64 + 32 * dblk + r;
#pragma unroll
        for (int i = 0; i < 16; ++i) dst[(size_t)((i & 3) + 8 * (i >> 2)) * 64] = acc[i];
        buf ^= 1;
    }
    asm volatile("s_waitcnt vmcnt(0) lgkmcnt(0)" ::: "memory"); __builtin_amdgcn_s_barrier(); asm volatile("" ::: "memory");
}
__device__ __forceinline__ void p3_ret_scan(Frame& F) {
    const float* KVC = (const float*)(F.ws + WS_KVC); bf16* ST = (bf16*)(F.ws + WS_ST);
    for (int gid = F.vcu * 512 + F.tid; gid < 64 * 2048; gid += F.G * 512) {
        const int bh = gid >> 11, i4 = gid & 2047, h = bh & 3;
        const float l2g = log2f(1.f - exp2f(-5.f - (float)h)); const float gam = exp2f(l2g), g127 = exp2f(127.f * l2g), g128 = exp2f(128.f * l2g);
        const f32x4* __restrict__ src = (const f32x4*)(KVC + (size_t)bh * 32 * 8192) + i4; v2u* __restrict__ dst = (v2u*)(ST + (size_t)bh * 32 * 8192) + i4;
        f32x4 st = {0.f, 0.f, 0.f, 0.f};
        f32x4 kvv[32];
#pragma unroll
        for (int n = 0; n < 32; ++n) kvv[n] = src[(size_t)n * 2048];
#pragma unroll
        for (int n = 0; n < 32; ++n) { const f32x4 kv = kvv[n]; st = st * g128 + kv * g127; const f32x4 o = st * gam;
            v2u w; w.x = cvtpk(o[0], o[1]); w.y = cvtpk(o[2], o[3]); dst[(size_t)n * 2048] = w; }
    }
}
__device__ __forceinline__ void p4_ret_out(Frame& F) {
    int lane = F.lane; asm volatile("" : "+v"(lane));
    const int r = lane & 31, hh = lane >> 5, wave = F.wave, qw = wave & 3, eh = wave >> 2;
    const bf16* RQ = (const bf16*)(F.ws + WS_RQ); const bf16* RK = (const bf16*)(F.ws + WS_RK); const bf16* RV = (const bf16*)(F.ws + WS_RV); const bf16* RG = (const bf16*)(F.ws + WS_RG);
    const bf16* ST = (const bf16*)(F.ws + WS_ST); bf16* MIX = (bf16*)(F.ws + WS_MIX);
    LAS float* ssx = (LAS float*)(F.lds + 98304);
    const int NU = 64 * 32;
#define RO_DMA(u_, buf_) do { const int bh_ = (u_) >> 5, c_ = ((u_) & 31) + 1, b_ = bh_ >> 2, h_ = bh_ & 3; const size_t row0_ = (size_t)b_ * RROWS + 128 * c_; LAS unsigned char* kim_ = F.lds + (buf_) * 49152; \
        _Pragma("unroll") for (int i_ = 0; i_ < 2; ++i_) { const int p_ = 2 * wave + i_; GLDS16R(RK + (row0_ + 64 * (p_ & 1) + lane) * 256 + 64 * h_ + 8 * (p_ >> 1), kim_ + (p_ >> 1) * 2048 + (p_ & 1) * 1024); } \
        _Pragma("unroll") for (int i_ = 0; i_ < 4; ++i_) { const int p_ = 4 * wave + i_; GLDS16R(RV + (row0_ + 16 * (p_ & 7) + (lane >> 2)) * 512 + 128 * h_ + 32 * (p_ >> 3) + 8 * (lane & 3), kim_ + 16384 + (p_ >> 3) * 8192 + (p_ & 7) * 1024); } } while (0)
#define RO_REGS(u_, QF, SB, GV) do { const int bh_ = (u_) >> 5, c_ = ((u_) & 31) + 1, b_ = bh_ >> 2, h_ = bh_ & 3; const size_t tok_ = (size_t)b_ * SEQ + 128 * (c_ - 1) + 32 * qw + r; \
        _Pragma("unroll") for (int s_ = 0; s_ < 4; ++s_) QF[s_] = *(const bf16x8_t*)(RQ + tok_ * 256 + 64 * h_ + 16 * s_ + 8 * hh); \
        const bf16* sp_ = ST + ((size_t)(bh_ * 32 + (c_ - 1)) * 128 + 64 * eh + r) * 64 + 8 * hh; \
        _Pragma("unroll") for (int k_ = 0; k_ < 2; ++k_) _Pragma("unroll") for (int s_ = 0; s_ < 4; ++s_) SB[k_][s_] = *(const bf16x8_t*)(sp_ + (size_t)k_ * 32 * 64 + 16 * s_); \
        const bf16* gp_ = RG + tok_ * 512 + 128 * h_ + 64 * eh + 8 * hh; \
        _Pragma("unroll") for (int k_ = 0; k_ < 2; ++k_) _Pragma("unroll") for (int g_ = 0; g_ < 2; ++g_) GV[k_][g_] = *(const v4u*)(gp_ + 32 * k_ + 16 * g_); } while (0)
    bf16x8_t qf[4], sb[2][4], nqf[4], nsb[2][4]; v4u gv[2][2], ngv[2][2];
    int u = F.vcu;
    if (u < NU) { RO_REGS(u, qf, sb, gv); RO_DMA(u, 0); }
    int buf = 0;
    for (; u < NU; u += F.G) {
        asm volatile("s_waitcnt vmcnt(0) lgkmcnt(0)" ::: "memory"); __builtin_amdgcn_s_barrier(); asm volatile("" ::: "memory");
        const int un = u + F.G;
        f32x16 y[2];
#pragma unroll
        for (int k = 0; k < 2; ++k)
#pragma unroll
            for (int i = 0; i < 16; ++i) y[k][i] = 0.f;
#pragma unroll
        for (int s_ = 0; s_ < 4; ++s_)
#pragma unroll
            for (int k = 0; k < 2; ++k) y[k] = MFMA32(sb[k][s_], qf[s_], y[k]);
        if (un < NU) { RO_REGS(un, nqf, nsb, ngv); RO_DMA(un, buf ^ 1); }
        const int bh = u >> 5, c = (u & 31) + 1, b = bh >> 2, h = bh & 3;
        const LAS unsigned char* kimg = F.lds + buf * 49152; const LAS unsigned char* vimg = kimg + 16384;
        const LAS unsigned char* kfb = kimg + hh * 2048 + r * 16;
        const LAS unsigned char* vfb = vimg + (2 * eh) * 8192 + (4 * hh + ((lane & 15) >> 2)) * 64 + ((lane >> 4) & 1) * 32 + (lane & 3) * 8;
#pragma unroll 1
        for (int kvb = 0; kvb <= qw; ++kvb) {
            f32x16 p;
#pragma unroll
            for (int i = 0; i < 16; ++i) p[i] = 0.f;
#pragma unroll
            for (int s_ = 0; s_ < 4; ++s_) { const bf16x8_t kf = *(const LAS bf16x8_t*)(kfb + s_ * 4096 + kvb * 512); p = MFMA32(kf, qf[s_], p); }
            if (kvb == qw) {
#pragma unroll
                for (int i = 0; i < 16; ++i) if (crow(i, hh) > r) p[i] = 0.f;
            }
            const bf16x8_t pa0 = pack8(p, 0), pa1 = pack8(p, 8);
#pragma unroll
            for (int k = 0; k < 2; ++k) {
                const LAS unsigned char* vp = vfb + k * 8192 + kvb * 2048;
                const s16x4_t l0 = vtr(vp), h0 = vtr(vp + 512), l1 = vtr(vp + 1024), h1 = vtr(vp + 1536);
                y[k] = MFMA32(__builtin_shufflevector(l0, h0, 0, 1, 2, 3, 4, 5, 6, 7), pa0, y[k]);
                y[k] = MFMA32(__builtin_shufflevector(l1, h1, 0, 1, 2, 3, 4, 5, 6, 7), pa1, y[k]);
            }
        }
        float ss = 0.f;
#pragma unroll
        for (int k = 0; k < 2; ++k)
#pragma unroll
            for (int i = 0; i < 16; ++i) ss += y[k][i] * y[k][i];
        ss += half_swap(ss);
        if (hh == 0) ssx[wave * 32 + r] = ss;
        asm volatile("s_waitcnt lgkmcnt(0)" ::: "memory"); __builtin_amdgcn_s_barrier(); asm volatile("" ::: "memory");
        const float rinv = rsqrtf((ss + ssx[(wave ^ 4) * 32 + r]) * (1.f / 128.f) + EPS);
        bf16* __restrict__ orow = MIX + ((size_t)b * SEQ + 128 * (c - 1) + 32 * qw + r) * 1024 + 512 + 128 * h + 64 * eh + 8 * hh;
#pragma unroll
        for (int k = 0; k < 2; ++k)
#pragma unroll
            for (int gp = 0; gp < 2; ++gp) {
                unsigned ga0 = gv[k][gp].x, ga1 = gv[k][gp].y, gb0 = gv[k][gp].z, gb1 = gv[k][gp].w;
                swap32(ga0, gb0); swap32(ga1, gb1);
                v2u wq[2];
#pragma unroll
                for (int gg = 0; gg < 2; ++gg) { const int g = 2 * gp + gg; float o4[4];
#pragma unroll
                    for (int j = 0; j < 4; ++j) { const unsigned gw_ = gg == 0 ? (j < 2 ? ga0 : ga1) : (j < 2 ? gb0 : gb1); const float gt = __builtin_bit_cast(float, (j & 1) ? (gw_ & 0xffff0000u) : (gw_ << 16));
                        const float sg = gt * __builtin_amdgcn_rcpf(1.f + __builtin_amdgcn_exp2f(-1.4426950408889634f * gt)); o4[j] = y[k][4 * g + j] * rinv * sg; }
                    wq[gg].x = cvtpk(o4[0], o4[1]); wq[gg].y = cvtpk(o4[2], o4[3]); }
                unsigned a0 = wq[0].x, a1 = wq[0].y, b0 = wq[1].x, b1 = wq[1].y;
                swap32(a0, b0); swap32(a1, b1);
                v4u w; w.x = a0; w.y = a1; w.z = b0; w.w = b1;
                *(v4u*)(orow + 32 * k + 16 * gp) = w; }
#pragma unroll
        for (int s_ = 0; s_ < 4; ++s_) { qf[s_] = nqf[s_]; sb[0][s_] = nsb[0][s_]; sb[1][s_] = nsb[1][s_]; }
#pragma unroll
        for (int k = 0; k < 2; ++k)
#pragma unroll
            for (int g = 0; g < 2; ++g) gv[k][g] = ngv[k][g];
        buf ^= 1;
    }
#undef RO_DMA
#undef RO_REGS
    asm volatile("s_waitcnt vmcnt(0) lgkmcnt(0)" ::: "memory"); __builtin_amdgcn_s_barrier(); asm volatile("" ::: "memory");
}

struct EpiOutProj {
    static constexpr bool PERM = true;
    const float* __restrict__ x; bf16* __restrict__ h1;
    __device__ __forceinline__ void prefetch(const pg8::Unit&, LAS unsigned char*, int, int) const {}
    __device__ __forceinline__ void operator()(const pg8::f32x4 (&acc)[2][2][4][2], const pg8::Unit& u, int wr, int wc, int fr, int fq, const LAS unsigned char* tab) const {
        const int row0 = u.pm * 256 + wr * 64 + fr, col0 = u.pn * 256 + wc * 32 + 8 * fq;
#pragma unroll
        for (int ai = 0; ai < 2; ++ai) {
            pg8::f32x4 xr[4][2][2];
#pragma unroll
            for (int m = 0; m < 4; ++m) { const size_t off = (size_t)(row0 + ai * 128 + m * 16) * D + col0;
#pragma unroll
                for (int bj = 0; bj < 2; ++bj)
#pragma unroll
                    for (int n = 0; n < 2; ++n) xr[m][bj][n] = *(const pg8::f32x4*)(x + off + bj * 128 + n * 4); }
#pragma unroll
            for (int m = 0; m < 4; ++m) { const size_t off = (size_t)(row0 + ai * 128 + m * 16) * D + col0;
#pragma unroll
                for (int bj = 0; bj < 2; ++bj) { const pg8::f32x4 v0 = xr[m][bj][0] + acc[ai][bj][m][0], v1 = xr[m][bj][1] + acc[ai][bj][m][1]; pg8::u32x4 w;
                    w.x = pg8::cvt_pk_bf16(v0[0], v0[1]); w.y = pg8::cvt_pk_bf16(v0[2], v0[3]); w.z = pg8::cvt_pk_bf16(v1[0], v1[1]); w.w = pg8::cvt_pk_bf16(v1[2], v1[3]);
                    *(pg8::u32x4*)(h1 + off + bj * 128) = w; } }
        }
    }
};

typedef float f32x16 __attribute__((ext_vector_type(16)));
typedef short s16x8 __attribute__((ext_vector_type(8)));
__device__ __forceinline__ void p6_router(Frame& F) {
    LAS int* hist = (LAS int*)(F.lds + RING_BYTES + 512);
    LAS unsigned char* xbw = F.lds + F.wave * 16384;
    LAS float* wl = (LAS float*)xbw;
    LAS float* rsb = wl + 32 * 36;
    const bf16* h1 = (const bf16*)(F.ws + WS_H1); bf16* XN2 = (bf16*)(F.ws + WS_XN2); const bf16* wrf = (const bf16*)(F.ws + WS_WRF);
    int* TOPE = (int*)(F.ws + WS_TOPE); float* TOPG = (float*)(F.ws + WS_TOPG); int* RANK = (int*)(F.ws + WS_RANK); float* RSTD = (float*)(F.ws + WS_RSTD);
    const int r = F.lane & 31, hi = F.lane >> 5;
    LAS float* gsh = (LAS float*)(F.lds + RING_BYTES + 1024);
    for (int i = F.tid; i < D; i += NWAVES * 64) gsh[i] = F.ffn_g[i];
    const LAS float* gl = gsh + 8 * hi;
    const int l4 = F.lane >> 4, l15 = F.lane & 15;
    for (int c = F.vcu; c < T / 256; c += F.G) {
        if (F.tid < NE) hist[F.tid] = 0;
        __syncthreads();
        const int row0 = c * 256 + F.wave * 32;
        const bf16* __restrict__ wrfp = wrf + (size_t)F.lane * 8;
        const bf16* xbase = h1 + (size_t)row0 * D;
        unsigned char* xo8 = (unsigned char*)XN2 + (size_t)row0 * D;
#define RT_DMA(cc, bufo) do { _Pragma("unroll") for (int i_ = 0; i_ < 8; ++i_) { const unsigned vo_ = (unsigned)l4 * (D * 2) + (unsigned)((l15 ^ ((4 * i_ + l4) & 15)) << 4); \
            glds16_sbase(xbase + (size_t)(4 * i_) * D + (cc) * 128, vo_, xbw + (bufo) + i_ * 1024); } } while (0)
        f32x16 acc;
#pragma unroll
        for (int i = 0; i < 16; ++i) acc[i] = 0.f;
        float ss = 0.f;
        const unsigned rdo = (unsigned)((r >> 2) * 1024 + ((r & 3) << 8)), rsw = (unsigned)(r & 15);
        v4u wa[8], wb[8];
#define RT_LOADW(W, s0) do { _Pragma("unroll") for (int q_ = 0; q_ < 4; ++q_) { \
            W[2 * q_] = *(const v4u*)(wrfp + (size_t)((s0) + q_) * 512); W[2 * q_ + 1] = *(const v4u*)(wrfp + (size_t)(4096 + ((s0) + q_) * 64) * 8); } } while (0)
#define RT_STEP(W, s0, xbuf) do { _Pragma("unroll") for (int q_ = 0; q_ < 4; ++q_) { const int sl_ = ((s0) + q_) & 7; \
            const v4u xw = *(const LAS v4u*)((xbuf) + rdo + (((unsigned)(2 * sl_ + hi) ^ rsw) << 4)); \
            const f32x4 x0 = {__builtin_bit_cast(float, xw.x << 16), __builtin_bit_cast(float, xw.x & 0xffff0000u), __builtin_bit_cast(float, xw.y << 16), __builtin_bit_cast(float, xw.y & 0xffff0000u)}; \
            const f32x4 x1 = {__builtin_bit_cast(float, xw.z << 16), __builtin_bit_cast(float, xw.z & 0xffff0000u), __builtin_bit_cast(float, xw.w << 16), __builtin_bit_cast(float, xw.w & 0xffff0000u)}; \
            ss += (x0[0] * x0[0] + x0[1] * x0[1]) + (x0[2] * x0[2] + x0[3] * x0[3]) + (x1[0] * x1[0] + x1[1] * x1[1]) + (x1[2] * x1[2] + x1[3] * x1[3]); \
            const f32x4 y0 = x0 * *(const LAS f32x4*)(gl + 16 * ((s0) + q_)), y1 = x1 * *(const LAS f32x4*)(gl + 16 * ((s0) + q_) + 4); v4u ah, al; \
            ah.x = pg8::cvt_pk_bf16(y0[0], y0[1]); ah.y = pg8::cvt_pk_bf16(y0[2], y0[3]); ah.z = pg8::cvt_pk_bf16(y1[0], y1[1]); ah.w = pg8::cvt_pk_bf16(y1[2], y1[3]); \
            al.x = pg8::cvt_pk_bf16(y0[0] - __builtin_bit_cast(float, ah.x << 16), y0[1] - __builtin_bit_cast(float, ah.x & 0xffff0000u)); \
            al.y = pg8::cvt_pk_bf16(y0[2] - __builtin_bit_cast(float, ah.y << 16), y0[3] - __builtin_bit_cast(float, ah.y & 0xffff0000u)); \
            al.z = pg8::cvt_pk_bf16(y1[0] - __builtin_bit_cast(float, ah.z << 16), y1[1] - __builtin_bit_cast(float, ah.z & 0xffff0000u)); \
            al.w = pg8::cvt_pk_bf16(y1[2] - __builtin_bit_cast(float, ah.w << 16), y1[3] - __builtin_bit_cast(float, ah.w & 0xffff0000u)); \
            const s16x8 Ah = __builtin_bit_cast(s16x8, ah), Al = __builtin_bit_cast(s16x8, al), Bh = __builtin_bit_cast(s16x8, W[2 * q_]), Bl = __builtin_bit_cast(s16x8, W[2 * q_ + 1]); \
            acc = __builtin_amdgcn_mfma_f32_32x32x16_bf16(Ah, Bh, acc, 0, 0, 0); acc = __builtin_amdgcn_mfma_f32_32x32x16_bf16(Al, Bh, acc, 0, 0, 0); acc = __builtin_amdgcn_mfma_f32_32x32x16_bf16(Ah, Bl, acc, 0, 0, 0); } } while (0)
#define RT_FP8(cc, xbuf) do { _Pragma("unroll") for (int i_ = 0; i_ < 8; ++i_) { const int row_ = 4 * i_ + l4, p_ = l15 ^ (row_ & 15); \
            const v4u xw = *(const LAS v4u*)((xbuf) + i_ * 1024 + F.lane * 16); const LAS float* g_ = gsh + (cc) * 128 + p_ * 8; const f32x4 g0 = *(const LAS f32x4*)g_, g1 = *(const LAS f32x4*)(g_ + 4); \
            v2u x8; x8.x = pk_fp8x4(__builtin_bit_cast(float, xw.x << 16) * g0[0], __builtin_bit_cast(float, xw.x & 0xffff0000u) * g0[1], __builtin_bit_cast(float, xw.y << 16) * g0[2], __builtin_bit_cast(float, xw.y & 0xffff0000u) * g0[3]); \
            x8.y = pk_fp8x4(__builtin_bit_cast(float, xw.z << 16) * g1[0], __builtin_bit_cast(float, xw.z & 0xffff0000u) * g1[1], __builtin_bit_cast(float, xw.w << 16) * g1[2], __builtin_bit_cast(float, xw.w & 0xffff0000u) * g1[3]); \
            *(v2u*)(xo8 + (size_t)row_ * D + (cc) * 128 + p_ * 8) = x8; } } while (0)
        asm volatile("s_waitcnt lgkmcnt(0)" ::: "memory");
        RT_DMA(0, 0);
        RT_LOADW(wa, 0);
#pragma unroll 1
        for (int cc = 0; cc < 8; ++cc) {
            const unsigned bo = (unsigned)(cc & 1) * 8192u;
            if (cc + 1 < 8) { RT_DMA(cc + 1, 8192u - bo); asm volatile("s_waitcnt vmcnt(8)" ::: "memory"); }
            else asm volatile("s_waitcnt vmcnt(0)" ::: "memory");
            const LAS unsigned char* xbuf = xbw + bo;
            RT_FP8(cc, xbuf);
            RT_LOADW(wb, 8 * cc + 4);
            RT_STEP(wa, 8 * cc, xbuf);
            if (cc + 1 < 8) { RT_LOADW(wa, 8 * cc + 8); }
            RT_STEP(wb, 8 * cc + 4, xbuf);
            asm volatile("s_waitcnt lgkmcnt(0)" ::: "memory");
        }
#undef RT_DMA
#undef RT_LOADW
#undef RT_STEP
#undef RT_FP8
        ss += __shfl_xor(ss, 32);
        const float rstd = rsqrtf(ss * (1.f / D) + EPS);
        if (hi == 0) { rsb[r] = rstd; RSTD[row0 + r] = rstd; }
        LDS_WAIT(); asm volatile("" ::: "memory");
        const float bias = F.b_router[r];
#pragma unroll
        for (int i = 0; i < 16; ++i) { const int row = (i & 3) + 8 * (i >> 2) + 4 * hi; wl[row * 36 + r] = acc[i] * rsb[row] + bias; }
        LDS_WAIT(); asm volatile("" ::: "memory");
        if (hi == 0) {
            float v0 = -INFINITY, v1 = -INFINITY, v2 = -INFINITY, v3 = -INFINITY; int i0 = 0, i1 = 0, i2 = 0, i3 = 0;
#pragma unroll
            for (int q = 0; q < 8; ++q) { const f32x4 lv = *(const LAS f32x4*)(wl + r * 36 + 4 * q);
#pragma unroll
                for (int jj = 0; jj < 4; ++jj) { const float xv = lv[jj]; const int e = 4 * q + jj;
                    if (xv > v3) {
                        if (xv > v0) { v3 = v2; i3 = i2; v2 = v1; i2 = i1; v1 = v0; i1 = i0; v0 = xv; i0 = e; }
                        else if (xv > v1) { v3 = v2; i3 = i2; v2 = v1; i2 = i1; v1 = xv; i1 = e; }
                        else if (xv > v2) { v3 = v2; i3 = i2; v2 = xv; i2 = e; }
                        else { v3 = xv; i3 = e; }
                    } } }
            const float e1 = __expf(v1 - v0), e2 = __expf(v2 - v0), e3 = __expf(v3 - v0); const float inv = 1.f / (1.f + e1 + e2 + e3);
            const int tok = row0 + r;
            *(int4*)(TOPE + tok * 4) = make_int4(i0, i1, i2, i3);
            *(float4*)(TOPG + tok * 4) = make_float4(inv, e1 * inv, e2 * inv, e3 * inv);
            const int r0 = __hip_atomic_fetch_add(&hist[i0], 1, __ATOMIC_RELAXED, __HIP_MEMORY_SCOPE_WORKGROUP), r1 = __hip_atomic_fetch_add(&hist[i1], 1, __ATOMIC_RELAXED, __HIP_MEMORY_SCOPE_WORKGROUP),
                      r2 = __hip_atomic_fetch_add(&hist[i2], 1, __ATOMIC_RELAXED, __HIP_MEMORY_SCOPE_WORKGROUP), r3 = __hip_atomic_fetch_add(&hist[i3], 1, __ATOMIC_RELAXED, __HIP_MEMORY_SCOPE_WORKGROUP);
            *(int4*)(RANK + tok * 4) = make_int4(r0, r1, r2, r3);
        }
        __syncthreads();
        if (F.tid < NE) hist[NE + F.tid] = (int)__hip_atomic_fetch_add((unsigned*)(F.ws + WS_CTL) + CW_GCNT + 64 * F.tid, (unsigned)hist[F.tid], __ATOMIC_RELAXED, __HIP_MEMORY_SCOPE_AGENT);
        __syncthreads();
        { int* RT = (int*)(F.ws + WS_ROWTOK_S); float* RR = (float*)(F.ws + WS_ROWRSTD_S); float* RGt = (float*)(F.ws + WS_ROWGATE_S);
          const int tok = c * 256 + (F.tid >> 1); const float rs = RSTD[tok];
#pragma unroll
          for (int kk = 0; kk < 2; ++kk) { const int k = (F.tid & 1) * 2 + kk; const int e = TOPE[tok * 4 + k]; const int dst = e * CAP + hist[NE + e] + RANK[tok * 4 + k];
              RT[dst] = tok * 4 + k; RR[dst] = rs; RGt[dst] = TOPG[tok * 4 + k]; } }
        __syncthreads();
    }
}

struct MoeOrder {
    const LAS int* te; const int* rowtok; int npn, G, c, Kb;
    __device__ __forceinline__ bool next(int i, pg8::Unit& u) const {
        const int L = i * G + c; const int nt = __builtin_amdgcn_readfirstlane(te[NTILES_MAX]);
        if (L >= nt * npn) return false;
        u.pm = L / npn; u.pn = L - u.pm * npn; u.e = __builtin_amdgcn_readfirstlane(te[u.pm]); u.sb = __builtin_amdgcn_readfirstlane(te[NTILES_MAX + 8 + u.pm]); return true;
    }
    __device__ __forceinline__ unsigned rowoff(const pg8::Unit& u, int r) const { const int v = rowtok[u.sb + r]; return (unsigned)(v < 0 ? 0 : (v >> 2)) * (unsigned)Kb; }
};
__device__ __forceinline__ void moe_tile_table(Frame& F) {
    LAS int* te = (LAS int*)(F.lds + TILE_E_OFF); LAS int* ts = te + NTILES_MAX + 8; LAS int* tb = (LAS int*)F.lds;
    const unsigned* gc = (const unsigned*)(F.ws + WS_CTL) + CW_GCNT;
    __syncthreads();
    if (F.tid == 0) { int p = 0; for (int e = 0; e < NE; ++e) { tb[e] = p; p += ((int)gc[64 * e] + 255) >> 8; } tb[NE] = p; te[NTILES_MAX] = p; }
    __syncthreads();
    for (int i = F.tid; i < NTILES_MAX; i += NWAVES * 64) { int e = 0;
#pragma unroll 1
        for (int q = 1; q < NE; ++q) e += (tb[q] <= i) ? 1 : 0;
        const bool ok = i < tb[NE]; te[i] = ok ? e : 0; ts[i] = ok ? e * CAP + 256 * (i - tb[e]) : 0; }
    __syncthreads();
}
__device__ __forceinline__ void swap16(unsigned& a, unsigned& b) { asm volatile("s_nop 1\n\tv_permlane16_swap_b32 %0, %1\n\ts_nop 1" : "+v"(a), "+v"(b)); }
#define SWAP16(A, B) do { unsigned a_ = (A), b_ = (B); swap16(a_, b_); (A) = a_; (B) = b_; } while (0)
struct EpiUp {
    static constexpr bool PERM = true;
    const float* __restrict__ bup; unsigned char* __restrict__ HB; const float* __restrict__ rowrstd;
    __device__ __forceinline__ void prefetch(const pg8::Unit& u, LAS unsigned char* tab, int wid, int lane) const {
        if (wid == 0) GLDS16R(bup + (size_t)u.e * 2048 + 256 * u.pn + 4 * lane, tab);
        else if (wid == 2) GLDS16R(rowrstd + (size_t)u.sb + 4 * lane, tab + 2048);
    }
    __device__ __forceinline__ void operator()(const pg8::f32x4 (&acc)[2][2][4][2], const pg8::Unit& u, int wr, int wc, int fr, int fq, const LAS unsigned char* tab) const {
        const int j0 = 128 * u.pn + 32 * wc + 8 * fq;
        const LAS float* tb = (const LAS float*)tab + 2 * (32 * wc + 8 * fq);
        pg8::f32x4 b4[4];
#pragma unroll
        for (int q = 0; q < 4; ++q) b4[q] = ((const LAS pg8::f32x4*)tb)[q];
        float rs8[2][4];
#pragma unroll
        for (int ai = 0; ai < 2; ++ai)
#pragma unroll
            for (int m = 0; m < 4; ++m) rs8[ai][m] = ((const LAS float*)(tab + 2048))[ai * 128 + wr * 64 + m * 16 + fr];
#pragma unroll
        for (int ai = 0; ai < 2; ++ai)
#pragma unroll
            for (int mp = 0; mp < 4; mp += 2) {
                v2u w2[2];
#pragma unroll
                for (int mm = 0; mm < 2; ++mm) { const int m = mp + mm; const float rsd = rs8[ai][m] * WDESCALE;
                    float o[8];
#pragma unroll
                    for (int n = 0; n < 2; ++n)
#pragma unroll
                        for (int i = 0; i < 4; ++i) {
                            float glu = acc[ai][0][m][n][i] * rsd + b4[2 * n + (i >> 1)][2 * (i & 1)], lin = acc[ai][1][m][n][i] * rsd + b4[2 * n + (i >> 1)][2 * (i & 1) + 1];
                            glu = fminf(glu, 7.f); lin = fminf(fmaxf(lin, -7.f), 7.f);
                            const float sg = __builtin_amdgcn_rcpf(1.f + __builtin_amdgcn_exp2f(-1.702f * 1.4426950408889634f * glu));
                            o[4 * n + i] = glu * sg * (lin + 1.f);
                        }
                    w2[mm].x = pk_fp8x4(o[0], o[1], o[2], o[3]); w2[mm].y = pk_fp8x4(o[4], o[5], o[6], o[7]); }
                SWAP16(w2[0].x, w2[1].x); SWAP16(w2[0].y, w2[1].y);
                const size_t row = (size_t)u.pm * 256 + ai * 128 + wr * 64 + (mp + (fq & 1)) * 16 + fr;
                v4u w; w.x = w2[0].x; w.y = w2[0].y; w.z = w2[1].x; w.w = w2[1].y;
                *(v4u*)(HB + row * D + j0 - 8 * (fq & 1)) = w;
            }
    }
};
struct EpiDown {
    static constexpr bool PERM = true;
    const int* __restrict__ rowtok; const float* __restrict__ rowgate; const float* __restrict__ bdn; unsigned char* __restrict__ ws;
    __device__ __forceinline__ void prefetch(const pg8::Unit& u, LAS unsigned char* tab, int wid, int lane) const {
        if (wid == 0) GLDS16R(bdn + (size_t)u.e * D + 256 * u.pn + 4 * lane, tab);
        else if (wid == 1) GLDS16R(rowtok + (size_t)u.sb + 4 * lane, tab + 1024);
        else if (wid == 2) GLDS16R(rowgate + (size_t)u.sb + 4 * lane, tab + 2048);
    }
    __device__ __forceinline__ void operator()(const pg8::f32x4 (&acc)[2][2][4][2], const pg8::Unit& u, int wr, int wc, int fr, int fq, const LAS unsigned char* tab) const {
        const int c0 = 256 * u.pn + 32 * wc + 8 * fq;
        const LAS float* bb = (const LAS float*)tab + 32 * wc + 8 * fq;
        pg8::f32x4 b4[2][2];
#pragma unroll
        for (int bj = 0; bj < 2; ++bj)
#pragma unroll
            for (int n = 0; n < 2; ++n) b4[bj][n] = *(const LAS pg8::f32x4*)(bb + 128 * bj + 4 * n);
        int tk8[2][4]; float gt8[2][4];
#pragma unroll
        for (int ai = 0; ai < 2; ++ai)
#pragma unroll
            for (int m = 0; m < 4; ++m) { tk8[ai][m] = ((const LAS int*)(tab + 1024))[ai * 128 + wr * 64 + m * 16 + fr]; gt8[ai][m] = ((const LAS float*)(tab + 2048))[ai * 128 + wr * 64 + m * 16 + fr]; }
#pragma unroll
        for (int ai = 0; ai < 2; ++ai)
#pragma unroll
            for (int m = 0; m < 4; ++m) {
                const int tk = tk8[ai][m];
                if (tk >= 0) {
                    const float gate = gt8[ai][m] * SLOT_SCALE; const float gsc = gate * WDESCALE; const int k = tk & 3;
                    const size_t soff = k == 0 ? WS_SLOT0 : (k == 1 ? WS_SLOT1 : (k == 2 ? WS_SLOT2 : WS_SLOT3));
                    unsigned char* p = (ws + soff) + (size_t)(tk >> 2) * D + c0;
                    v2u w2[2];
#pragma unroll
                    for (int bj = 0; bj < 2; ++bj) { const pg8::f32x4 v0 = acc[ai][bj][m][0] * gsc + b4[bj][0] * gate, v1 = acc[ai][bj][m][1] * gsc + b4[bj][1] * gate;
                        w2[bj].x = pk_fp8x4(v0[0], v0[1], v0[2], v0[3]); w2[bj].y = pk_fp8x4(v1[0], v1[1], v1[2], v1[3]); }
                    SWAP16(w2[0].x, w2[1].x); SWAP16(w2[0].y, w2[1].y);
                    v4u w; w.x = w2[0].x; w.y = w2[0].y; w.z = w2[1].x; w.w = w2[1].y;
                    *(v4u*)(p + 120 * (fq & 1)) = w;
                }
            }
    }
};
__device__ __forceinline__ void p10_final(Frame& F) {
    const int gw = F.vcu * NWAVES + F.wave, NGW = F.G * NWAVES;
    const unsigned char* s0 = F.ws + WS_SLOT0; const unsigned char* s1 = F.ws + WS_SLOT1; const unsigned char* s2 = F.ws + WS_SLOT2; const unsigned char* s3 = F.ws + WS_SLOT3;
    typedef float f32x2v __attribute__((ext_vector_type(2)));
#pragma unroll 2
    for (int m = gw; m < T; m += NGW) {
        const uint2* __restrict__ pin = (const uint2*)((const bf16*)(F.ws + WS_H1) + (size_t)m * D); float4* __restrict__ p = (float4*)(F.out + (size_t)m * D);
        float4 v[4]; float ss = 0.f;
#pragma unroll
        for (int q = 0; q < 4; ++q) { { const v2u hw_ = __builtin_nontemporal_load((const v2u*)pin + F.lane + 64 * q); const uint2 hw = make_uint2(hw_.x, hw_.y); v[q] = make_float4(__builtin_bit_cast(float, hw.x << 16), __builtin_bit_cast(float, hw.x & 0xffff0000u), __builtin_bit_cast(float, hw.y << 16), __builtin_bit_cast(float, hw.y & 0xffff0000u)); }
            const int z = __builtin_nontemporal_load((const int*)(s0 + (size_t)m * D) + F.lane + 64 * q), a = __builtin_nontemporal_load((const int*)(s1 + (size_t)m * D) + F.lane + 64 * q), b = __builtin_nontemporal_load((const int*)(s2 + (size_t)m * D) + F.lane + 64 * q), c = __builtin_nontemporal_load((const int*)(s3 + (size_t)m * D) + F.lane + 64 * q);
            const f32x2v zl = __builtin_amdgcn_cvt_pk_f32_fp8(z, false), zh = __builtin_amdgcn_cvt_pk_f32_fp8(z, true), al = __builtin_amdgcn_cvt_pk_f32_fp8(a, false), ah = __builtin_amdgcn_cvt_pk_f32_fp8(a, true);
            const f32x2v bl = __builtin_amdgcn_cvt_pk_f32_fp8(b, false), bh = __builtin_amdgcn_cvt_pk_f32_fp8(b, true), cl = __builtin_amdgcn_cvt_pk_f32_fp8(c, false), ch = __builtin_amdgcn_cvt_pk_f32_fp8(c, true);
            v[q].x += ((zl[0] + al[0]) + (bl[0] + cl[0])) * (1.f / SLOT_SCALE); v[q].y += ((zl[1] + al[1]) + (bl[1] + cl[1])) * (1.f / SLOT_SCALE);
            v[q].z += ((zh[0] + ah[0]) + (bh[0] + ch[0])) * (1.f / SLOT_SCALE); v[q].w += ((zh[1] + ah[1]) + (bh[1] + ch[1])) * (1.f / SLOT_SCALE);
            ss += v[q].x * v[q].x + v[q].y * v[q].y + v[q].z * v[q].z + v[q].w * v[q].w; }
        const float rs = rsqrtf(wave_sum(ss) * (1.f / D) + EPS);
#pragma unroll
        for (int q = 0; q < 4; ++q) { const float4 gg = ((const float4*)F.final_g)[F.lane + 64 * q]; { f32x4 ov = {v[q].x * rs * gg.x, v[q].y * rs * gg.y, v[q].z * rs * gg.z, v[q].w * rs * gg.w}; __builtin_nontemporal_store(ov, (f32x4*)p + F.lane + 64 * q); } }
    }
}

__global__ void __launch_bounds__(NWAVES * 64, 2) mk_fwd(Args args) {
    extern __shared__ __attribute__((aligned(16))) unsigned char lds[];
    Frame F;
    F.lds = (LAS unsigned char*)lds;
    F.tid = threadIdx.x; F.lane = F.tid & 63; F.wave = __builtin_amdgcn_readfirstlane(F.tid >> 6);
    F.G = gridDim.x; { const int bx = blockIdx.x; F.vcu = (F.G % 8 == 0) ? (bx % 8) * (F.G / 8) + bx / 8 : bx; }
    F.x = args.in[0]; F.meta = args.in[1]; F.attn_g = args.in[2]; F.w_in = args.in[3]; F.dlam = args.in[4]; F.subln = args.in[5]; F.w_out = args.in[6]; F.ffn_g = args.in[7];
    F.w_router = args.in[8]; F.b_router = args.in[9]; F.w_up = args.in[10]; F.b_up = args.in[11]; F.w_down = args.in[12]; F.b_down = args.in[13]; F.final_g = args.in[14];
    F.out = args.out; F.ws = args.ws;
    volatile LAS unsigned* MISC = (volatile LAS unsigned*)(F.lds + MISC_OFF);
    for (int u = F.tid; u < (TILE_E_OFF - LDSCTL_OFF) / 4; u += NWAVES * 64) ((LAS unsigned*)(F.lds + LDSCTL_OFF))[u] = 0u;
    __syncthreads();
    unsigned* ctl = (unsigned*)(F.ws + WS_CTL);
    XcdBarrier bar = xcd_barrier_post(ctl + CW_BAR + args.li * XCD_BAR_WORDS, MISC + 8);
    const int lo = args.ph_lo, hi = args.ph_hi;
#define IN(k) (lo <= (k) && (k) < hi)
#define BOTH(k) (IN(k) && IN((k) + 1))

    if (IN(0)) { p0_prologue(F); if (BOTH(0)) xcd_barrier(bar); }

    if (IN(1)) {
        pg8::Gemm g{(const bf16*)(F.ws + WS_HN), (const bf16*)(F.ws + WS_WIN), T, NPROJ, D, 0};
        pg8::StaticOrder S; S.init(T, NPROJ, F.G, (int)blockIdx.x);
        EpiInProj E{(bf16*)(F.ws + WS_DQ), (bf16*)(F.ws + WS_DK), (bf16*)(F.ws + WS_DV), (bf16*)(F.ws + WS_RQ), (bf16*)(F.ws + WS_RK), (bf16*)(F.ws + WS_RV), (bf16*)(F.ws + WS_RG),
                    (const float2*)(F.ws + WS_ROPE_D)};
        if (F.tid < 128) { const int par_ = F.tid >> 6, i_ = F.tid & 63;
            ((LAS float*)(F.lds + pg8::EPI_TAB_OFF + par_ * pg8::EPI_TAB_BYTES))[i_] = (i_ < 32 ? inv_freq_d(i_) : inv_freq_r(i_ - 32)) * 0.15915494309189535f; }
        __syncthreads();
        pg8::gemm_phase<EpiInProj, pg8::StaticOrder, true, false>(F.lds, g, S, E);
        if (BOTH(1)) xcd_barrier(bar);
    }

    if (IN(2)) { p2_ret_kv(F); if (BOTH(2)) xcd_barrier(bar); }
    if (IN(3)) { p3_ret_scan(F); if (BOTH(3)) xcd_barrier(bar); }
    if (IN(4)) { p4_ret_out(F); p4_attention<0>(F); if (BOTH(4)) xcd_barrier(bar); }

    if (IN(5)) {
        pg8::Gemm g{(const bf16*)(F.ws + WS_MIX), (const bf16*)(F.ws + WS_WOUT), T, D, D, 0};
        pg8::StaticOrder S; S.init(T, D, F.G, (int)blockIdx.x);
        EpiOutProj E{F.x, (bf16*)(F.ws + WS_H1)};
        pg8::gemm_phase<EpiOutProj, pg8::StaticOrder, true, false>(F.lds, g, S, E);
        if (BOTH(5)) xcd_barrier(bar);
    }
    if (IN(6)) { p6_router(F); if (BOTH(6)) xcd_barrier(bar); }

    if (IN(8)) {
        moe_tile_table(F);
        pg8::Gemm g{(const bf16*)(F.ws + WS_XN2), (const bf16*)(F.ws + WS_WUP), NROWS_MAX, 2048, D / 2, (size_t)2048 * D};
        MoeOrder S{(const LAS int*)(F.lds + TILE_E_OFF), (const int*)(F.ws + WS_ROWTOK_S), 8, F.G, F.vcu, D};
        EpiUp E{F.b_up, (unsigned char*)(F.ws + WS_HB), (const float*)(F.ws + WS_ROWRSTD_S)};
        pg8::gemm_phase<EpiUp, MoeOrder, true, true, true>(F.lds, g, S, E);
        if (BOTH(8)) xcd_barrier(bar);
    }
    if (IN(9)) {
        moe_tile_table(F);
        pg8::Gemm g{(const bf16*)(F.ws + WS_HB), (const bf16*)(F.ws + WS_WDN), NROWS_MAX, D, D / 2, (size_t)D * D};
        MoeOrder S{(const LAS int*)(F.lds + TILE_E_OFF), (const int*)(F.ws + WS_ROWTOK_S), 4, F.G, F.vcu, D};
        EpiDown E{(const int*)(F.ws + WS_ROWTOK_S), (const float*)(F.ws + WS_ROWGATE_S), F.b_down, F.ws};
        pg8::gemm_phase<EpiDown, MoeOrder, true, false, true>(F.lds, g, S, E);
        if (BOTH(9)) xcd_barrier(bar);
    }
    if (IN(10)) { p10_final(F); }
#undef IN
#undef BOTH
}
static int g_grid = 0;
static void mk_launch(Args a, int lo, int hi, int li, hipStream_t stream) {
    a.ph_lo = lo; a.ph_hi = hi; a.li = li; a.pad = 0;
    hipLaunchKernelGGL(mk_fwd, dim3(g_grid), dim3(NWAVES * 64), LDS_BYTES, stream, a);
}
extern "C" void kernel_launch(void* const* d_in, const int* in_sizes, int n_in, void* d_out, int out_size, void* d_ws, size_t ws_size, hipStream_t stream) {
    float* out = (float*)d_out; unsigned char* ws = (unsigned char*)d_ws;
    if (g_grid == 0) {
        if (ws_size < WS_END) { fprintf(stderr, "kernel_launch: workspace too small (%zu < %zu)\n", ws_size, (size_t)WS_END); g_grid = -1; return; }
        int dev = 0, cus = 0;
        if (hipGetDevice(&dev) != hipSuccess || hipDeviceGetAttribute(&cus, hipDeviceAttributeMultiprocessorCount, dev) != hipSuccess) { g_grid = -1; return; }
        if (hipFuncSetAttribute((const void*)mk_fwd, hipFuncAttributeMaxDynamicSharedMemorySize, LDS_BYTES) != hipSuccess) { fprintf(stderr, "kernel_launch: hipFuncSetAttribute failed\n"); g_grid = -1; return; }
        int per_cu = 0;
        if (hipOccupancyMaxActiveBlocksPerMultiprocessor(&per_cu, (const void*)mk_fwd, NWAVES * 64, LDS_BYTES) != hipSuccess || per_cu < 1) fprintf(stderr, "kernel_launch: occupancy query says %d\n", per_cu);
        (void)hipGetLastError();
        g_grid = cus;
    }
    if (g_grid < 0) return;
    (void)hipMemsetAsync(ws + WS_CTL, 0, 1 * MiB, stream);
    Args a{};
    for (int i = 0; i < 15; ++i) a.in[i] = (const float*)d_in[i];
    a.out = out; a.ws = ws;
    mk_launch(a, 0, 11, 0, stream);
}
```

```cpp
#include <hip/hip_runtime.h>
#include <cstdint>
#include <cstdio>

typedef unsigned short bf16;
constexpr int D = 1024, NB = 16, SEQ = 4096, NMETA = 16, LTOT = SEQ + NMETA, T = NB * SEQ;
constexpr int NPROJ = 3072;
constexpr int KROWS = 64 + SEQ;
constexpr int RROWS = 128 + SEQ;
constexpr int NE = 32, TOPK = 4;
constexpr int NASSIGN = T * TOPK;
constexpr int NROWS_MAX = NASSIGN + NE * 256;
constexpr int NTILES_MAX = NROWS_MAX / 256;
constexpr float EPS = 1e-5f;
constexpr float C2 = 0.125f * 1.4426950408889634f;
constexpr float LAMBDA_INIT = 0.2f;
constexpr float SLOT_SCALE = 16.f;
constexpr float WSCALE = 32.f, WDESCALE = 1.f / 32.f;

constexpr size_t MiB = 1u << 20;
constexpr size_t WS_CTL = 0;
constexpr size_t WS_ROPE_D = 1 * MiB;
constexpr size_t WS_ROPE_R = 2 * MiB + 64 * 1024;
constexpr size_t WS_TOPE = 3 * MiB + 128 * 1024;
constexpr size_t WS_TOPG = 4 * MiB + 128 * 1024;
constexpr size_t WS_RANK = 5 * MiB + 128 * 1024;
constexpr size_t WS_ROWTOK = 6 * MiB + 128 * 1024;
constexpr size_t WS_MISC = 7 * MiB + 512 * 1024;
constexpr size_t WS_WDN = 8 * MiB;
constexpr size_t WS_WUP = 72 * MiB;
constexpr size_t WS_WIN = 200 * MiB;
constexpr size_t WS_WOUT = 206 * MiB;
constexpr size_t WS_HN = 208 * MiB;
constexpr size_t WS_XN2 = 208 * MiB;
constexpr size_t WS_HB = 336 * MiB;
constexpr size_t WS_DQ = 336 * MiB;
constexpr size_t WS_DK = 400 * MiB;
constexpr size_t WS_DV = 466 * MiB;
constexpr size_t WS_RQ = 532 * MiB;
constexpr size_t WS_RK = 564 * MiB;
constexpr size_t WS_RV = 598 * MiB;
constexpr size_t WS_RG = 664 * MiB;
constexpr size_t WS_KVC = 728 * MiB;
constexpr size_t WS_ST = 796 * MiB;
constexpr size_t WS_MIX = 864 * MiB;
constexpr size_t WS_SLOT0 = 600 * MiB, WS_SLOT1 = 72 * MiB, WS_SLOT2 = 208 * MiB, WS_SLOT3 = 864 * MiB;
constexpr size_t WS_WRF = 7 * MiB + 640 * 1024;
constexpr size_t WS_RSTD = 7 * MiB + 768 * 1024;
constexpr size_t WS_ROWRSTD = 992 * MiB;
constexpr size_t WS_ROWGATE = 994 * MiB;
constexpr size_t WS_H1 = 728 * MiB;
constexpr int CAP = 65536;
constexpr size_t WS_ROWTOK_S = 1000 * MiB;
constexpr size_t WS_ROWRSTD_S = 1008 * MiB;
constexpr size_t WS_ROWGATE_S = 1016 * MiB;
constexpr size_t WS_END = 1024 * MiB;


__device__ __forceinline__ unsigned f2bf(float f) { unsigned u = __builtin_bit_cast(unsigned, f); return (u + 0x7fffu + ((u >> 16) & 1u)) >> 16; }
__device__ __forceinline__ unsigned pk2(float lo, float hi) { return f2bf(lo) | (f2bf(hi) << 16); }
__device__ __forceinline__ float bf2f(bf16 h) { return __builtin_bit_cast(float, (unsigned)h << 16); }
__device__ __forceinline__ float wave_sum(float v) {
#pragma unroll
    for (int o = 1; o < 64; o <<= 1) v += __shfl_xor(v, o);
    return v;
}
namespace pg8 {
#define PG8_LAS __attribute__((address_space(3)))
typedef unsigned short bf16_t;
typedef short bf16x8 __attribute__((ext_vector_type(8)));
typedef float f32x4 __attribute__((ext_vector_type(4)));
typedef unsigned u32x4 __attribute__((ext_vector_type(4)));
typedef unsigned u32x2 __attribute__((ext_vector_type(2)));
constexpr int EPI_TAB_OFF = 138 * 1024, EPI_TAB_BYTES = 3072;
constexpr int BM = 256, BK = 64, HALF = 128, HTB = HALF * BK * 2  , STAGE_BYTES = 8 * HTB, NXCD = 8, WGM = 8;

__host__ __device__ __forceinline__ int lds_byte(int r, int c) { const int st = (r >> 4) * 2 + (c >> 5), rr = r & 15, cc = c & 31, ob = rr * 64 + cc * 2; return st * 1024 + (ob ^ (((ob >> 9) & 1) << 5)); }
__host__ __device__ __forceinline__ void stage_rc(int b, int& R, int& C) { const int st = b / 1024, sb = b % 1024, swz = sb ^ (((sb >> 9) & 1) << 5); R = (st >> 1) * 16 + swz / 64; C = (st & 1) * 32 + (swz % 64) / 2; }
__host__ __device__ __forceinline__ int perm32(int rho) { const int n = rho >> 4, i = rho & 15; return 8 * (i >> 2) + 4 * n + (i & 3); }

struct Unit { int pm, pn, e, sb; };
struct Gemm { const bf16_t* A; const bf16_t* Bt; int M, N, K; size_t estride; };

struct StaticOrder {
    int nM, nN, nwg, G, c;
    __host__ __device__ __forceinline__ void init(int M, int N, int G_, int c_) { nM = M / BM; nN = N / BM; nwg = nM * nN; G = G_; c = c_; }
    __host__ __device__ __forceinline__ bool next(int i, Unit& u) const {
        const long L = (long)i * G + c; if (L >= nwg) return false;
        int wgid = (int)L; { const int q = nwg / NXCD, r = nwg % NXCD, xcd = wgid % NXCD, off = wgid / NXCD; wgid = (xcd < r ? xcd * (q + 1) : r * (q + 1) + (xcd - r) * q) + off; }
        const int nig = WGM * nN, gid = wgid / nig, fm = gid * WGM, gsz = (nM - fm) < WGM ? (nM - fm) : WGM;
        u.pm = fm + ((wgid % nig) % gsz); u.pn = (wgid % nig) / gsz; u.e = 0; u.sb = 0; return true;
    }
    __device__ __forceinline__ unsigned rowoff(const Unit&, int) const { return 0u; }
};

__device__ __forceinline__ unsigned cvt_pk_bf16(float lo, float hi) { unsigned r; asm volatile("v_cvt_pk_bf16_f32 %0, %1, %2" : "=v"(r) : "v"(lo), "v"(hi)); return r; }

typedef int v8i_t __attribute__((ext_vector_type(8)));
typedef int v4i_t __attribute__((ext_vector_type(4)));
template <class Epi, class Sched, bool ALIGN_EPI, bool GATHER, bool FP8 = false>
__device__ __forceinline__ void gemm_phase(PG8_LAS unsigned char* lds, const Gemm g, const Sched& S, const Epi& E) {
    const int tid = threadIdx.x, wid = __builtin_amdgcn_readfirstlane(tid >> 6), lane = tid & 63, wr = wid >> 2, wc = wid & 3, fr = lane & 15, fq = lane >> 4;
    const int K = g.K, nt = K / BK;
    unsigned voffA[2], voffB[2];
#pragma unroll
    for (int i = 0; i < 2; ++i) { int R, C; stage_rc(tid * 16 + i * 8192, R, C); const int Rb = Epi::PERM ? ((R & ~31) + perm32(R & 31)) : R;
        voffA[i] = (unsigned)(R * K + C) * 2u; voffB[i] = (unsigned)(Rb * K + C) * 2u; }
    const size_t kstep = (size_t)(BK * 2);
    const size_t hstep = (size_t)HALF * K * 2;
    const size_t tstep = 2 * hstep;
    const unsigned ldsw = (unsigned)wid * 1024u;
    const int aoff = lds_byte(wr * 64 + fr, fq * 8), boff = lds_byte(wc * 32 + fr, fq * 8);
#define PG8_SA(b, h) (((b) * 2 + (h)) * HTB)
#define PG8_SB(b, h) ((4 + (b) * 2 + (h)) * HTB)
#define PG8_STAGE(bufoff, gbase, voff) do { _Pragma("unroll") for (int _i = 0; _i < 2; ++_i) \
        __builtin_amdgcn_global_load_lds((const unsigned*)((const char*)(gbase) + (voff)[_i]), (PG8_LAS unsigned*)(lds + (bufoff) + ldsw + _i * 8192), 16, 0, 0); } while (0)
#define PG8_STAGE_A(bufoff, gbase, h, V) do { if constexpr (GATHER) { PG8_STAGE(bufoff, gbase, V[h]); } else { PG8_STAGE(bufoff, (gbase) + (h) * hstep, voffA); } } while (0)
#define PG8_LDA(dst, b, h) do { _Pragma("unroll") for (int m = 0; m < 4; ++m) _Pragma("unroll") for (int k = 0; k < 2; ++k) dst[m][k] = *(const PG8_LAS bf16x8*)(lds + PG8_SA(b, h) + aoff + m * 2048 + k * 1024); } while (0)
#define PG8_LDB(dst, b, h) do { _Pragma("unroll") for (int n = 0; n < 2; ++n) _Pragma("unroll") for (int k = 0; k < 2; ++k) dst[n][k] = *(const PG8_LAS bf16x8*)(lds + PG8_SB(b, h) + boff + n * 2048 + k * 1024); } while (0)
#define PG8_MMA(ai, bj, At, Bt) do { if constexpr (FP8) __builtin_amdgcn_sched_barrier(0); __builtin_amdgcn_s_setprio(1); _Pragma("unroll") for (int m = 0; m < 4; ++m) _Pragma("unroll") for (int n = 0; n < 2; ++n) { \
        if constexpr (FP8) { const v8i_t a8 = __builtin_shufflevector(__builtin_bit_cast(v4i_t, At[m][0]), __builtin_bit_cast(v4i_t, At[m][1]), 0, 1, 2, 3, 4, 5, 6, 7); \
            const v8i_t b8 = __builtin_shufflevector(__builtin_bit_cast(v4i_t, Bt[n][0]), __builtin_bit_cast(v4i_t, Bt[n][1]), 0, 1, 2, 3, 4, 5, 6, 7); \
            asm volatile("v_mfma_f32_16x16x128_f8f6f4 %0, %1, %2, %0" : "+v"(acc[ai][bj][m][n]) : "v"(b8), "v"(a8)); } \
        else { _Pragma("unroll") for (int k = 0; k < 2; ++k) acc[ai][bj][m][n] = __builtin_amdgcn_mfma_f32_16x16x32_bf16(Bt[n][k], At[m][k], acc[ai][bj][m][n], 0, 0, 0); } } \
        __builtin_amdgcn_s_setprio(0); if constexpr (FP8) __builtin_amdgcn_sched_barrier(0); } while (0)
#define PG8_WAIT_V(n) asm volatile("s_waitcnt vmcnt(" #n ")" ::: "memory")
#define PG8_WAIT_L(n) asm volatile("s_waitcnt lgkmcnt(" #n ")" ::: "memory")
#define PG8_BAR __builtin_amdgcn_s_barrier()
#define PG8_SCHED __builtin_amdgcn_sched_barrier(0)
#define PG8_ROWOFFS(V, u) do { _Pragma("unroll") for (int _i = 0; _i < 2; ++_i) { int _R, _C; stage_rc(tid * 16 + _i * 8192, _R, _C); _Pragma("unroll") for (int _h = 0; _h < 2; ++_h) V[_h][_i] = S.rowoff(u, _h * HALF + _R) + (unsigned)_C * 2u; } } while (0)
    Unit cur, nxt, nn; int ui = 0;
    if (!S.next(0, cur)) return;
    bool has_next = S.next(1, nxt);
    unsigned vc[2][2], vn[2][2], vnn[2][2];
    if constexpr (GATHER) { PG8_ROWOFFS(vc, cur); if (has_next) { PG8_ROWOFFS(vn, nxt); } else { PG8_ROWOFFS(vn, cur); } }
    f32x4 acc[2][2][4][2];
#pragma unroll
    for (int a = 0; a < 2; ++a)
#pragma unroll
        for (int b = 0; b < 2; ++b)
#pragma unroll
            for (int m = 0; m < 4; ++m)
#pragma unroll
                for (int n = 0; n < 2; ++n) acc[a][b][m][n] = (f32x4){0.f, 0.f, 0.f, 0.f};
    bf16x8 At[4][2], B0[2][2], B1[2][2];
    const char* cA = (const char*)g.A + (GATHER ? (size_t)0 : (size_t)cur.pm * tstep); const char* cB = (const char*)g.Bt + (size_t)cur.e * g.estride + (size_t)cur.pn * tstep;
    PG8_STAGE(PG8_SB(0, 0), cB, voffB); PG8_STAGE(PG8_SB(0, 1), cB + hstep, voffB); PG8_STAGE_A(PG8_SA(0, 0), cA, 0, vc); PG8_STAGE_A(PG8_SA(0, 1), cA, 1, vc);
    if (wr == 1) PG8_BAR;
    PG8_WAIT_V(2); PG8_BAR;
    PG8_STAGE(PG8_SB(1, 0), cB + kstep, voffB); PG8_STAGE_A(PG8_SA(1, 0), cA + kstep, 0, vc); PG8_STAGE(PG8_SB(1, 1), cB + hstep + kstep, voffB);
    PG8_WAIT_V(6); PG8_BAR;
    for (;;) {
        const char* nA = GATHER ? cA : (has_next ? (const char*)g.A + (size_t)nxt.pm * tstep : cA);
        const char* nB = has_next ? (const char*)g.Bt + (size_t)nxt.e * g.estride + (size_t)nxt.pn * tstep : cB;
#pragma unroll 1
        for (int t = 0; t < nt; t += 2) {
            const bool last = (t == nt - 2);
            if (t == 0) E.prefetch(cur, lds + EPI_TAB_OFF + (ui & 1) * EPI_TAB_BYTES, wid, lane);
            const char* a1 = cA + (size_t)(t + 1) * kstep;
            const char* a2 = last ? nA : cA + (size_t)(t + 2) * kstep; const char* b2 = last ? nB : cB + (size_t)(t + 2) * kstep;
            const char* a3 = a2 + kstep; const char* b3 = b2 + kstep;
            unsigned w2[2][2];
            if constexpr (GATHER) {
#pragma unroll
                for (int h = 0; h < 2; ++h)
#pragma unroll
                    for (int i = 0; i < 2; ++i) w2[h][i] = last ? vn[h][i] : vc[h][i];
            }
            PG8_LDB(B0, 0, 0); PG8_LDB(B1, 0, 1); PG8_SCHED; PG8_LDA(At, 0, 0); PG8_STAGE_A(PG8_SA(1, 1), a1, 1, vc);
            PG8_WAIT_V(8); PG8_WAIT_L(0); PG8_BAR; PG8_MMA(0, 0, At, B0); PG8_MMA(0, 1, At, B1); PG8_BAR; PG8_SCHED;
            PG8_LDA(At, 0, 1); PG8_STAGE(PG8_SB(0, 0), b2, voffB); PG8_STAGE(PG8_SB(0, 1), b2 + hstep, voffB); PG8_STAGE_A(PG8_SA(0, 0), a2, 0, w2);
            PG8_WAIT_V(8); PG8_WAIT_L(0); PG8_BAR; PG8_MMA(1, 0, At, B0); PG8_MMA(1, 1, At, B1); PG8_BAR; PG8_SCHED;
            PG8_LDB(B0, 1, 0); PG8_LDB(B1, 1, 1); PG8_SCHED; PG8_LDA(At, 1, 0); PG8_STAGE_A(PG8_SA(0, 1), a2, 1, w2);
            PG8_WAIT_V(8); PG8_WAIT_L(0); PG8_BAR; PG8_MMA(0, 0, At, B0); PG8_MMA(0, 1, At, B1); PG8_BAR; PG8_SCHED;
            PG8_LDA(At, 1, 1); PG8_STAGE(PG8_SB(1, 0), b3, voffB); PG8_STAGE(PG8_SB(1, 1), b3 + hstep, voffB); PG8_STAGE_A(PG8_SA(1, 0), a3, 0, w2);
            PG8_WAIT_V(8); PG8_WAIT_L(0); PG8_BAR; PG8_MMA(1, 0, At, B0); PG8_MMA(1, 1, At, B1); PG8_BAR; PG8_SCHED;
        }
        if constexpr (ALIGN_EPI) { if (wr == 0) PG8_BAR; }
        bool has_nn = false;
        if constexpr (GATHER) { has_nn = has_next && S.next(ui + 2, nn); if (has_nn) { PG8_ROWOFFS(vnn, nn); } else { PG8_ROWOFFS(vnn, cur); } }
        else { has_nn = has_next && S.next(ui + 2, nn); }
        if constexpr (FP8) asm volatile("s_nop 15\n\ts_nop 15" ::: "memory");
        E(acc, cur, wr, wc, fr, fq, lds + EPI_TAB_OFF + (ui & 1) * EPI_TAB_BYTES);
        if constexpr (GATHER) { asm volatile("" : "+v"(vnn[0][0]), "+v"(vnn[0][1]), "+v"(vnn[1][0]), "+v"(vnn[1][1])); }
        if (!has_next) break;
#pragma unroll
        for (int a = 0; a < 2; ++a)
#pragma unroll
            for (int b = 0; b < 2; ++b)
#pragma unroll
                for (int m = 0; m < 4; ++m)
#pragma unroll
                    for (int n = 0; n < 2; ++n) acc[a][b][m][n] = (f32x4){0.f, 0.f, 0.f, 0.f};
        cur = nxt; cA = nA; cB = nB; ++ui; nxt = nn; has_next = has_nn;
        if constexpr (GATHER) {
#pragma unroll
            for (int h = 0; h < 2; ++h)
#pragma unroll
                for (int i = 0; i < 2; ++i) { vc[h][i] = vn[h][i]; vn[h][i] = vnn[h][i]; }
        }
        if constexpr (ALIGN_EPI) { if (wr == 1) PG8_BAR; }
    }
    PG8_WAIT_V(0);
    if constexpr (!ALIGN_EPI) { if (wr == 0) PG8_BAR; }
    PG8_BAR;
#undef PG8_SA
#undef PG8_SB
#undef PG8_STAGE
#undef PG8_STAGE_A
#undef PG8_LDA
#undef PG8_LDB
#undef PG8_MMA
#undef PG8_WAIT_V
#undef PG8_WAIT_L
#undef PG8_BAR
#undef PG8_SCHED
#undef PG8_ROWOFFS
}
}
#define GAS __attribute__((address_space(1)))
#define LAS __attribute__((address_space(3)))
typedef unsigned v4u __attribute__((ext_vector_type(4)));
typedef unsigned v2u __attribute__((ext_vector_type(2)));
typedef float f32x4 __attribute__((ext_vector_type(4)));
typedef float f32x16 __attribute__((ext_vector_type(16)));
#define LDS_WAIT() asm volatile("s_waitcnt lgkmcnt(0)" ::: "memory")
#define VM_WAIT() asm volatile("s_waitcnt vmcnt(0)" ::: "memory")
constexpr int NWAVES = 8;
constexpr int RING_BYTES = 131072;
constexpr int LDSCTL_OFF = RING_BYTES, MISC_OFF = LDSCTL_OFF + 320;
constexpr int TILE_E_OFF = RING_BYTES + 1024;
constexpr int LDS_BYTES = 147456;
static_assert(TILE_E_OFF + (NTILES_MAX + 8) * 4 <= LDS_BYTES, "LDS map");
constexpr int CW_GCNT = 32768;
constexpr int TILE_S_OFF = TILE_E_OFF + (NTILES_MAX + 8) * 4;
static_assert(TILE_S_OFF + NTILES_MAX * 4 <= 138 * 1024, "LDS map");
constexpr int CW_BAR = 4096;

#define XB_TMO      128
#define XB_XCNT(j)  (256  + 64 * (j))
#define XB_XSUB(j)  (1280 + 64 * (j))
#define XB_XGEN(j)  (2304 + 64 * (j))
#define XB_TOP      3328
#define XB_TOPGEN   3392
#define XCD_BAR_WORDS 3456
#define XB_SPIN_CAP (1u << 18)
__device__ __forceinline__ unsigned xb_ld(unsigned* p)              { return __hip_atomic_load(p, __ATOMIC_RELAXED, __HIP_MEMORY_SCOPE_AGENT); }
__device__ __forceinline__ unsigned xb_add(unsigned* p, unsigned v) { return __hip_atomic_fetch_add(p, v, __ATOMIC_RELAXED, __HIP_MEMORY_SCOPE_AGENT); }
__device__ __forceinline__ unsigned xb_xcc_id() { return (unsigned)__builtin_amdgcn_s_getreg((3 << 11) | 20) & 0xFu; }
#define XB_SPIN(cond, bar) do { unsigned _sp = 0; while (cond) { __builtin_amdgcn_s_sleep(1); \
    if ((++_sp & 255u) == 0u) { if (xb_ld(&(bar)[XB_TMO])) break; if (_sp > XB_SPIN_CAP) { atomicAdd(&(bar)[XB_TMO], 1u); break; } } } } while (0)
struct XcdBarrier { unsigned* bar; unsigned x; volatile LAS unsigned* st; };
__device__ __forceinline__ XcdBarrier xcd_barrier_post(unsigned* bar, volatile LAS unsigned* st) {
    XcdBarrier b; b.bar = bar; b.x = xb_xcc_id(); b.st = st;
    if (threadIdx.x == 0) (void)xb_add(&bar[XB_XCNT(b.x)], 1u);
    return b;
}
__device__ __forceinline__ void xcd_barrier_complete(unsigned* bar, unsigned x, unsigned& nloc, unsigned& nx) {
    const unsigned G = gridDim.x * gridDim.y * gridDim.z;
    unsigned sum, cnt, mine, sp = 0u;
    for (;;) {
        sum = 0u; cnt = 0u; mine = 0u;
#pragma unroll
        for (unsigned j = 0; j < 16; ++j) { const unsigned c = xb_ld(&bar[XB_XCNT(j)]); sum += c; cnt += (c > 0u) ? 1u : 0u; mine = (j == x) ? c : mine; }
        if (sum == G) break;
        __builtin_amdgcn_s_sleep(1);
        if ((++sp & 255u) == 0u) { if (xb_ld(&bar[XB_TMO])) break; if (sp > XB_SPIN_CAP) { atomicAdd(&bar[XB_TMO], 1u); break; } }
    }
    nloc = mine > 0u ? mine : 1u; nx = cnt > 0u ? cnt : 1u;
}
__device__ __forceinline__ void xcd_barrier(const XcdBarrier& b) {
    asm volatile("s_waitcnt vmcnt(0)" ::: "memory");
    __syncthreads();
    if (threadIdx.x == 0) {
        unsigned* bar = b.bar;
        __builtin_amdgcn_s_waitcnt(0);
        unsigned nloc = b.st[0], nx = b.st[1];
        if (nloc == 0u) { xcd_barrier_complete(bar, b.x, nloc, nx); b.st[0] = nloc; b.st[1] = nx; }
        const unsigned old = xb_add(&bar[XB_XSUB(b.x)], 1u);
        const unsigned gen = old / nloc;
        if (old + 1u == (gen + 1u) * nloc) {
            __builtin_amdgcn_fence(__ATOMIC_RELEASE, "agent");
            asm volatile("s_waitcnt vmcnt(0)" ::: "memory");
            const unsigned og = xb_add(&bar[XB_TOP], 1u);
            const unsigned tg = og / nx;
            if (og + 1u == (tg + 1u) * nx) xb_add(&bar[XB_TOPGEN], 1u);
            else XB_SPIN(xb_ld(&bar[XB_TOPGEN]) == tg, bar);
            __builtin_amdgcn_fence(__ATOMIC_ACQUIRE, "agent");
            xb_add(&bar[XB_XGEN(b.x)], 1u);
            asm volatile("s_waitcnt vmcnt(0)" ::: "memory");
        } else {
            XB_SPIN(xb_ld(&bar[XB_XGEN(b.x)]) == gen, bar);
            __builtin_amdgcn_fence(__ATOMIC_ACQUIRE, "agent");
            asm volatile("s_waitcnt vmcnt(0)" ::: "memory");
        }
    }
    __syncthreads();
}

__device__ __forceinline__ void glds16_raw(const void* gsrc, unsigned lds_dst) { unsigned keep;
    asm volatile("s_mov_b32 %0, m0\n\ts_mov_b32 m0, %2\n\ts_nop 0\n\tglobal_load_lds_dwordx4 %1, off\n\ts_mov_b32 m0, %0" : "=&s"(keep) : "v"(gsrc), "s"(lds_dst) : "memory"); }
#define GLDS16R(gp, lp) glds16_raw((const void*)(gp), (unsigned)__builtin_amdgcn_readfirstlane((int)(unsigned)(size_t)(lp)))
struct Args { const float* in[15]; float* out; unsigned char* ws; int ph_lo, ph_hi, li, pad; };
struct Frame {
    LAS unsigned char* lds;
    int tid, lane, wave, vcu, G;
    const float *x, *meta, *attn_g, *w_in, *dlam, *subln, *w_out, *ffn_g, *w_router, *b_router, *w_up, *b_up, *w_down, *b_down, *final_g;
    float* out; unsigned char* ws;
};

template <class DestRow>
__device__ __forceinline__ void p0_transpose_item(const float* __restrict__ W, int K, int N, bf16* __restrict__ WT, LAS float* scr, int item, int lane, DestRow dest) {
    const int nblk = N / 32, kb = item / nblk, nb = item % nblk, k0 = 64 * kb, n0 = 32 * nb;
#pragma unroll 8
    for (int i = 0; i < 32; ++i) { const int kk = 2 * i + (lane >> 5); scr[kk * 33 + (lane & 31)] = __builtin_nontemporal_load(W + (size_t)(k0 + kk) * N + n0 + (lane & 31)); }
    LDS_WAIT(); asm volatile("" ::: "memory");
    const int c = lane & 7;
#pragma unroll
    for (int j = 0; j < 4; ++j) { const int n = (lane >> 3) + 8 * j; const LAS float* s = scr + (8 * c) * 33 + n;
        v4u o; o.x = pk2(s[0 * 33], s[1 * 33]); o.y = pk2(s[2 * 33], s[3 * 33]); o.z = pk2(s[4 * 33], s[5 * 33]); o.w = pk2(s[6 * 33], s[7 * 33]);
        *(v4u*)(WT + (size_t)dest(n0 + n) * K + k0 + 8 * c) = o; }
    LDS_WAIT(); asm volatile("" ::: "memory");
}

__device__ __forceinline__ unsigned pk_fp8x4(float a, float b, float c, float d) { int w = __builtin_amdgcn_cvt_pk_fp8_f32(a, b, 0, false); w = __builtin_amdgcn_cvt_pk_fp8_f32(c, d, w, true); return (unsigned)w; }
template <class DestRow>
__device__ __forceinline__ void p0_transpose_item_fp8(const float* __restrict__ W, int K, int N, unsigned char* __restrict__ WT, LAS float* scr, int item, int lane, DestRow dest, float scale) {
    const int nblk = N / 32, kb = item / nblk, nb = item % nblk, k0 = 64 * kb, n0 = 32 * nb;
#pragma unroll 8
    for (int i = 0; i < 32; ++i) { const int kk = 2 * i + (lane >> 5); scr[kk * 33 + (lane & 31)] = __builtin_nontemporal_load(W + (size_t)(k0 + kk) * N + n0 + (lane & 31)); }
    LDS_WAIT(); asm volatile("" ::: "memory");
    const int c = lane & 7;
#pragma unroll
    for (int j = 0; j < 4; ++j) { const int n = (lane >> 3) + 8 * j; const LAS float* s = scr + (8 * c) * 33 + n;
        v2u o; o.x = pk_fp8x4(s[0 * 33] * scale, s[1 * 33] * scale, s[2 * 33] * scale, s[3 * 33] * scale); o.y = pk_fp8x4(s[4 * 33] * scale, s[5 * 33] * scale, s[6 * 33] * scale, s[7 * 33] * scale);
        *(v2u*)(WT + (size_t)dest(n0 + n) * K + k0 + 8 * c) = o; }
    LDS_WAIT(); asm volatile("" ::: "memory");
}
struct DestId { __device__ __forceinline__ int operator()(int n) const { return n; } };
struct DestIn {
    __device__ __forceinline__ int operator()(int n) const { const int pn = n >> 8; const bool rope = (pn < 4) || pn == 6 || pn == 7; if (!rope) return n;
        const int w = n & 255, hh = w >> 6, bj = (w >> 5) & 1, dd = w & 31; return (pn << 8) + 128 * bj + 32 * hh + dd; }
};
struct DestUp {
    __device__ __forceinline__ int operator()(int c) const { return ((c >> 8) << 8) + 128 * (c & 1) + ((c >> 1) & 127); }
};

__device__ __forceinline__ float inv_freq_d(int i) { return exp2f(-(float)i / 32.0f * 13.287712379549449f); }
__device__ __forceinline__ float inv_freq_r(int i) { return exp2f(-(float)i / 31.0f * 13.287712379549449f); }

__device__ __forceinline__ void p0_meta(Frame& F, int j) {
    LAS float* hn = (LAS float*)F.lds;
    LAS float* part = (LAS float*)(F.lds + 65536);
    LAS float* fin = (LAS float*)(F.lds + 98304);
    for (int r = F.wave * 2; r < F.wave * 2 + 2; ++r) {
        const float* src = F.meta + (size_t)r * D;
        float4 v[4]; float ss = 0.f;
#pragma unroll
        for (int q = 0; q < 4; ++q) { v[q] = ((const float4*)src)[F.lane + 64 * q]; ss += v[q].x * v[q].x + v[q].y * v[q].y + v[q].z * v[q].z + v[q].w * v[q].w; }
        const float rs = rsqrtf(wave_sum(ss) * (1.f / D) + EPS);
#pragma unroll
        for (int q = 0; q < 4; ++q) { const float4 gg = ((const float4*)F.attn_g)[F.lane + 64 * q]; const int k = 4 * (F.lane + 64 * q);
            hn[r * D + k] = v[q].x * rs * gg.x; hn[r * D + k + 1] = v[q].y * rs * gg.y; hn[r * D + k + 2] = v[q].z * rs * gg.z; hn[r * D + k + 3] = v[q].w * rs * gg.w; }
    }
    __syncthreads();
    float acc[16];
#pragma unroll
    for (int r = 0; r < 16; ++r) acc[r] = 0.f;
    for (int k = 128 * F.wave; k < 128 * F.wave + 128; k += 4) {
        float wv[4];
#pragma unroll
        for (int q = 0; q < 4; ++q) wv[q] = F.w_in[(size_t)(k + q) * NPROJ + 64 * j + F.lane];
#pragma unroll
        for (int r = 0; r < 16; ++r) { const f32x4 h4 = *(const LAS f32x4*)(hn + r * D + k); acc[r] += h4[0] * wv[0] + h4[1] * wv[1] + h4[2] * wv[2] + h4[3] * wv[3]; }
    }
#pragma unroll
    for (int r = 0; r < 16; ++r) part[(F.wave * 16 + r) * 64 + F.lane] = acc[r];
    __syncthreads();
    for (int idx = F.tid; idx < 1024; idx += 512) { float s = 0.f;
#pragma unroll
        for (int w = 0; w < 8; ++w) s += part[w * 1024 + idx];
        fin[idx] = s; }
    __syncthreads();
    bf16* DK = (bf16*)(F.ws + WS_DK); bf16* DV = (bf16*)(F.ws + WS_DV); bf16* RK = (bf16*)(F.ws + WS_RK); bf16* RV = (bf16*)(F.ws + WS_RV);
    for (int idx = F.tid; idx < 1024; idx += 512) {
        const int r = idx >> 6, c = idx & 63; float val = fin[idx];
        const bool isdk = j >= 8 && j < 16, isrk = j >= 28 && j < 32;
        if (isdk || isrk) {
            const int i = c & 31; const float ang = (float)r * (isdk ? inv_freq_d(i) : inv_freq_r(i)); const float cs = cosf(ang), sn = sinf(ang);
            const float other = fin[idx ^ 32];
            val = c < 32 ? val * cs - other * sn : val * cs + other * sn;
            if (isrk) val *= 0.125f * exp2f(-(float)(112 + r) * log2f(1.f - exp2f(-5.f - (float)(j - 28))));
        }
        const bf16 o = (bf16)f2bf(val);
        for (int bb = 0; bb < NB; ++bb) {
            if (isdk) DK[((size_t)bb * KROWS + r) * 512 + 64 * (j - 8) + c] = o;
            else if (j >= 16 && j < 24) DV[((size_t)bb * KROWS + r) * 512 + 64 * (j - 16) + c] = o;
            else if (isrk) RK[((size_t)bb * RROWS + 112 + r) * 256 + 64 * (j - 28) + c] = o;
            else RV[((size_t)bb * RROWS + 112 + r) * 512 + 64 * (j - 32) + c] = o;
        }
    }
    __syncthreads();
}

__device__ __forceinline__ void p0_prologue(Frame& F) {
    if (F.vcu < 48) { const int j = F.vcu; const bool need = (j >= 8 && j < 24) || (j >= 28 && j < 40); if (need) p0_meta(F, j); }
    LAS float* scr = (LAS float*)(F.lds + F.wave * 16384);
    const int gw = F.vcu * NWAVES + F.wave, NGW = F.G * NWAVES;
    bf16* WinT = (bf16*)(F.ws + WS_WIN); bf16* WoutT = (bf16*)(F.ws + WS_WOUT); bf16* WupT = (bf16*)(F.ws + WS_WUP); bf16* WdnT = (bf16*)(F.ws + WS_WDN);
    constexpr int I_IN = (D / 64) * (NPROJ / 32), I_OUT = (D / 64) * (D / 32), I_UP = (D / 64) * (2048 / 32), I_DN = (D / 64) * (D / 32);
    constexpr int NITEMS = I_IN + I_OUT + NE * I_UP + NE * I_DN;
    for (int it = gw; it < NITEMS; it += NGW) {
        int r = it;
        if (r < I_IN) { p0_transpose_item(F.w_in, D, NPROJ, WinT, scr, r, F.lane, DestIn{}); continue; } r -= I_IN;
        if (r < I_OUT) { p0_transpose_item(F.w_out, D, D, WoutT, scr, r, F.lane, DestId{}); continue; } r -= I_OUT;
        if (r < NE * I_UP) { const int e = r / I_UP; p0_transpose_item_fp8(F.w_up + (size_t)e * D * 2048, D, 2048, (unsigned char*)WupT + (size_t)e * 2048 * D, scr, r % I_UP, F.lane, DestUp{}, WSCALE); continue; } r -= NE * I_UP;
        { const int e = r / I_DN; p0_transpose_item_fp8(F.w_down + (size_t)e * D * D, D, D, (unsigned char*)WdnT + (size_t)e * D * D, scr, r % I_DN, F.lane, DestId{}, WSCALE); }
    }
    bf16* HN = (bf16*)(F.ws + WS_HN);
#pragma unroll 2
    for (int m = gw; m < T; m += NGW) {
        const float* __restrict__ src = F.x + (size_t)m * D;
        float4 v[4]; float ss = 0.f;
#pragma unroll
        for (int q = 0; q < 4; ++q) { const f32x4 t4 = __builtin_nontemporal_load((const f32x4*)src + F.lane + 64 * q); v[q] = make_float4(t4[0], t4[1], t4[2], t4[3]); ss += v[q].x * v[q].x + v[q].y * v[q].y + v[q].z * v[q].z + v[q].w * v[q].w; }
        const float rs = rsqrtf(wave_sum(ss) * (1.f / D) + EPS);
#pragma unroll
        for (int q = 0; q < 4; ++q) { const float4 gg = ((const float4*)F.attn_g)[F.lane + 64 * q];
            uint2 o; o.x = pk2(v[q].x * rs * gg.x, v[q].y * rs * gg.y); o.y = pk2(v[q].z * rs * gg.z, v[q].w * rs * gg.w);
            ((uint2*)(HN + (size_t)m * D))[F.lane + 64 * q] = o; }
    }
    float2* tabD = (float2*)(F.ws + WS_ROPE_D); float2* tabR = (float2*)(F.ws + WS_ROPE_R);
    for (int idx = F.vcu * 512 + F.tid; idx < LTOT * 32; idx += F.G * 512) {
        const int pos = idx >> 5, i = idx & 31; const float aD = (float)pos * inv_freq_d(i), aR = (float)pos * inv_freq_r(i);
        tabD[idx] = make_float2(cosf(aD), sinf(aD)); tabR[idx] = make_float2(cosf(aR), sinf(aR));
    }
    { bf16* wrf = (bf16*)(F.ws + WS_WRF);
      for (int idx = F.vcu * 512 + F.tid; idx < 64 * 64; idx += F.G * 512) { const int s_ = idx >> 6, ln = idx & 63, n = ln & 31, hi = ln >> 5; unsigned h[4], l[4];
#pragma unroll
          for (int j = 0; j < 4; ++j) { const float w0 = F.w_router[(16 * s_ + 8 * hi + 2 * j) * NE + n], w1 = F.w_router[(16 * s_ + 8 * hi + 2 * j + 1) * NE + n];
              const unsigned h0 = f2bf(w0), h1 = f2bf(w1); h[j] = h0 | (h1 << 16); l[j] = f2bf(w0 - bf2f((bf16)h0)) | (f2bf(w1 - bf2f((bf16)h1)) << 16); }
          *(v4u*)(wrf + (size_t)idx * 8) = (v4u){h[0], h[1], h[2], h[3]}; *(v4u*)(wrf + (size_t)(4096 + idx) * 8) = (v4u){l[0], l[1], l[2], l[3]}; } }
    { v4u* rt = (v4u*)(F.ws + WS_ROWTOK_S); const v4u m1 = {0xffffffffu, 0xffffffffu, 0xffffffffu, 0xffffffffu};
      for (int idx = F.vcu * 512 + F.tid; idx < NE * CAP / 4; idx += F.G * 512) rt[idx] = m1; }
    { v4u* DK = (v4u*)(F.ws + WS_DK); v4u* DV = (v4u*)(F.ws + WS_DV); v4u* RK = (v4u*)(F.ws + WS_RK); v4u* RV = (v4u*)(F.ws + WS_RV); const v4u z = {0u, 0u, 0u, 0u};
      constexpr int nA = NB * 48 * 64, nB = NB * 112 * 32, nC = NB * 112 * 64;
      for (int idx = F.vcu * 512 + F.tid; idx < nC; idx += F.G * 512) {
          if (idx < nA) { const int b = idx / (48 * 64), r = idx % (48 * 64); DK[((size_t)b * KROWS + 16) * 64 + r] = z; DV[((size_t)b * KROWS + 16) * 64 + r] = z; }
          if (idx < nB) { const int b = idx / (112 * 32), r = idx % (112 * 32); RK[(size_t)b * RROWS * 32 + r] = z; }
          { const int b = idx / (112 * 64), r = idx % (112 * 64); RV[(size_t)b * RROWS * 64 + r] = z; }
      } }
}

struct EpiInProj {
    static constexpr bool PERM = true;
    bf16 *__restrict__ DQ, *__restrict__ DK, *__restrict__ DV, *__restrict__ RQ, *__restrict__ RK, *__restrict__ RV, *__restrict__ RG; const float2 *__restrict__ tabD;
    __device__ __forceinline__ void prefetch(const pg8::Unit&, LAS unsigned char*, int, int) const {}
    __device__ __forceinline__ void operator()(const pg8::f32x4 (&acc)[2][2][4][2], const pg8::Unit& u, int wr, int wc, int fr, int fq, const LAS unsigned char* tab) const {
        const int pn = u.pn;
        bf16* __restrict__ base; int ld, colb, rk, rope; float sc = 1.f;
        float dsgn = 0.f;
        if (pn < 2) { base = DQ; ld = 512; colb = 256 * pn; rk = 0; rope = 1; sc = C2; }
        else if (pn < 4) { base = DK; ld = 512; colb = 256 * (pn - 2); rk = 1; rope = 1; }
        else if (pn < 6) { base = DV; ld = 512; colb = 256 * (pn - 4); rk = 1; rope = 0; }
        else if (pn == 6) { base = RQ; ld = 256; colb = 0; rk = 0; rope = 2; dsgn = 1.f; }
        else if (pn == 7) { base = RK; ld = 256; colb = 0; rk = 2; rope = 2; sc = 0.125f; dsgn = -1.f; }
        else if (pn < 10) { base = RV; ld = 512; colb = 256 * (pn - 8); rk = 2; rope = 0; }
        else { base = RG; ld = 512; colb = 256 * (pn - 10); rk = 0; rope = 0; }
        const float l2g = dsgn * log2f(1.f - exp2f(-5.f - (float)wc));
        float fr8[8];
        { const LAS float* ft = (const LAS float*)tab + (rope == 2 ? 32 : 0) + 8 * fq; const pg8::f32x4 f0 = *(const LAS pg8::f32x4*)ft, f1 = *(const LAS pg8::f32x4*)(ft + 4);
#pragma unroll
          for (int p = 0; p < 4; ++p) { fr8[p] = f0[p]; fr8[4 + p] = f1[p]; } }
#pragma unroll
        for (int ai = 0; ai < 2; ++ai)
#pragma unroll
            for (int m = 0; m < 4; ++m) {
                const int tr = u.pm * 256 + ai * 128 + wr * 64 + m * 16 + fr; const int b = tr >> 12, t = tr & 4095;
                const size_t drow = rk == 0 ? (size_t)tr : rk == 1 ? ((size_t)b * KROWS + 64 + t) : ((size_t)b * RROWS + 128 + t);
                bf16* __restrict__ rowp = base + drow * ld + colb;
                if (rope) {
                    const float pos = (float)(t + NMETA);
                    pg8::f32x4 cs[4];
#pragma unroll
                    for (int p = 0; p < 8; ++p) { const float rev = __builtin_amdgcn_fractf(pos * fr8[p]); cs[p >> 1][2 * (p & 1)] = __builtin_amdgcn_cosf(rev); cs[p >> 1][2 * (p & 1) + 1] = __builtin_amdgcn_sinf(rev); }
                    pg8::u32x4 w1, w2;
                    const float scr_ = sc * __builtin_amdgcn_exp2f((float)(t & 127) * l2g);
#pragma unroll
                    for (int n = 0; n < 2; ++n) {
                        const pg8::f32x4 x1 = acc[ai][0][m][n], x2 = acc[ai][1][m][n]; float o1[4], o2[4];
#pragma unroll
                        for (int i = 0; i < 4; ++i) { const float c = cs[2 * n + (i >> 1)][2 * (i & 1)], s = cs[2 * n + (i >> 1)][2 * (i & 1) + 1];
                            o1[i] = (x1[i] * c - x2[i] * s) * scr_; o2[i] = (x2[i] * c + x1[i] * s) * scr_; }
                        w1[2 * n] = pg8::cvt_pk_bf16(o1[0], o1[1]); w1[2 * n + 1] = pg8::cvt_pk_bf16(o1[2], o1[3]);
                        w2[2 * n] = pg8::cvt_pk_bf16(o2[0], o2[1]); w2[2 * n + 1] = pg8::cvt_pk_bf16(o2[2], o2[3]);
                    }
                    *(pg8::u32x4*)(rowp + 64 * wc + 8 * fq) = w1; *(pg8::u32x4*)(rowp + 64 * wc + 32 + 8 * fq) = w2;
                } else {
#pragma unroll
                    for (int bj = 0; bj < 2; ++bj) { const pg8::f32x4 v0 = acc[ai][bj][m][0], v1 = acc[ai][bj][m][1]; pg8::u32x4 w;
                        w.x = pg8::cvt_pk_bf16(v0[0], v0[1]); w.y = pg8::cvt_pk_bf16(v0[2], v0[3]); w.z = pg8::cvt_pk_bf16(v1[0], v1[1]); w.w = pg8::cvt_pk_bf16(v1[2], v1[3]);
                        *(pg8::u32x4*)(rowp + 128 * bj + 32 * wc + 8 * fq) = w; }
                }
            }
    }
};


typedef short bf16x8_t __attribute__((ext_vector_type(8)));
typedef short s16x4_t __attribute__((ext_vector_type(4)));
typedef float f32x2_t __attribute__((ext_vector_type(2)));
typedef __bf16 bf16x2_t __attribute__((ext_vector_type(2)));
#define MFMA32(a, b, c) __builtin_amdgcn_mfma_f32_32x32x16_bf16((a), (b), (c), 0, 0, 0)
__device__ __forceinline__ int crow(int i, int hh) { return (i & 3) + 8 * (i >> 2) + 4 * hh; }
__device__ __forceinline__ unsigned cvtpk(float lo, float hi) { f32x2_t v = {lo, hi}; bf16x2_t b = __builtin_convertvector(v, bf16x2_t); return __builtin_bit_cast(unsigned, b); }
__device__ __forceinline__ s16x4_t vtr(const LAS unsigned char* p) { typedef short v4i16_t __attribute__((ext_vector_type(4))); return __builtin_bit_cast(s16x4_t, __builtin_amdgcn_ds_read_tr16_b64_v4i16((LAS v4i16_t*)p)); }
__device__ __forceinline__ bf16x8_t pack8(const f32x16& x, int s8) {
    v4u w; w.x = cvtpk(x[s8], x[s8 + 1]); w.y = cvtpk(x[s8 + 2], x[s8 + 3]); w.z = cvtpk(x[s8 + 4], x[s8 + 5]); w.w = cvtpk(x[s8 + 6], x[s8 + 7]); return __builtin_bit_cast(bf16x8_t, w);
}
__device__ __forceinline__ float vmax3(float a, float b, float c) { float r; asm("v_max3_f32 %0, %1, %2, %3" : "=v"(r) : "v"(a), "v"(b), "v"(c)); return r; }
__device__ __forceinline__ float vmax2(float a, float b) { float r; asm("v_max_f32 %0, %1, %2" : "=v"(r) : "v"(a), "v"(b)); return r; }
__device__ __forceinline__ float half_max(float v) { float a = v, b = v; asm("s_nop 1\n\tv_permlane32_swap_b32 %0, %1\n\ts_nop 1" : "+v"(a), "+v"(b)); return vmax2(a, b); }
__device__ __forceinline__ void swap32(unsigned& a, unsigned& b) { asm volatile("s_nop 1\n\tv_permlane32_swap_b32 %0, %1\n\ts_nop 1" : "+v"(a), "+v"(b)); }
__device__ __forceinline__ float half_swap(float v) { return __shfl_xor(v, 32); }
constexpr int AT_K = 0, AT_V = 3 * 8192, AT_ST = AT_V + 3 * 16384, AT_ST7 = RING_BYTES + 1024, AT_SCR = AT_ST7 + 8192;
static_assert(AT_ST + 7 * 8192 <= RING_BYTES && AT_SCR + 1024 <= 147456, "attention LDS map");
__device__ __forceinline__ LAS unsigned char* at_stage(LAS unsigned char* lds, int wave) { return lds + (wave < 7 ? AT_ST + wave * 8192 : AT_ST7); }
#define GLDS16(gp, lp) __builtin_amdgcn_global_load_lds((const unsigned*)(gp), (LAS unsigned*)(lp), 16, 0, 0)
__device__ __forceinline__ void glds16_asm(const void* gsrc, unsigned lds_dst) { unsigned keep;
    asm volatile("s_mov_b32 %0, m0\n\ts_mov_b32 m0, %2\n\ts_nop 0\n\tglobal_load_lds_dwordx4 %1, off\n\ts_mov_b32 m0, %0" : "=&s"(keep) : "v"(gsrc), "s"(lds_dst) : "memory"); }
__device__ __forceinline__ void glds16_sbase(const void* sbase, unsigned voff, const LAS unsigned char* lp) { unsigned keep;
    asm volatile("s_mov_b32 %0, m0\n\ts_mov_b32 m0, %3\n\ts_nop 0\n\tglobal_load_lds_dwordx4 %1, %2\n\ts_mov_b32 m0, %0" : "=&s"(keep) : "v"(voff), "s"(sbase), "s"((unsigned)(size_t)lp) : "memory"); }
#define GLDS16A(gp, lp) glds16_asm((const void*)(gp), (unsigned)__builtin_amdgcn_readfirstlane((int)(unsigned)(size_t)(lp)))

constexpr float AT_THR = 8.f;
constexpr int AT_SLOT = 8192;
#define SBAR() __builtin_amdgcn_sched_barrier(0)
#define PIN(x) asm volatile("" : "+v"(x))
#define WAIT_BAR(N) asm volatile("s_waitcnt vmcnt(" #N ") lgkmcnt(0)\n\ts_barrier" ::: "memory")
#define MX3(a, b, c) __builtin_elementwise_maximum(__builtin_elementwise_maximum((a), (b)), (c))
__device__ __forceinline__ float at_rowmax(const f32x16& p0, const f32x16& p1) {
    float a = MX3(p0[0], p0[1], p1[0]), b = MX3(p0[2], p0[3], p1[1]); a = MX3(a, p1[2], p1[3]);
#pragma unroll
    for (int r = 4; r < 16; r += 4) { a = MX3(a, p0[r], p0[r + 1]); b = MX3(b, p0[r + 2], p0[r + 3]); a = MX3(a, p1[r], p1[r + 1]); b = MX3(b, p1[r + 2], p1[r + 3]); }
    return half_max(__builtin_elementwise_maximum(a, b)); }
__device__ __forceinline__ void at_cmask(f32x16& p0, f32x16& p1, int jb, int qrel, int hi) {
    const int kb = 64 * jb + 4 * hi;
#pragma unroll
    for (int r = 0; r < 16; ++r) { const int kv = kb + (r & 3) + 8 * (r >> 2); if (kv > qrel) p0[r] = -INFINITY; if (kv + 32 > qrel) p1[r] = -INFINITY; } }
template <int MP, int VAR>
__device__ __forceinline__ void attn_pass(Frame& F, f32x16 (&o)[4], int b, int h, int qb, float lam) {
    int lane = F.lane; asm volatile("" : "+v"(lane));
    const int r = lane & 31, hh = lane >> 5, wave = F.wave;
    const bf16* DQ = (const bf16*)(F.ws + WS_DQ); const bf16* DK = (const bf16*)(F.ws + WS_DK); const bf16* DV = (const bf16*)(F.ws + WS_DV);
    const int tq = 32 * wave + r;
    const size_t trow = (size_t)b * SEQ + 256 * qb + tq;
    const int NT = 4 * qb + 5;
    const LAS unsigned char* kp0 = F.lds + AT_K + hh * 1024 + r * 16;
    const LAS unsigned char* vp0 = F.lds + AT_V + (4 * hh + ((lane & 15) >> 2)) * 64 + ((lane >> 4) & 1) * 32 + (lane & 3) * 8;
    const int kh = 2 * h + MP;
    bf16x8_t qr[4];
#pragma unroll
    for (int s_ = 0; s_ < 4; ++s_) qr[s_] = *(const bf16x8_t*)(DQ + trow * 512 + 64 * kh + 16 * s_ + 8 * hh);
    const int pc0 = 2 * wave, pc1 = 2 * wave + 1;
    const bf16* kbase = DK + (size_t)b * KROWS * 512 + 64 * kh + 8 * wave;
    const bf16* vbase0 = DV + ((size_t)b * KROWS + 16 * (pc0 & 3)) * 512 + 128 * h + 32 * (pc0 >> 2);
    const bf16* vbase1 = DV + ((size_t)b * KROWS + 16 * (pc1 & 3)) * 512 + 128 * h + 32 * (pc1 >> 2);
    const unsigned koff = (unsigned)lane * 1024u, voff = (unsigned)(lane >> 2) * 1024u + (unsigned)(lane & 3) * 16u;
    const int vd0 = (pc0 >> 2) * 4096 + (pc0 & 3) * 1024, vd1 = (pc1 >> 2) * 4096 + (pc1 & 3) * 1024;
#define DMA_K(t, sl) do { const int t_ = (t); const bool ex_ = t_ < NT; glds16_sbase(kbase + (size_t)(ex_ ? t_ : 0) * 64 * 512, koff, F.lds + (ex_ ? AT_K + (sl) + wave * 1024 : AT_SCR)); } while (0)
#define DMA_V0(t, sl) glds16_sbase(vbase0 + (size_t)(t) * 64 * 512, voff, F.lds + AT_V + 2 * (sl) + vd0)
#define DMA_V1(t, sl) glds16_sbase(vbase1 + (size_t)(t) * 64 * 512, voff, F.lds + AT_V + 2 * (sl) + vd1)
#define DMA_V(t, sl) do { DMA_V0(t, sl); DMA_V1(t, sl); } while (0)
    asm volatile("s_waitcnt lgkmcnt(0)\n\ts_barrier" ::: "memory");
    DMA_K(0, 0); DMA_V(0, 0); DMA_K(1, AT_SLOT); DMA_K(2, 2 * AT_SLOT);
    float mref = 0.f, l = 0.f, alpha = 1.f; bool resc = false;
    f32x16 negm;
#pragma unroll
    for (int i = 0; i < 16; ++i) negm[i] = 0.f;
    PIN(negm);
#pragma unroll
    for (int k = 0; k < 4; ++k)
#pragma unroll
        for (int i = 0; i < 16; ++i) o[k][i] = 0.f;
    f32x16 pA0, pA1, pB0, pB1; bf16x8_t kf[8]; s16x4_t vlo[16], vhi[16]; v4u pw0, pw1, pw2, pw3;
    int sl_prev = 0, sl_cur = 0, sl_next = AT_SLOT;
#define ROT() do { sl_prev = sl_cur; sl_cur = sl_next; sl_next = (sl_next == 2 * AT_SLOT) ? 0 : sl_next + AT_SLOT; } while (0)
#define KLOAD(i, base) kf[i] = *(const LAS bf16x8_t*)((base) + ((i) >> 1) * 2048 + ((i) & 1) * 512)
#define EX(v) __builtin_amdgcn_exp2f(v)
#define RESC() do { if (resc) { _Pragma("unroll") for (int k_ = 0; k_ < 4; ++k_) _Pragma("unroll") for (int i_ = 0; i_ < 16; ++i_) o[k_][i_] *= alpha; } } while (0)
    WAIT_BAR(0);
    _Pragma("unroll") for (int i = 0; i < 8; ++i) KLOAD(i, kp0);
    pA0 = MFMA32(kf[0], qr[0], negm); pA1 = MFMA32(kf[1], qr[0], negm); pA0 = MFMA32(kf[2], qr[1], pA0); pA1 = MFMA32(kf[3], qr[1], pA1);
    pA0 = MFMA32(kf[4], qr[2], pA0); pA1 = MFMA32(kf[5], qr[2], pA1); pA0 = MFMA32(kf[6], qr[3], pA0); pA1 = MFMA32(kf[7], qr[3], pA1);
#pragma unroll
    for (int i = 0; i < 16; ++i) { if (i >= 8) pA0[i] = -INFINITY; pA1[i] = -INFINITY; }
    { mref = at_rowmax(pA0, pA1);
#pragma unroll
      for (int i = 0; i < 16; ++i) { negm[i] = -mref; pA0[i] = EX(pA0[i] - mref); pA1[i] = EX(pA1[i] - mref); } }
    WAIT_BAR(0);
    DMA_K(3, 0); DMA_V(1, AT_SLOT); ROT();
    _Pragma("unroll") for (int i = 0; i < 8; ++i) KLOAD(i, kp0 + sl_cur);
    WAIT_BAR(3);
#define PKW(P, i) cvtpk(P[i], P[i + 1])
#define PAF(k) __builtin_bit_cast(bf16x8_t, pw##k)
#define VFR(j) __builtin_shufflevector(vlo[j], vhi[j], 0, 1, 2, 3, 4, 5, 6, 7)
#define VRD(j) do { vlo[j] = vtr(vp_ + (((j) & 3) * 4096 + ((j) >> 2) * 1024)); vhi[j] = vtr(vp_ + (((j) & 3) * 4096 + ((j) >> 2) * 1024 + 512)); } while (0)
#define KRD(G, i) do { if (G) { KLOAD(i, kp0 + sl_next); } } while (0)
#define GAPA(MF, a0, a1, a2, a3, W0, W1, PW) do { MF; sacc += a0; sacc += a1; sacc += a2; sacc += a3; W0; W1; PIN(PW); PIN(sacc); SBAR(); } while (0)
#define GAPB(MF, X, i) do { MF; X[i] = EX(X[i]); X[i + 1] = EX(X[i + 1]); PIN(X); SBAR(); } while (0)
#define GAPX(MF, R, X, i) do { MF; R = MX3(R, X[i], X[i + 1]); X[i] = EX(X[i]); X[i + 1] = EX(X[i + 1]); PIN(X); PIN(R); SBAR(); } while (0)
#define STEP(C0, C1, P0, P1, t, MASK, GK, GV, GL) do { SBAR(); \
    const LAS unsigned char* vp_ = vp0 + 2 * sl_prev; \
    float sacc = P0[0] + P0[1]; \
    if (GK) DMA_K((t) + 3, sl_cur);                                                                                      \
                    GAPA(C0 = MFMA32(kf[0], qr[0], negm), P0[2], P0[3], P0[4], P0[5],     pw0[0] = PKW(P0, 0),  pw0[1] = PKW(P0, 2),  pw0); \
    if (GV) DMA_V0((t) + 1, sl_next); \
                    GAPA(C1 = MFMA32(kf[1], qr[0], negm), P0[6], P0[7], P0[8], P0[9],     pw0[2] = PKW(P0, 4),  pw0[3] = PKW(P0, 6),  pw0); \
    if (GV) DMA_V1((t) + 1, sl_next); \
                    GAPA(C0 = MFMA32(kf[2], qr[1], C0),   P0[10], P0[11], P0[12], P0[13], pw1[0] = PKW(P0, 8),  pw1[1] = PKW(P0, 10), pw1); \
                    GAPA(C1 = MFMA32(kf[3], qr[1], C1),   P0[14], P0[15], P1[0], P1[1],   pw1[2] = PKW(P0, 12), pw1[3] = PKW(P0, 14), pw1); \
    VRD(0); SBAR(); GAPA(C0 = MFMA32(kf[4], qr[2], C0),   P1[2], P1[3], P1[4], P1[5],     pw2[0] = PKW(P1, 0),  pw2[1] = PKW(P1, 2),  pw2); \
    VRD(1); SBAR(); GAPA(C1 = MFMA32(kf[5], qr[2], C1),   P1[6], P1[7], P1[8], P1[9],     pw2[2] = PKW(P1, 4),  pw2[3] = PKW(P1, 6),  pw2); \
    VRD(2); SBAR(); GAPA(C0 = MFMA32(kf[6], qr[3], C0),   P1[10], P1[11], P1[12], P1[13], pw3[0] = PKW(P1, 8),  pw3[1] = PKW(P1, 10), pw3); \
    VRD(3); SBAR(); GAPA(C1 = MFMA32(kf[7], qr[3], C1),   P1[14], P1[15], 0.f, 0.f,       pw3[2] = PKW(P1, 12), pw3[3] = PKW(P1, 14), pw3); \
    l += sacc; \
    if (MASK) { int q_ = tq; asm volatile("" : "+v"(q_)); at_cmask(C0, C1, (t) - (NT - 4), q_, hh); }        \
      \
    float ra_ = C0[0], rb_ = C0[2]; \
    VRD(4);  KRD(GL, 0); SBAR();  GAPX(o[0] = MFMA32(VFR(0),  PAF(0), o[0]), ra_, C0, 0); \
    VRD(5);  SBAR();              GAPX(o[1] = MFMA32(VFR(1),  PAF(0), o[1]), rb_, C0, 2); \
    VRD(6);  KRD(GL, 1); SBAR();  GAPX(o[2] = MFMA32(VFR(2),  PAF(0), o[2]), ra_, C0, 4); \
    VRD(7);  SBAR();              GAPX(o[3] = MFMA32(VFR(3),  PAF(0), o[3]), rb_, C0, 6); \
    VRD(8);  KRD(GL, 2); SBAR();  GAPX(o[0] = MFMA32(VFR(4),  PAF(1), o[0]), ra_, C0, 8); \
    VRD(9);  SBAR();              GAPX(o[1] = MFMA32(VFR(5),  PAF(1), o[1]), rb_, C0, 10); \
    VRD(10); KRD(GL, 3); SBAR();  GAPX(o[2] = MFMA32(VFR(6),  PAF(1), o[2]), ra_, C0, 12); \
    VRD(11); SBAR();              GAPX(o[3] = MFMA32(VFR(7),  PAF(1), o[3]), rb_, C0, 14); \
    VRD(12); KRD(GL, 4); SBAR();  GAPX(o[0] = MFMA32(VFR(8),  PAF(2), o[0]), ra_, C1, 0); \
    VRD(13); SBAR();              GAPX(o[1] = MFMA32(VFR(9),  PAF(2), o[1]), rb_, C1, 2); \
    VRD(14); KRD(GL, 5); SBAR();  GAPX(o[2] = MFMA32(VFR(10), PAF(2), o[2]), ra_, C1, 4); \
    VRD(15); SBAR();              GAPX(o[3] = MFMA32(VFR(11), PAF(2), o[3]), rb_, C1, 6); \
             KRD(GL, 6); SBAR();  GAPX(o[0] = MFMA32(VFR(12), PAF(3), o[0]), ra_, C1, 8); \
                                  GAPX(o[1] = MFMA32(VFR(13), PAF(3), o[1]), rb_, C1, 10); \
             KRD(GL, 7); SBAR();  GAPX(o[2] = MFMA32(VFR(14), PAF(3), o[2]), ra_, C1, 12); \
                                  GAPX(o[3] = MFMA32(VFR(15), PAF(3), o[3]), rb_, C1, 14); \
    { const float rm = half_max(__builtin_elementwise_maximum(ra_, rb_));                                                 \
      if (__builtin_expect(__any(rm > AT_THR), 0)) { const float dl = fmaxf(rm, 0.f); mref += dl;                          \
          const float al_ = __builtin_amdgcn_exp2f(-dl), nm_ = -mref; l *= al_; \
          _Pragma("unroll") for (int i_ = 0; i_ < 16; ++i_) { float a_ = C0[i_], b_ = C1[i_], c_ = negm[i_];                \
              asm volatile("v_mul_f32 %0, %0, %3\n\tv_mul_f32 %1, %1, %3\n\tv_mov_b32 %2, %4" : "+v"(a_), "+v"(b_), "+v"(c_) : "v"(al_), "v"(nm_)); C0[i_] = a_; C1[i_] = b_; negm[i_] = c_; } \
          _Pragma("unroll") for (int k_ = 0; k_ < 4; ++k_) _Pragma("unroll") for (int i_ = 0; i_ < 16; ++i_) { float a_ = o[k_][i_]; asm volatile("v_mul_f32 %0, %0, %1" : "+v"(a_) : "v"(al_)); o[k_][i_] = a_; } } } \
    } while (0)
    int t = 1;
#pragma unroll 1
    do {
        STEP(pB0, pB1, pA0, pA1, t, (t >= NT - 4), true, true, true);         WAIT_BAR(3); ROT();
        STEP(pA0, pA1, pB0, pB1, t + 1, (t + 1 >= NT - 4), true, true, true); WAIT_BAR(3); ROT();
        t += 2;
    } while (t + 2 < NT);
    STEP(pB0, pB1, pA0, pA1, NT - 2, true, false, true, true); WAIT_BAR(0); ROT();
    STEP(pA0, pA1, pB0, pB1, NT - 1, true, false, false, false);
    { float sacc = pA0[0] + pA0[1];
#pragma unroll
      for (int i = 2; i < 16; ++i) sacc += pA0[i];
#pragma unroll
      for (int i = 0; i < 16; ++i) sacc += pA1[i];
      l += sacc;
      pw0 = (v4u){PKW(pA0, 0), PKW(pA0, 2), PKW(pA0, 4), PKW(pA0, 6)}; pw1 = (v4u){PKW(pA0, 8), PKW(pA0, 10), PKW(pA0, 12), PKW(pA0, 14)};
      pw2 = (v4u){PKW(pA1, 0), PKW(pA1, 2), PKW(pA1, 4), PKW(pA1, 6)}; pw3 = (v4u){PKW(pA1, 8), PKW(pA1, 10), PKW(pA1, 12), PKW(pA1, 14)};
      const LAS unsigned char* vp_ = vp0 + 2 * sl_cur;
#pragma unroll
      for (int ks = 0; ks < 4; ++ks)
#pragma unroll
          for (int k = 0; k < 4; ++k) { const s16x4_t lo = vtr(vp_ + k * 4096 + ks * 1024), hi = vtr(vp_ + k * 4096 + ks * 1024 + 512);
              const bf16x8_t vf = __builtin_shufflevector(lo, hi, 0, 1, 2, 3, 4, 5, 6, 7);
              o[k] = MFMA32(vf, ks == 0 ? PAF(0) : ks == 1 ? PAF(1) : ks == 2 ? PAF(2) : PAF(3), o[k]); } }
#undef DMA_K
#undef DMA_V
#undef DMA_V0
#undef DMA_V1
#undef ROT
#undef KLOAD
#undef EX
#undef RESC
#undef PKW
#undef PAF
#undef VFR
#undef VRD
#undef KRD
#undef GAPA
#undef GAPB
#undef GAPX
#undef STEP
    l += half_swap(l);
    const float linv = (MP == 1 ? lam : 1.f) / l;
    int lz_ = F.lane; asm volatile("" : "+v"(lz_));
    LAS v4u* st = (LAS v4u*)at_stage(F.lds, wave) + lz_;
#pragma unroll
    for (int q = 0; q < 8; ++q) { const int k = q >> 1, i0 = 8 * (q & 1);
        if constexpr (MP == 1) { v4u w; w.x = cvtpk(o[k][i0] * linv, o[k][i0 + 1] * linv); w.y = cvtpk(o[k][i0 + 2] * linv, o[k][i0 + 3] * linv);
            w.z = cvtpk(o[k][i0 + 4] * linv, o[k][i0 + 5] * linv); w.w = cvtpk(o[k][i0 + 6] * linv, o[k][i0 + 7] * linv); st[q * 64] = w; }
        else { const v4u w = st[q * 64];
#pragma unroll
            for (int j = 0; j < 4; ++j) { const unsigned u = w[j];
                o[k][i0 + 2 * j] = o[k][i0 + 2 * j] * linv - __builtin_bit_cast(float, u << 16); o[k][i0 + 2 * j + 1] = o[k][i0 + 2 * j + 1] * linv - __builtin_bit_cast(float, u & 0xffff0000u); } }
    }
}
template <int VAR>
__device__ __forceinline__ void attn_unit(Frame& F, int b, int h, int qb, float lam) {
    const int lane = F.lane, wave = F.wave;
    bf16* MIX = (bf16*)(F.ws + (VAR == 0 ? WS_MIX : WS_HN));
    f32x16 o[4];
    attn_pass<1, VAR>(F, o, b, h, qb, lam);
    attn_pass<0, VAR>(F, o, b, h, qb, lam);
    int lz = F.lane; asm volatile("" : "+v"(lz));
    const int r = lz & 31, hh = lz >> 5;
    float ss = 0.f;
#pragma unroll
    for (int k = 0; k < 4; ++k)
#pragma unroll
        for (int i = 0; i < 16; ++i) ss += o[k][i] * o[k][i];
    ss += half_swap(ss);
    const float rinv = rsqrtf(ss * (1.f / 128.f) + EPS) * (1.f - LAMBDA_INIT);
    LAS unsigned char* sg = at_stage(F.lds, wave);
    const float* __restrict__ gsub = F.subln + 4 * hh;
#pragma unroll
    for (int k = 0; k < 4; ++k)
#pragma unroll
        for (int g = 0; g < 4; ++g) { const f32x4 g4 = *(const f32x4*)(gsub + 32 * k + 8 * g); v2u w;
            w.x = cvtpk(o[k][4 * g] * rinv * g4[0], o[k][4 * g + 1] * rinv * g4[1]); w.y = cvtpk(o[k][4 * g + 2] * rinv * g4[2], o[k][4 * g + 3] * rinv * g4[3]);
            *(LAS v2u*)(sg + r * 256 + ((64 * k + 16 * g + 8 * hh) ^ ((r & 15) << 4))) = w; }
    bf16* __restrict__ obase = MIX + ((size_t)b * SEQ + 256 * qb + 32 * wave + (lz >> 4)) * 1024 + 128 * h + (lz & 15) * 8;
#pragma unroll
    for (int j = 0; j < 8; ++j) { const int row = 4 * j + (lz >> 4); const v4u x = *(const LAS v4u*)(sg + row * 256 + (((lz & 15) ^ (row & 15)) << 4)); *(v4u*)(obase + (size_t)(4 * j) * 1024) = x; }
}
template <int VAR>
__device__ __forceinline__ void p4_attention(Frame& F) {
    float lam;
    { float s01 = 0.f, s23 = 0.f; for (int i = 0; i < 64; ++i) { s01 += F.dlam[i] * F.dlam[64 + i]; s23 += F.dlam[128 + i] * F.dlam[192 + i]; } lam = __expf(s01) - __expf(s23) + LAMBDA_INIT; }
    for (int v = F.vcu; v < 256; v += F.G) {
        const int bh = v >> 2, j = v & 3;
#pragma unroll 1
        for (int u = 0; u < 4; ++u) { const int qb = u == 0 ? j : u == 1 ? 15 - j : u == 2 ? 7 - j : 8 + j; attn_unit<VAR>(F, bh >> 2, bh & 3, qb, lam); }
    }
}

__device__ __forceinline__ void p2_ret_kv(Frame& F) {
    const int lane = F.lane, r = lane & 31, hh = lane >> 5, wave = F.wave;
    const bf16* RK = (const bf16*)(F.ws + WS_RK); const bf16* RV = (const bf16*)(F.ws + WS_RV); float* KVC = (float*)(F.ws + WS_KVC);
    const int eblk = wave & 3, dblk = wave >> 2;
    const int trl = (8 * hh + ((lane & 15) >> 2)) * 64 + ((lane >> 4) & 1) * 32 + (lane & 3) * 8;
    int buf = 0; bool first = true;
    for (int u = F.vcu; u < 64 * 32; u += F.G) {
        const int bh = u >> 5, n = u & 31, b = bh >> 2, h = bh & 3;
        if (first) {
            const size_t row0 = (size_t)b * RROWS + 128 * n;
#pragma unroll
            for (int i = 0; i < 2; ++i) { const int p = 2 * wave + i; GLDS16R(RK + (row0 + 16 * (p & 7) + (lane >> 2)) * 256 + 64 * h + 32 * (p >> 3) + 8 * (lane & 3), F.lds + (p >> 3) * 8192 + (p & 7) * 1024); }
#pragma unroll
            for (int i = 0; i < 4; ++i) { const int p = 4 * wave + i; GLDS16R(RV + (row0 + 16 * (p & 7) + (lane >> 2)) * 512 + 128 * h + 32 * (p >> 3) + 8 * (lane & 3), F.lds + 16384 + (p >> 3) * 8192 + (p & 7) * 1024); }
            first = false;
        }
        asm volatile("s_waitcnt vmcnt(0) lgkmcnt(0)" ::: "memory"); __builtin_amdgcn_s_barrier(); asm volatile("" ::: "memory");
        const int un = u + F.G;
        if (un < 64 * 32) {
            const int bh2 = un >> 5, n2 = un & 31, b2 = bh2 >> 2, h2 = bh2 & 3; const size_t row0 = (size_t)b2 * RROWS + 128 * n2; LAS unsigned char* nb = F.lds + (buf ^ 1) * 49152;
#pragma unroll
            for (int i = 0; i < 2; ++i) { const int p = 2 * wave + i; GLDS16R(RK + (row0 + 16 * (p & 7) + (lane >> 2)) * 256 + 64 * h2 + 32 * (p >> 3) + 8 * (lane & 3), nb + (p >> 3) * 8192 + (p & 7) * 1024); }
#pragma unroll
            for (int i = 0; i < 4; ++i) { const int p = 4 * wave + i; GLDS16R(RV + (row0 + 16 * (p & 7) + (lane >> 2)) * 512 + 128 * h2 + 32 * (p >> 3) + 8 * (lane & 3), nb + 16384 + (p >> 3) * 8192 + (p & 7) * 1024); }
        }
        const LAS unsigned char* cb = F.lds + buf * 49152;
        const LAS unsigned char* ap = cb + 16384 + eblk * 8192 + trl; const LAS unsigned char* bp = cb + dblk * 8192 + trl;
        f32x16 acc;
#pragma unroll
        for (int i = 0; i < 16; ++i) acc[i] = 0.f;
#pragma unroll
        for (int s_ = 0; s_ < 8; ++s_) {
            const s16x4_t al = vtr(ap + s_ * 1024), ah = vtr(ap + s_ * 1024 + 256), bl = vtr(bp + s_ * 1024), bhh = vtr(bp + s_ * 1024 + 256);
            acc = MFMA32(__builtin_shufflevector(al, ah, 0, 1, 2, 3, 4, 5, 6, 7), __builtin_shufflevector(bl, bhh, 0, 1, 2, 3, 4, 5, 6, 7), acc);
        }
        float* dst = KVC + ((size_t)u * 128 + 32 * eblk + 4 * hh) * 64 + 32 * dblk + r;
#pragma unroll
        for (int i = 0; i < 16; ++i) dst[(size_t)((i & 3) + 8 * (i >> 2)) * 64] = acc[i];
        buf ^= 1;
    }
    asm volatile("s_waitcnt vmcnt(0) lgkmcnt(0)" ::: "memory"); __builtin_amdgcn_s_barrier(); asm volatile("" ::: "memory");
}
__device__ __forceinline__ void p3_ret_scan(Frame& F) {
    const float* KVC = (const float*)(F.ws + WS_KVC); bf16* ST = (bf16*)(F.ws + WS_ST);
    for (int gid = F.vcu * 512 + F.tid; gid < 64 * 2048; gid += F.G * 512) {
        const int bh = gid >> 11, i4 = gid & 2047, h = bh & 3;
        const float l2g = log2f(1.f - exp2f(-5.f - (float)h)); const float gam = exp2f(l2g), g127 = exp2f(127.f * l2g), g128 = exp2f(128.f * l2g);
        const f32x4* __restrict__ src = (const f32x4*)(KVC + (size_t)bh * 32 * 8192) + i4; v2u* __restrict__ dst = (v2u*)(ST + (size_t)bh * 32 * 8192) + i4;
        f32x4 st = {0.f, 0.f, 0.f, 0.f};
        f32x4 kvv[32];
#pragma unroll
        for (int n = 0; n < 32; ++n) kvv[n] = src[(size_t)n * 2048];
#pragma unroll
        for (int n = 0; n < 32; ++n) { const f32x4 kv = kvv[n]; st = st * g128 + kv * g127; const f32x4 o = st * gam;
            v2u w; w.x = cvtpk(o[0], o[1]); w.y = cvtpk(o[2], o[3]); dst[(size_t)n * 2048] = w; }
    }
}
__device__ __forceinline__ void p2_ret_state(Frame& F) {
    int lane = F.lane; asm volatile("" : "+v"(lane));
    const int r = lane & 31, hh = lane >> 5, wave = F.wave;
    const bf16* RK = (const bf16*)(F.ws + WS_RK); const bf16* RV = (const bf16*)(F.ws + WS_RV); bf16* ST = (bf16*)(F.ws + WS_ST);
    const int trl = (8 * hh + ((lane & 15) >> 2)) * 64 + ((lane >> 4) & 1) * 32 + (lane & 3) * 8;
    constexpr int RS_SLOT = 24576;
    for (int w = F.vcu; w < 256; w += F.G) {
        const int bh = w >> 2, q = w & 3, b = bh >> 2, h = bh & 3;
        const float g128 = exp2f(128.f * log2f(1.f - exp2f(-5.f - (float)h)));
#define RS_DMA(n_, s_) do { const int nn_ = (n_) < 32 ? (n_) : 31; const size_t row0_ = (size_t)b * RROWS + 128 * nn_; LAS unsigned char* sl_ = F.lds + (s_) * RS_SLOT; \
            _Pragma("unroll") for (int i_ = 0; i_ < 2; ++i_) { const int p_ = 2 * wave + i_; GLDS16R(RK + (row0_ + 16 * (p_ & 7) + (lane >> 2)) * 256 + 64 * h + 32 * (p_ >> 3) + 8 * (lane & 3), sl_ + (p_ >> 3) * 8192 + (p_ & 7) * 1024); } \
            GLDS16R(RV + (row0_ + 16 * wave + (lane >> 2)) * 512 + 128 * h + 32 * q + 8 * (lane & 3), sl_ + 16384 + wave * 1024); } while (0)
        asm volatile("s_waitcnt vmcnt(0) lgkmcnt(0)" ::: "memory"); __builtin_amdgcn_s_barrier(); asm volatile("" ::: "memory");
        RS_DMA(0, 0); RS_DMA(1, 1); RS_DMA(2, 2);
        f32x16 st;
#pragma unroll
        for (int i = 0; i < 16; ++i) st[i] = 0.f;
        bf16* dst = ST + ((size_t)bh * 32 * 128 + 32 * q + r) * 64 + 32 * wave + 4 * hh;
#pragma unroll 1
        for (int n = 0; n < 32; ++n) {
            if (wave < 2) { if (n == 0) asm volatile("s_waitcnt vmcnt(6)" ::: "memory"); else if (n == 1) asm volatile("s_waitcnt vmcnt(10)" ::: "memory");
                            else if (n == 2) asm volatile("s_waitcnt vmcnt(14)" ::: "memory"); else asm volatile("s_waitcnt vmcnt(18)" ::: "memory"); }
            else asm volatile("s_waitcnt vmcnt(6)" ::: "memory");
            asm volatile("s_waitcnt lgkmcnt(0)" ::: "memory"); __builtin_amdgcn_s_barrier(); asm volatile("" ::: "memory");
            RS_DMA(n + 3, (n + 3) & 3);
            if (wave < 2) {
                const LAS unsigned char* cb = F.lds + (n & 3) * RS_SLOT;
                const LAS unsigned char* ap = cb + 16384 + trl; const LAS unsigned char* bp = cb + wave * 8192 + trl;
#pragma unroll
                for (int s_ = 0; s_ < 8; ++s_) {
                    const s16x4_t al = vtr(ap + s_ * 1024), ah = vtr(ap + s_ * 1024 + 256), bl = vtr(bp + s_ * 1024), bhh = vtr(bp + s_ * 1024 + 256);
                    st = MFMA32(__builtin_shufflevector(bl, bhh, 0, 1, 2, 3, 4, 5, 6, 7), __builtin_shufflevector(al, ah, 0, 1, 2, 3, 4, 5, 6, 7), st);
                }
#pragma unroll
                for (int i = 0; i < 16; ++i) st[i] *= g128;
#pragma unroll
                for (int g = 0; g < 4; ++g) { v2u wv; wv.x = cvtpk(st[4 * g], st[4 * g + 1]); wv.y = cvtpk(st[4 * g + 2], st[4 * g + 3]); *(v2u*)(dst + (size_t)n * 8192 + 8 * g) = wv; }
            }
        }
#undef RS_DMA
    }
    asm volatile("s_waitcnt vmcnt(0) lgkmcnt(0)" ::: "memory"); __builtin_amdgcn_s_barrier(); asm volatile("" ::: "memory");
}
__device__ __forceinline__ void p4_ret_out(Frame& F) {
    int lane = F.lane; asm volatile("" : "+v"(lane));
    const int r = lane & 31, hh = lane >> 5, wave = F.wave, qw = wave & 3, eh = wave >> 2;
    const bf16* RQ = (const bf16*)(F.ws + WS_RQ); const bf16* RK = (const bf16*)(F.ws + WS_RK); const bf16* RV = (const bf16*)(F.ws + WS_RV); const bf16* RG = (const bf16*)(F.ws + WS_RG);
    const bf16* ST = (const bf16*)(F.ws + WS_ST); bf16* MIX = (bf16*)(F.ws + WS_MIX);
    LAS float* ssx = (LAS float*)(F.lds + 98304);
    const int NU = 64 * 32;
#define RO_DMA(u_, buf_) do { const int bh_ = (u_) >> 5, c_ = ((u_) & 31) + 1, b_ = bh_ >> 2, h_ = bh_ & 3; const size_t row0_ = (size_t)b_ * RROWS + 128 * c_; LAS unsigned char* kim_ = F.lds + (buf_) * 49152; \
        _Pragma("unroll") for (int i_ = 0; i_ < 2; ++i_) { const int p_ = 2 * wave + i_; GLDS16R(RK + (row0_ + 64 * (p_ & 1) + lane) * 256 + 64 * h_ + 8 * (p_ >> 1), kim_ + (p_ >> 1) * 2048 + (p_ & 1) * 1024); } \
        _Pragma("unroll") for (int i_ = 0; i_ < 4; ++i_) { const int p_ = 4 * wave + i_; GLDS16R(RV + (row0_ + 16 * (p_ & 7) + (lane >> 2)) * 512 + 128 * h_ + 32 * (p_ >> 3) + 8 * (lane & 3), kim_ + 16384 + (p_ >> 3) * 8192 + (p_ & 7) * 1024); } } while (0)
#define RO_REGS(u_, QF, SB, GV) do { const int bh_ = (u_) >> 5, c_ = ((u_) & 31) + 1, b_ = bh_ >> 2, h_ = bh_ & 3; const size_t tok_ = (size_t)b_ * SEQ + 128 * (c_ - 1) + 32 * qw + r; \
        _Pragma("unroll") for (int s_ = 0; s_ < 4; ++s_) QF[s_] = *(const bf16x8_t*)(RQ + tok_ * 256 + 64 * h_ + 16 * s_ + 8 * hh); \
        const bf16* sp_ = ST + ((size_t)(bh_ * 32 + (c_ - 1)) * 128 + 64 * eh + r) * 64 + 8 * hh; \
        _Pragma("unroll") for (int k_ = 0; k_ < 2; ++k_) _Pragma("unroll") for (int s_ = 0; s_ < 4; ++s_) SB[k_][s_] = *(const bf16x8_t*)(sp_ + (size_t)k_ * 32 * 64 + 16 * s_); \
        const bf16* gp_ = RG + tok_ * 512 + 128 * h_ + 64 * eh + 8 * hh; \
        _Pragma("unroll") for (int k_ = 0; k_ < 2; ++k_) _Pragma("unroll") for (int g_ = 0; g_ < 2; ++g_) GV[k_][g_] = *(const v4u*)(gp_ + 32 * k_ + 16 * g_); } while (0)
    bf16x8_t qf[4], sb[2][4], nqf[4], nsb[2][4]; v4u gv[2][2], ngv[2][2];
    int u = F.vcu;
    if (u < NU) { RO_REGS(u, qf, sb, gv); RO_DMA(u, 0); }
    int buf = 0;
    for (; u < NU; u += F.G) {
        asm volatile("s_waitcnt vmcnt(0) lgkmcnt(0)" ::: "memory"); __builtin_amdgcn_s_barrier(); asm volatile("" ::: "memory");
        const int un = u + F.G;
        f32x16 y[2];
#pragma unroll
        for (int k = 0; k < 2; ++k)
#pragma unroll
            for (int i = 0; i < 16; ++i) y[k][i] = 0.f;
#pragma unroll
        for (int s_ = 0; s_ < 4; ++s_)
#pragma unroll
            for (int k = 0; k < 2; ++k) y[k] = MFMA32(sb[k][s_], qf[s_], y[k]);
        if (un < NU) { RO_REGS(un, nqf, nsb, ngv); RO_DMA(un, buf ^ 1); }
        const int bh = u >> 5, c = (u & 31) + 1, b = bh >> 2, h = bh & 3;
        const LAS unsigned char* kimg = F.lds + buf * 49152; const LAS unsigned char* vimg = kimg + 16384;
        const LAS unsigned char* kfb = kimg + hh * 2048 + r * 16;
        const LAS unsigned char* vfb = vimg + (2 * eh) * 8192 + (4 * hh + ((lane & 15) >> 2)) * 64 + ((lane >> 4) & 1) * 32 + (lane & 3) * 8;
#pragma unroll 1
        for (int kvb = 0; kvb <= qw; ++kvb) {
            f32x16 p;
#pragma unroll
            for (int i = 0; i < 16; ++i) p[i] = 0.f;
#pragma unroll
            for (int s_ = 0; s_ < 4; ++s_) { const bf16x8_t kf = *(const LAS bf16x8_t*)(kfb + s_ * 4096 + kvb * 512); p = MFMA32(kf, qf[s_], p); }
            if (kvb == qw) {
#pragma unroll
                for (int i = 0; i < 16; ++i) if (crow(i, hh) > r) p[i] = 0.f;
            }
            const bf16x8_t pa0 = pack8(p, 0), pa1 = pack8(p, 8);
#pragma unroll
            for (int k = 0; k < 2; ++k) {
                const LAS unsigned char* vp = vfb + k * 8192 + kvb * 2048;
                const s16x4_t l0 = vtr(vp), h0 = vtr(vp + 512), l1 = vtr(vp + 1024), h1 = vtr(vp + 1536);
                y[k] = MFMA32(__builtin_shufflevector(l0, h0, 0, 1, 2, 3, 4, 5, 6, 7), pa0, y[k]);
                y[k] = MFMA32(__builtin_shufflevector(l1, h1, 0, 1, 2, 3, 4, 5, 6, 7), pa1, y[k]);
            }
        }
        float ss = 0.f;
#pragma unroll
        for (int k = 0; k < 2; ++k)
#pragma unroll
            for (int i = 0; i < 16; ++i) ss += y[k][i] * y[k][i];
        ss += half_swap(ss);
        if (hh == 0) ssx[wave * 32 + r] = ss;
        asm volatile("s_waitcnt lgkmcnt(0)" ::: "memory"); __builtin_amdgcn_s_barrier(); asm volatile("" ::: "memory");
        const float rinv = rsqrtf((ss + ssx[(wave ^ 4) * 32 + r]) * (1.f / 128.f) + EPS);
        bf16* __restrict__ orow = MIX + ((size_t)b * SEQ + 128 * (c - 1) + 32 * qw + r) * 1024 + 512 + 128 * h + 64 * eh + 8 * hh;
#pragma unroll
        for (int k = 0; k < 2; ++k)
#pragma unroll
            for (int gp = 0; gp < 2; ++gp) {
                unsigned ga0 = gv[k][gp].x, ga1 = gv[k][gp].y, gb0 = gv[k][gp].z, gb1 = gv[k][gp].w;
                swap32(ga0, gb0); swap32(ga1, gb1);
                v2u wq[2];
#pragma unroll
                for (int gg = 0; gg < 2; ++gg) { const int g = 2 * gp + gg; float o4[4];
#pragma unroll
                    for (int j = 0; j < 4; ++j) { const unsigned gw_ = gg == 0 ? (j < 2 ? ga0 : ga1) : (j < 2 ? gb0 : gb1); const float gt = __builtin_bit_cast(float, (j & 1) ? (gw_ & 0xffff0000u) : (gw_ << 16));
                        const float sg = gt * __builtin_amdgcn_rcpf(1.f + __builtin_amdgcn_exp2f(-1.4426950408889634f * gt)); o4[j] = y[k][4 * g + j] * rinv * sg; }
                    wq[gg].x = cvtpk(o4[0], o4[1]); wq[gg].y = cvtpk(o4[2], o4[3]); }
                unsigned a0 = wq[0].x, a1 = wq[0].y, b0 = wq[1].x, b1 = wq[1].y;
                swap32(a0, b0); swap32(a1, b1);
                v4u w; w.x = a0; w.y = a1; w.z = b0; w.w = b1;
                *(v4u*)(orow + 32 * k + 16 * gp) = w; }
#pragma unroll
        for (int s_ = 0; s_ < 4; ++s_) { qf[s_] = nqf[s_]; sb[0][s_] = nsb[0][s_]; sb[1][s_] = nsb[1][s_]; }
#pragma unroll
        for (int k = 0; k < 2; ++k)
#pragma unroll
            for (int g = 0; g < 2; ++g) gv[k][g] = ngv[k][g];
        buf ^= 1;
    }
#undef RO_DMA
#undef RO_REGS
    asm volatile("s_waitcnt vmcnt(0) lgkmcnt(0)" ::: "memory"); __builtin_amdgcn_s_barrier(); asm volatile("" ::: "memory");
}

struct EpiOutProj {
    static constexpr bool PERM = true;
    const float* __restrict__ x; bf16* __restrict__ h1;
    __device__ __forceinline__ void prefetch(const pg8::Unit&, LAS unsigned char*, int, int) const {}
    __device__ __forceinline__ void operator()(const pg8::f32x4 (&acc)[2][2][4][2], const pg8::Unit& u, int wr, int wc, int fr, int fq, const LAS unsigned char* tab) const {
        const int row0 = u.pm * 256 + wr * 64 + fr, col0 = u.pn * 256 + wc * 32 + 8 * fq;
#pragma unroll
        for (int ai = 0; ai < 2; ++ai) {
            pg8::f32x4 xr[4][2][2];
#pragma unroll
            for (int m = 0; m < 4; ++m) { const size_t off = (size_t)(row0 + ai * 128 + m * 16) * D + col0;
#pragma unroll
                for (int bj = 0; bj < 2; ++bj)
#pragma unroll
                    for (int n = 0; n < 2; ++n) xr[m][bj][n] = *(const pg8::f32x4*)(x + off + bj * 128 + n * 4); }
#pragma unroll
            for (int m = 0; m < 4; ++m) { const size_t off = (size_t)(row0 + ai * 128 + m * 16) * D + col0;
#pragma unroll
                for (int bj = 0; bj < 2; ++bj) { const pg8::f32x4 v0 = xr[m][bj][0] + acc[ai][bj][m][0], v1 = xr[m][bj][1] + acc[ai][bj][m][1]; pg8::u32x4 w;
                    w.x = pg8::cvt_pk_bf16(v0[0], v0[1]); w.y = pg8::cvt_pk_bf16(v0[2], v0[3]); w.z = pg8::cvt_pk_bf16(v1[0], v1[1]); w.w = pg8::cvt_pk_bf16(v1[2], v1[3]);
                    *(pg8::u32x4*)(h1 + off + bj * 128) = w; } }
        }
    }
};

typedef float f32x16 __attribute__((ext_vector_type(16)));
typedef short s16x8 __attribute__((ext_vector_type(8)));
__device__ __forceinline__ void p6_router(Frame& F) {
    LAS int* hist = (LAS int*)(F.lds + RING_BYTES + 512);
    LAS unsigned char* xbw = F.lds + F.wave * 16384;
    LAS float* wl = (LAS float*)xbw;
    LAS float* rsb = wl + 32 * 36;
    const bf16* h1 = (const bf16*)(F.ws + WS_H1); bf16* XN2 = (bf16*)(F.ws + WS_XN2); const bf16* wrf = (const bf16*)(F.ws + WS_WRF);
    int* TOPE = (int*)(F.ws + WS_TOPE); float* TOPG = (float*)(F.ws + WS_TOPG); int* RANK = (int*)(F.ws + WS_RANK); float* RSTD = (float*)(F.ws + WS_RSTD);
    const int r = F.lane & 31, hi = F.lane >> 5;
    LAS float* gsh = (LAS float*)(F.lds + RING_BYTES + 1024);
    for (int i = F.tid; i < D; i += NWAVES * 64) gsh[i] = F.ffn_g[i];
    const LAS float* gl = gsh + 8 * hi;
    const int l4 = F.lane >> 4, l15 = F.lane & 15;
    for (int c = F.vcu; c < T / 256; c += F.G) {
        if (F.tid < NE) hist[F.tid] = 0;
        __syncthreads();
        const int row0 = c * 256 + F.wave * 32;
        const bf16* __restrict__ wrfp = wrf + (size_t)F.lane * 8;
        const bf16* xbase = h1 + (size_t)row0 * D;
        unsigned char* xo8 = (unsigned char*)XN2 + (size_t)row0 * D;
#define RT_DMA(cc, bufo) do { _Pragma("unroll") for (int i_ = 0; i_ < 8; ++i_) { const unsigned vo_ = (unsigned)l4 * (D * 2) + (unsigned)((l15 ^ ((4 * i_ + l4) & 15)) << 4); \
            glds16_sbase(xbase + (size_t)(4 * i_) * D + (cc) * 128, vo_, xbw + (bufo) + i_ * 1024); } } while (0)
        f32x16 acc;
#pragma unroll
        for (int i = 0; i < 16; ++i) acc[i] = 0.f;
        float ss = 0.f;
        const unsigned rdo = (unsigned)((r >> 2) * 1024 + ((r & 3) << 8)), rsw = (unsigned)(r & 15);
        v4u wa[8], wb[8];
#define RT_LOADW(W, s0) do { _Pragma("unroll") for (int q_ = 0; q_ < 4; ++q_) { \
            W[2 * q_] = *(const v4u*)(wrfp + (size_t)((s0) + q_) * 512); W[2 * q_ + 1] = *(const v4u*)(wrfp + (size_t)(4096 + ((s0) + q_) * 64) * 8); } } while (0)
#define RT_STEP(W, s0, xbuf) do { _Pragma("unroll") for (int q_ = 0; q_ < 4; ++q_) { const int sl_ = ((s0) + q_) & 7; \
            const v4u xw = *(const LAS v4u*)((xbuf) + rdo + (((unsigned)(2 * sl_ + hi) ^ rsw) << 4)); \
            const f32x4 x0 = {__builtin_bit_cast(float, xw.x << 16), __builtin_bit_cast(float, xw.x & 0xffff0000u), __builtin_bit_cast(float, xw.y << 16), __builtin_bit_cast(float, xw.y & 0xffff0000u)}; \
            const f32x4 x1 = {__builtin_bit_cast(float, xw.z << 16), __builtin_bit_cast(float, xw.z & 0xffff0000u), __builtin_bit_cast(float, xw.w << 16), __builtin_bit_cast(float, xw.w & 0xffff0000u)}; \
            ss += (x0[0] * x0[0] + x0[1] * x0[1]) + (x0[2] * x0[2] + x0[3] * x0[3]) + (x1[0] * x1[0] + x1[1] * x1[1]) + (x1[2] * x1[2] + x1[3] * x1[3]); \
            const f32x4 y0 = x0 * *(const LAS f32x4*)(gl + 16 * ((s0) + q_)), y1 = x1 * *(const LAS f32x4*)(gl + 16 * ((s0) + q_) + 4); v4u ah, al; \
            ah.x = pg8::cvt_pk_bf16(y0[0], y0[1]); ah.y = pg8::cvt_pk_bf16(y0[2], y0[3]); ah.z = pg8::cvt_pk_bf16(y1[0], y1[1]); ah.w = pg8::cvt_pk_bf16(y1[2], y1[3]); \
            al.x = pg8::cvt_pk_bf16(y0[0] - __builtin_bit_cast(float, ah.x << 16), y0[1] - __builtin_bit_cast(float, ah.x & 0xffff0000u)); \
            al.y = pg8::cvt_pk_bf16(y0[2] - __builtin_bit_cast(float, ah.y << 16), y0[3] - __builtin_bit_cast(float, ah.y & 0xffff0000u)); \
            al.z = pg8::cvt_pk_bf16(y1[0] - __builtin_bit_cast(float, ah.z << 16), y1[1] - __builtin_bit_cast(float, ah.z & 0xffff0000u)); \
            al.w = pg8::cvt_pk_bf16(y1[2] - __builtin_bit_cast(float, ah.w << 16), y1[3] - __builtin_bit_cast(float, ah.w & 0xffff0000u)); \
            const s16x8 Ah = __builtin_bit_cast(s16x8, ah), Al = __builtin_bit_cast(s16x8, al), Bh = __builtin_bit_cast(s16x8, W[2 * q_]), Bl = __builtin_bit_cast(s16x8, W[2 * q_ + 1]); \
            acc = __builtin_amdgcn_mfma_f32_32x32x16_bf16(Ah, Bh, acc, 0, 0, 0); acc = __builtin_amdgcn_mfma_f32_32x32x16_bf16(Al, Bh, acc, 0, 0, 0); acc = __builtin_amdgcn_mfma_f32_32x32x16_bf16(Ah, Bl, acc, 0, 0, 0); } } while (0)
#define RT_FP8(cc, xbuf) do { _Pragma("unroll") for (int i_ = 0; i_ < 8; ++i_) { const int row_ = 4 * i_ + l4, p_ = l15 ^ (row_ & 15); \
            const v4u xw = *(const LAS v4u*)((xbuf) + i_ * 1024 + F.lane * 16); const LAS float* g_ = gsh + (cc) * 128 + p_ * 8; const f32x4 g0 = *(const LAS f32x4*)g_, g1 = *(const LAS f32x4*)(g_ + 4); \
            v2u x8; x8.x = pk_fp8x4(__builtin_bit_cast(float, xw.x << 16) * g0[0], __builtin_bit_cast(float, xw.x & 0xffff0000u) * g0[1], __builtin_bit_cast(float, xw.y << 16) * g0[2], __builtin_bit_cast(float, xw.y & 0xffff0000u) * g0[3]); \
            x8.y = pk_fp8x4(__builtin_bit_cast(float, xw.z << 16) * g1[0], __builtin_bit_cast(float, xw.z & 0xffff0000u) * g1[1], __builtin_bit_cast(float, xw.w << 16) * g1[2], __builtin_bit_cast(float, xw.w & 0xffff0000u) * g1[3]); \
            *(v2u*)(xo8 + (size_t)row_ * D + (cc) * 128 + p_ * 8) = x8; } } while (0)
        asm volatile("s_waitcnt lgkmcnt(0)" ::: "memory");
        RT_DMA(0, 0);
        RT_LOADW(wa, 0);
#pragma unroll 1
        for (int cc = 0; cc < 8; ++cc) {
            const unsigned bo = (unsigned)(cc & 1) * 8192u;
            if (cc + 1 < 8) { RT_DMA(cc + 1, 8192u - bo); asm volatile("s_waitcnt vmcnt(8)" ::: "memory"); }
            else asm volatile("s_waitcnt vmcnt(0)" ::: "memory");
            const LAS unsigned char* xbuf = xbw + bo;
            RT_FP8(cc, xbuf);
            RT_LOADW(wb, 8 * cc + 4);
            RT_STEP(wa, 8 * cc, xbuf);
            if (cc + 1 < 8) { RT_LOADW(wa, 8 * cc + 8); }
            RT_STEP(wb, 8 * cc + 4, xbuf);
            asm volatile("s_waitcnt lgkmcnt(0)" ::: "memory");
        }
#undef RT_DMA
#undef RT_LOADW
#undef RT_STEP
#undef RT_FP8
        ss += __shfl_xor(ss, 32);
        const float rstd = rsqrtf(ss * (1.f / D) + EPS);
        if (hi == 0) { rsb[r] = rstd; RSTD[row0 + r] = rstd; }
        LDS_WAIT(); asm volatile("" ::: "memory");
        const float bias = F.b_router[r];
#pragma unroll
        for (int i = 0; i < 16; ++i) { const int row = (i & 3) + 8 * (i >> 2) + 4 * hi; wl[row * 36 + r] = acc[i] * rsb[row] + bias; }
        LDS_WAIT(); asm volatile("" ::: "memory");
        if (hi == 0) {
            float v0 = -INFINITY, v1 = -INFINITY, v2 = -INFINITY, v3 = -INFINITY; int i0 = 0, i1 = 0, i2 = 0, i3 = 0;
#pragma unroll
            for (int q = 0; q < 8; ++q) { const f32x4 lv = *(const LAS f32x4*)(wl + r * 36 + 4 * q);
#pragma unroll
                for (int jj = 0; jj < 4; ++jj) { const float xv = lv[jj]; const int e = 4 * q + jj;
                    if (xv > v3) {
                        if (xv > v0) { v3 = v2; i3 = i2; v2 = v1; i2 = i1; v1 = v0; i1 = i0; v0 = xv; i0 = e; }
                        else if (xv > v1) { v3 = v2; i3 = i2; v2 = v1; i2 = i1; v1 = xv; i1 = e; }
                        else if (xv > v2) { v3 = v2; i3 = i2; v2 = xv; i2 = e; }
                        else { v3 = xv; i3 = e; }
                    } } }
            const float e1 = __expf(v1 - v0), e2 = __expf(v2 - v0), e3 = __expf(v3 - v0); const float inv = 1.f / (1.f + e1 + e2 + e3);
            const int tok = row0 + r;
            *(int4*)(TOPE + tok * 4) = make_int4(i0, i1, i2, i3);
            *(float4*)(TOPG + tok * 4) = make_float4(inv, e1 * inv, e2 * inv, e3 * inv);
            const int r0 = __hip_atomic_fetch_add(&hist[i0], 1, __ATOMIC_RELAXED, __HIP_MEMORY_SCOPE_WORKGROUP), r1 = __hip_atomic_fetch_add(&hist[i1], 1, __ATOMIC_RELAXED, __HIP_MEMORY_SCOPE_WORKGROUP),
                      r2 = __hip_atomic_fetch_add(&hist[i2], 1, __ATOMIC_RELAXED, __HIP_MEMORY_SCOPE_WORKGROUP), r3 = __hip_atomic_fetch_add(&hist[i3], 1, __ATOMIC_RELAXED, __HIP_MEMORY_SCOPE_WORKGROUP);
            *(int4*)(RANK + tok * 4) = make_int4(r0, r1, r2, r3);
        }
        __syncthreads();
        if (F.tid < NE) hist[NE + F.tid] = (int)__hip_atomic_fetch_add((unsigned*)(F.ws + WS_CTL) + CW_GCNT + 64 * F.tid, (unsigned)hist[F.tid], __ATOMIC_RELAXED, __HIP_MEMORY_SCOPE_AGENT);
        __syncthreads();
        { int* RT = (int*)(F.ws + WS_ROWTOK_S); float* RR = (float*)(F.ws + WS_ROWRSTD_S); float* RGt = (float*)(F.ws + WS_ROWGATE_S);
          const int tok = c * 256 + (F.tid >> 1); const float rs = RSTD[tok];
#pragma unroll
          for (int kk = 0; kk < 2; ++kk) { const int k = (F.tid & 1) * 2 + kk; const int e = TOPE[tok * 4 + k]; const int dst = e * CAP + hist[NE + e] + RANK[tok * 4 + k];
              RT[dst] = tok * 4 + k; RR[dst] = rs; RGt[dst] = TOPG[tok * 4 + k]; } }
        __syncthreads();
    }
}

struct MoeOrder {
    const LAS int* te; const int* rowtok; int npn, G, c, Kb;
    __device__ __forceinline__ bool next(int i, pg8::Unit& u) const {
        const int L = i * G + c; const int nt = __builtin_amdgcn_readfirstlane(te[NTILES_MAX]);
        if (L >= nt * npn) return false;
        u.pm = L / npn; u.pn = L - u.pm * npn; u.e = __builtin_amdgcn_readfirstlane(te[u.pm]); u.sb = __builtin_amdgcn_readfirstlane(te[NTILES_MAX + 8 + u.pm]); return true;
    }
    __device__ __forceinline__ unsigned rowoff(const pg8::Unit& u, int r) const { const int v = rowtok[u.sb + r]; return (unsigned)(v < 0 ? 0 : (v >> 2)) * (unsigned)Kb; }
};
__device__ __forceinline__ void moe_tile_table(Frame& F) {
    LAS int* te = (LAS int*)(F.lds + TILE_E_OFF); LAS int* ts = te + NTILES_MAX + 8; LAS int* tb = (LAS int*)F.lds;
    const unsigned* gc = (const unsigned*)(F.ws + WS_CTL) + CW_GCNT;
    __syncthreads();
    if (F.tid == 0) { int p = 0; for (int e = 0; e < NE; ++e) { tb[e] = p; p += ((int)gc[64 * e] + 255) >> 8; } tb[NE] = p; te[NTILES_MAX] = p; }
    __syncthreads();
    for (int i = F.tid; i < NTILES_MAX; i += NWAVES * 64) { int e = 0;
#pragma unroll 1
        for (int q = 1; q < NE; ++q) e += (tb[q] <= i) ? 1 : 0;
        const bool ok = i < tb[NE]; te[i] = ok ? e : 0; ts[i] = ok ? e * CAP + 256 * (i - tb[e]) : 0; }
    __syncthreads();
}
__device__ __forceinline__ void swap16(unsigned& a, unsigned& b) { asm volatile("s_nop 1\n\tv_permlane16_swap_b32 %0, %1\n\ts_nop 1" : "+v"(a), "+v"(b)); }
#define SWAP16(A, B) do { unsigned a_ = (A), b_ = (B); swap16(a_, b_); (A) = a_; (B) = b_; } while (0)
struct EpiUp {
    static constexpr bool PERM = true;
    const float* __restrict__ bup; unsigned char* __restrict__ HB; const float* __restrict__ rowrstd;
    __device__ __forceinline__ void prefetch(const pg8::Unit& u, LAS unsigned char* tab, int wid, int lane) const {
        if (wid == 0) GLDS16R(bup + (size_t)u.e * 2048 + 256 * u.pn + 4 * lane, tab);
        else if (wid == 2) GLDS16R(rowrstd + (size_t)u.sb + 4 * lane, tab + 2048);
    }
    __device__ __forceinline__ void operator()(const pg8::f32x4 (&acc)[2][2][4][2], const pg8::Unit& u, int wr, int wc, int fr, int fq, const LAS unsigned char* tab) const {
        const int j0 = 128 * u.pn + 32 * wc + 8 * fq;
        const LAS float* tb = (const LAS float*)tab + 2 * (32 * wc + 8 * fq);
        pg8::f32x4 b4[4];
#pragma unroll
        for (int q = 0; q < 4; ++q) b4[q] = ((const LAS pg8::f32x4*)tb)[q];
        float rs8[2][4];
#pragma unroll
        for (int ai = 0; ai < 2; ++ai)
#pragma unroll
            for (int m = 0; m < 4; ++m) rs8[ai][m] = ((const LAS float*)(tab + 2048))[ai * 128 + wr * 64 + m * 16 + fr];
#pragma unroll
        for (int ai = 0; ai < 2; ++ai)
#pragma unroll
            for (int mp = 0; mp < 4; mp += 2) {
                v2u w2[2];
#pragma unroll
                for (int mm = 0; mm < 2; ++mm) { const int m = mp + mm; const float rsd = rs8[ai][m] * WDESCALE;
                    float o[8];
#pragma unroll
                    for (int n = 0; n < 2; ++n)
#pragma unroll
                        for (int i = 0; i < 4; ++i) {
                            float glu = acc[ai][0][m][n][i] * rsd + b4[2 * n + (i >> 1)][2 * (i & 1)], lin = acc[ai][1][m][n][i] * rsd + b4[2 * n + (i >> 1)][2 * (i & 1) + 1];
                            glu = fminf(glu, 7.f); lin = fminf(fmaxf(lin, -7.f), 7.f);
                            const float sg = __builtin_amdgcn_rcpf(1.f + __builtin_amdgcn_exp2f(-1.702f * 1.4426950408889634f * glu));
                            o[4 * n + i] = glu * sg * (lin + 1.f);
                        }
                    w2[mm].x = pk_fp8x4(o[0], o[1], o[2], o[3]); w2[mm].y = pk_fp8x4(o[4], o[5], o[6], o[7]); }
                SWAP16(w2[0].x, w2[1].x); SWAP16(w2[0].y, w2[1].y);
                const size_t row = (size_t)u.pm * 256 + ai * 128 + wr * 64 + (mp + (fq & 1)) * 16 + fr;
                v4u w; w.x = w2[0].x; w.y = w2[0].y; w.z = w2[1].x; w.w = w2[1].y;
                *(v4u*)(HB + row * D + j0 - 8 * (fq & 1)) = w;
            }
    }
};
struct EpiDown {
    static constexpr bool PERM = true;
    const int* __restrict__ rowtok; const float* __restrict__ rowgate; const float* __restrict__ bdn; unsigned char* __restrict__ ws;
    __device__ __forceinline__ void prefetch(const pg8::Unit& u, LAS unsigned char* tab, int wid, int lane) const {
        if (wid == 0) GLDS16R(bdn + (size_t)u.e * D + 256 * u.pn + 4 * lane, tab);
        else if (wid == 1) GLDS16R(rowtok + (size_t)u.sb + 4 * lane, tab + 1024);
        else if (wid == 2) GLDS16R(rowgate + (size_t)u.sb + 4 * lane, tab + 2048);
    }
    __device__ __forceinline__ void operator()(const pg8::f32x4 (&acc)[2][2][4][2], const pg8::Unit& u, int wr, int wc, int fr, int fq, const LAS unsigned char* tab) const {
        const int c0 = 256 * u.pn + 32 * wc + 8 * fq;
        const LAS float* bb = (const LAS float*)tab + 32 * wc + 8 * fq;
        pg8::f32x4 b4[2][2];
#pragma unroll
        for (int bj = 0; bj < 2; ++bj)
#pragma unroll
            for (int n = 0; n < 2; ++n) b4[bj][n] = *(const LAS pg8::f32x4*)(bb + 128 * bj + 4 * n);
        int tk8[2][4]; float gt8[2][4];
#pragma unroll
        for (int ai = 0; ai < 2; ++ai)
#pragma unroll
            for (int m = 0; m < 4; ++m) { tk8[ai][m] = ((const LAS int*)(tab + 1024))[ai * 128 + wr * 64 + m * 16 + fr]; gt8[ai][m] = ((const LAS float*)(tab + 2048))[ai * 128 + wr * 64 + m * 16 + fr]; }
#pragma unroll
        for (int ai = 0; ai < 2; ++ai)
#pragma unroll
            for (int m = 0; m < 4; ++m) {
                const int tk = tk8[ai][m];
                if (tk >= 0) {
                    const float gate = gt8[ai][m] * SLOT_SCALE; const float gsc = gate * WDESCALE; const int k = tk & 3;
                    const size_t soff = k == 0 ? WS_SLOT0 : (k == 1 ? WS_SLOT1 : (k == 2 ? WS_SLOT2 : WS_SLOT3));
                    unsigned char* p = (ws + soff) + (size_t)(tk >> 2) * D + c0;
                    v2u w2[2];
#pragma unroll
                    for (int bj = 0; bj < 2; ++bj) { const pg8::f32x4 v0 = acc[ai][bj][m][0] * gsc + b4[bj][0] * gate, v1 = acc[ai][bj][m][1] * gsc + b4[bj][1] * gate;
                        w2[bj].x = pk_fp8x4(v0[0], v0[1], v0[2], v0[3]); w2[bj].y = pk_fp8x4(v1[0], v1[1], v1[2], v1[3]); }
                    SWAP16(w2[0].x, w2[1].x); SWAP16(w2[0].y, w2[1].y);
                    v4u w; w.x = w2[0].x; w.y = w2[0].y; w.z = w2[1].x; w.w = w2[1].y;
                    *(v4u*)(p + 120 * (fq & 1)) = w;
                }
            }
    }
};
__device__ __forceinline__ void p10_final(Frame& F) {
    const int gw = F.vcu * NWAVES + F.wave, NGW = F.G * NWAVES;
    const unsigned char* s0 = F.ws + WS_SLOT0; const unsigned char* s1 = F.ws + WS_SLOT1; const unsigned char* s2 = F.ws + WS_SLOT2; const unsigned char* s3 = F.ws + WS_SLOT3;
    typedef float f32x2v __attribute__((ext_vector_type(2)));
#pragma unroll 2
    for (int m = gw; m < T; m += NGW) {
        const uint2* __restrict__ pin = (const uint2*)((const bf16*)(F.ws + WS_H1) + (size_t)m * D); float4* __restrict__ p = (float4*)(F.out + (size_t)m * D);
        float4 v[4]; float ss = 0.f;
#pragma unroll
        for (int q = 0; q < 4; ++q) { { const v2u hw_ = __builtin_nontemporal_load((const v2u*)pin + F.lane + 64 * q); const uint2 hw = make_uint2(hw_.x, hw_.y); v[q] = make_float4(__builtin_bit_cast(float, hw.x << 16), __builtin_bit_cast(float, hw.x & 0xffff0000u), __builtin_bit_cast(float, hw.y << 16), __builtin_bit_cast(float, hw.y & 0xffff0000u)); }
            const int z = __builtin_nontemporal_load((const int*)(s0 + (size_t)m * D) + F.lane + 64 * q), a = __builtin_nontemporal_load((const int*)(s1 + (size_t)m * D) + F.lane + 64 * q), b = __builtin_nontemporal_load((const int*)(s2 + (size_t)m * D) + F.lane + 64 * q), c = __builtin_nontemporal_load((const int*)(s3 + (size_t)m * D) + F.lane + 64 * q);
            const f32x2v zl = __builtin_amdgcn_cvt_pk_f32_fp8(z, false), zh = __builtin_amdgcn_cvt_pk_f32_fp8(z, true), al = __builtin_amdgcn_cvt_pk_f32_fp8(a, false), ah = __builtin_amdgcn_cvt_pk_f32_fp8(a, true);
            const f32x2v bl = __builtin_amdgcn_cvt_pk_f32_fp8(b, false), bh = __builtin_amdgcn_cvt_pk_f32_fp8(b, true), cl = __builtin_amdgcn_cvt_pk_f32_fp8(c, false), ch = __builtin_amdgcn_cvt_pk_f32_fp8(c, true);
            v[q].x += ((zl[0] + al[0]) + (bl[0] + cl[0])) * (1.f / SLOT_SCALE); v[q].y += ((zl[1] + al[1]) + (bl[1] + cl[1])) * (1.f / SLOT_SCALE);
            v[q].z += ((zh[0] + ah[0]) + (bh[0] + ch[0])) * (1.f / SLOT_SCALE); v[q].w += ((zh[1] + ah[1]) + (bh[1] + ch[1])) * (1.f / SLOT_SCALE);
            ss += v[q].x * v[q].x + v[q].y * v[q].y + v[q].z * v[q].z + v[q].w * v[q].w; }
        const float rs = rsqrtf(wave_sum(ss) * (1.f / D) + EPS);
#pragma unroll
        for (int q = 0; q < 4; ++q) { const float4 gg = ((const float4*)F.final_g)[F.lane + 64 * q]; { f32x4 ov = {v[q].x * rs * gg.x, v[q].y * rs * gg.y, v[q].z * rs * gg.z, v[q].w * rs * gg.w}; __builtin_nontemporal_store(ov, (f32x4*)p + F.lane + 64 * q); } }
    }
}

__global__ void __launch_bounds__(NWAVES * 64, 2) mk_fwd(Args args) {
    extern __shared__ __attribute__((aligned(16))) unsigned char lds[];
    Frame F;
    F.lds = (LAS unsigned char*)lds;
    F.tid = threadIdx.x; F.lane = F.tid & 63; F.wave = __builtin_amdgcn_readfirstlane(F.tid >> 6);
    F.G = gridDim.x; { const int bx = blockIdx.x; F.vcu = (F.G % 8 == 0) ? (bx % 8) * (F.G / 8) + bx / 8 : bx; }
    F.x = args.in[0]; F.meta = args.in[1]; F.attn_g = args.in[2]; F.w_in = args.in[3]; F.dlam = args.in[4]; F.subln = args.in[5]; F.w_out = args.in[6]; F.ffn_g = args.in[7];
    F.w_router = args.in[8]; F.b_router = args.in[9]; F.w_up = args.in[10]; F.b_up = args.in[11]; F.w_down = args.in[12]; F.b_down = args.in[13]; F.final_g = args.in[14];
    F.out = args.out; F.ws = args.ws;
    volatile LAS unsigned* MISC = (volatile LAS unsigned*)(F.lds + MISC_OFF);
    for (int u = F.tid; u < (TILE_E_OFF - LDSCTL_OFF) / 4; u += NWAVES * 64) ((LAS unsigned*)(F.lds + LDSCTL_OFF))[u] = 0u;
    __syncthreads();
    unsigned* ctl = (unsigned*)(F.ws + WS_CTL);
    XcdBarrier bar = xcd_barrier_post(ctl + CW_BAR + args.li * XCD_BAR_WORDS, MISC + 8);
    const int lo = args.ph_lo, hi = args.ph_hi;
#define IN(k) (lo <= (k) && (k) < hi)
#define BOTH(k) (IN(k) && IN((k) + 1))

    if (IN(0)) { p0_prologue(F); if (BOTH(0)) xcd_barrier(bar); }

    if (IN(1)) {
        pg8::Gemm g{(const bf16*)(F.ws + WS_HN), (const bf16*)(F.ws + WS_WIN), T, NPROJ, D, 0};
        pg8::StaticOrder S; S.init(T, NPROJ, F.G, (int)blockIdx.x);
        EpiInProj E{(bf16*)(F.ws + WS_DQ), (bf16*)(F.ws + WS_DK), (bf16*)(F.ws + WS_DV), (bf16*)(F.ws + WS_RQ), (bf16*)(F.ws + WS_RK), (bf16*)(F.ws + WS_RV), (bf16*)(F.ws + WS_RG),
                    (const float2*)(F.ws + WS_ROPE_D)};
        if (F.tid < 128) { const int par_ = F.tid >> 6, i_ = F.tid & 63;
            ((LAS float*)(F.lds + pg8::EPI_TAB_OFF + par_ * pg8::EPI_TAB_BYTES))[i_] = (i_ < 32 ? inv_freq_d(i_) : inv_freq_r(i_ - 32)) * 0.15915494309189535f; }
        __syncthreads();
        pg8::gemm_phase<EpiInProj, pg8::StaticOrder, true, false>(F.lds, g, S, E);
        if (BOTH(1)) xcd_barrier(bar);
    }

    if (IN(2)) { p2_ret_state(F); if (BOTH(2)) xcd_barrier(bar); }
    if (IN(4)) { p4_ret_out(F); p4_attention<0>(F); if (BOTH(4)) xcd_barrier(bar); }

    if (IN(5)) {
        pg8::Gemm g{(const bf16*)(F.ws + WS_MIX), (const bf16*)(F.ws + WS_WOUT), T, D, D, 0};
        pg8::StaticOrder S; S.init(T, D, F.G, (int)blockIdx.x);
        EpiOutProj E{F.x, (bf16*)(F.ws + WS_H1)};
        pg8::gemm_phase<EpiOutProj, pg8::StaticOrder, true, false>(F.lds, g, S, E);
        if (BOTH(5)) xcd_barrier(bar);
    }
    if (IN(6)) { p6_router(F); if (BOTH(6)) xcd_barrier(bar); }

    if (IN(8)) {
        moe_tile_table(F);
        pg8::Gemm g{(const bf16*)(F.ws + WS_XN2), (const bf16*)(F.ws + WS_WUP), NROWS_MAX, 2048, D / 2, (size_t)2048 * D};
        MoeOrder S{(const LAS int*)(F.lds + TILE_E_OFF), (const int*)(F.ws + WS_ROWTOK_S), 8, F.G, F.vcu, D};
        EpiUp E{F.b_up, (unsigned char*)(F.ws + WS_HB), (const float*)(F.ws + WS_ROWRSTD_S)};
        pg8::gemm_phase<EpiUp, MoeOrder, true, true, true>(F.lds, g, S, E);
        if (BOTH(8)) xcd_barrier(bar);
    }
    if (IN(9)) {
        moe_tile_table(F);
        pg8::Gemm g{(const bf16*)(F.ws + WS_HB), (const bf16*)(F.ws + WS_WDN), NROWS_MAX, D, D / 2, (size_t)D * D};
        MoeOrder S{(const LAS int*)(F.lds + TILE_E_OFF), (const int*)(F.ws + WS_ROWTOK_S), 4, F.G, F.vcu, D};
        EpiDown E{(const int*)(F.ws + WS_ROWTOK_S), (const float*)(F.ws + WS_ROWGATE_S), F.b_down, F.ws};
        pg8::gemm_phase<EpiDown, MoeOrder, true, false, true>(F.lds, g, S, E);
        if (BOTH(9)) xcd_barrier(bar);
    }
    if (IN(10)) { p10_final(F); }
#undef IN
#undef BOTH
}
static int g_grid = 0;
static void mk_launch(Args a, int lo, int hi, int li, hipStream_t stream) {
    a.ph_lo = lo; a.ph_hi = hi; a.li = li; a.pad = 0;
    hipLaunchKernelGGL(mk_fwd, dim3(g_grid), dim3(NWAVES * 64), LDS_BYTES, stream, a);
}
extern "C" void kernel_launch(void* const* d_in, const int* in_sizes, int n_in, void* d_out, int out_size, void* d_ws, size_t ws_size, hipStream_t stream) {
    float* out = (float*)d_out; unsigned char* ws = (unsigned char*)d_ws;
    if (g_grid == 0) {
        if (ws_size < WS_END) { fprintf(stderr, "kernel_launch: workspace too small (%zu < %zu)\n", ws_size, (size_t)WS_END); g_grid = -1; return; }
        int dev = 0, cus = 0;
        if (hipGetDevice(&dev) != hipSuccess || hipDeviceGetAttribute(&cus, hipDeviceAttributeMultiprocessorCount, dev) != hipSuccess) { g_grid = -1; return; }
        if (hipFuncSetAttribute((const void*)mk_fwd, hipFuncAttributeMaxDynamicSharedMemorySize, LDS_BYTES) != hipSuccess) { fprintf(stderr, "kernel_launch: hipFuncSetAttribute failed\n"); g_grid = -1; return; }
        int per_cu = 0;
        if (hipOccupancyMaxActiveBlocksPerMultiprocessor(&per_cu, (const void*)mk_fwd, NWAVES * 64, LDS_BYTES) != hipSuccess || per_cu < 1) fprintf(stderr, "kernel_launch: occupancy query says %d\n", per_cu);
        (void)hipGetLastError();
        g_grid = cus;
    }
    if (g_grid < 0) return;
    (void)hipMemsetAsync(ws + WS_CTL, 0, 1 * MiB, stream);
    Args a{};
    for (int i = 0; i < 15; ++i) a.in[i] = (const float*)d_in[i];
    a.out = out; a.ws = ws;
    mk_launch(a, 0, 11, 0, stream);
}
```

```cpp
#include <hip/hip_runtime.h>
#include <cstdint>
#include <cstdio>

typedef unsigned short bf16;
constexpr int D = 1024, NB = 16, SEQ = 4096, NMETA = 16, LTOT = SEQ + NMETA, T = NB * SEQ;
constexpr int NPROJ = 3072;
constexpr int KROWS = 64 + SEQ;
constexpr int RROWS = 128 + SEQ;
constexpr int NE = 32, TOPK = 4;
constexpr int NASSIGN = T * TOPK;
constexpr int NROWS_MAX = NASSIGN + NE * 256;
constexpr int NTILES_MAX = NROWS_MAX / 256;
constexpr float EPS = 1e-5f;
constexpr float C2 = 0.125f * 1.4426950408889634f;
constexpr float LAMBDA_INIT = 0.2f;
constexpr float SLOT_SCALE = 16.f;
constexpr float WSCALE = 32.f, WDESCALE = 1.f / 32.f;

constexpr size_t MiB = 1u << 20;
constexpr size_t WS_CTL = 0;
constexpr size_t WS_ROPE_D = 1 * MiB;
constexpr size_t WS_ROPE_R = 2 * MiB + 64 * 1024;
constexpr size_t WS_TOPE = 3 * MiB + 128 * 1024;
constexpr size_t WS_TOPG = 4 * MiB + 128 * 1024;
constexpr size_t WS_RANK = 5 * MiB + 128 * 1024;
constexpr size_t WS_ROWTOK = 6 * MiB + 128 * 1024;
constexpr size_t WS_MISC = 7 * MiB + 512 * 1024;
constexpr size_t WS_WDN = 8 * MiB;
constexpr size_t WS_WUP = 72 * MiB;
constexpr size_t WS_WIN = 200 * MiB;
constexpr size_t WS_WOUT = 206 * MiB;
constexpr size_t WS_HN = 208 * MiB;
constexpr size_t WS_XN2 = 208 * MiB;
constexpr size_t WS_HB = 336 * MiB;
constexpr size_t WS_DQ = 336 * MiB;
constexpr size_t WS_DK = 400 * MiB;
constexpr size_t WS_DV = 466 * MiB;
constexpr size_t WS_RQ = 532 * MiB;
constexpr size_t WS_RK = 564 * MiB;
constexpr size_t WS_RV = 598 * MiB;
constexpr size_t WS_RG = 664 * MiB;
constexpr size_t WS_KVC = 728 * MiB;
constexpr size_t WS_ST = 796 * MiB;
constexpr size_t WS_MIX = 864 * MiB;
constexpr size_t WS_SLOT0 = 600 * MiB, WS_SLOT1 = 72 * MiB, WS_SLOT2 = 208 * MiB, WS_SLOT3 = 864 * MiB;
constexpr size_t WS_WRF = 7 * MiB + 640 * 1024;
constexpr size_t WS_RSTD = 7 * MiB + 768 * 1024;
constexpr size_t WS_ROWRSTD = 992 * MiB;
constexpr size_t WS_ROWGATE = 994 * MiB;
constexpr size_t WS_H1 = 728 * MiB;
constexpr int CAP = 65536;
constexpr size_t WS_ROWTOK_S = 1000 * MiB;
constexpr size_t WS_ROWRSTD_S = 1008 * MiB;
constexpr size_t WS_ROWGATE_S = 1016 * MiB;
constexpr size_t WS_END = 1024 * MiB;


__device__ __forceinline__ unsigned f2bf(float f) { unsigned u = __builtin_bit_cast(unsigned, f); return (u + 0x7fffu + ((u >> 16) & 1u)) >> 16; }
__device__ __forceinline__ unsigned pk2(float lo, float hi) { return f2bf(lo) | (f2bf(hi) << 16); }
__device__ __forceinline__ float bf2f(bf16 h) { return __builtin_bit_cast(float, (unsigned)h << 16); }
__device__ __forceinline__ float wave_sum(float v) {
#pragma unroll
    for (int o = 1; o < 64; o <<= 1) v += __shfl_xor(v, o);
    return v;
}
namespace pg8 {
#define PG8_LAS __attribute__((address_space(3)))
typedef unsigned short bf16_t;
typedef short bf16x8 __attribute__((ext_vector_type(8)));
typedef float f32x4 __attribute__((ext_vector_type(4)));
typedef unsigned u32x4 __attribute__((ext_vector_type(4)));
typedef unsigned u32x2 __attribute__((ext_vector_type(2)));
constexpr int EPI_TAB_OFF = 138 * 1024, EPI_TAB_BYTES = 3072;
constexpr int BM = 256, BK = 64, HALF = 128, HTB = HALF * BK * 2  , STAGE_BYTES = 8 * HTB, NXCD = 8, WGM = 8;

__host__ __device__ __forceinline__ int lds_byte(int r, int c) { const int st = (r >> 4) * 2 + (c >> 5), rr = r & 15, cc = c & 31, ob = rr * 64 + cc * 2; return st * 1024 + (ob ^ (((ob >> 9) & 1) << 5)); }
__host__ __device__ __forceinline__ void stage_rc(int b, int& R, int& C) { const int st = b / 1024, sb = b % 1024, swz = sb ^ (((sb >> 9) & 1) << 5); R = (st >> 1) * 16 + swz / 64; C = (st & 1) * 32 + (swz % 64) / 2; }
__host__ __device__ __forceinline__ int perm32(int rho) { const int n = rho >> 4, i = rho & 15; return 8 * (i >> 2) + 4 * n + (i & 3); }

struct Unit { int pm, pn, e, sb; };
struct Gemm { const bf16_t* A; const bf16_t* Bt; int M, N, K; size_t estride; };

struct StaticOrder {
    int nM, nN, nwg, G, c;
    __host__ __device__ __forceinline__ void init(int M, int N, int G_, int c_) { nM = M / BM; nN = N / BM; nwg = nM * nN; G = G_; c = c_; }
    __host__ __device__ __forceinline__ bool next(int i, Unit& u) const {
        const long L = (long)i * G + c; if (L >= nwg) return false;
        int wgid = (int)L; { const int q = nwg / NXCD, r = nwg % NXCD, xcd = wgid % NXCD, off = wgid / NXCD; wgid = (xcd < r ? xcd * (q + 1) : r * (q + 1) + (xcd - r) * q) + off; }
        const int nig = WGM * nN, gid = wgid / nig, fm = gid * WGM, gsz = (nM - fm) < WGM ? (nM - fm) : WGM;
        u.pm = fm + ((wgid % nig) % gsz); u.pn = (wgid % nig) / gsz; u.e = 0; u.sb = 0; return true;
    }
    __device__ __forceinline__ unsigned rowoff(const Unit&, int) const { return 0u; }
};

__device__ __forceinline__ unsigned cvt_pk_bf16(float lo, float hi) { unsigned r; asm volatile("v_cvt_pk_bf16_f32 %0, %1, %2" : "=v"(r) : "v"(lo), "v"(hi)); return r; }

typedef int v8i_t __attribute__((ext_vector_type(8)));
typedef int v4i_t __attribute__((ext_vector_type(4)));
template <class Epi, class Sched, bool ALIGN_EPI, bool GATHER, bool FP8 = false>
__device__ __forceinline__ void gemm_phase(PG8_LAS unsigned char* lds, const Gemm g, const Sched& S, const Epi& E) {
    const int tid = threadIdx.x, wid = __builtin_amdgcn_readfirstlane(tid >> 6), lane = tid & 63, wr = wid >> 2, wc = wid & 3, fr = lane & 15, fq = lane >> 4;
    const int K = g.K, nt = K / BK;
    unsigned voffA[2], voffB[2];
#pragma unroll
    for (int i = 0; i < 2; ++i) { int R, C; stage_rc(tid * 16 + i * 8192, R, C); const int Rb = Epi::PERM ? ((R & ~31) + perm32(R & 31)) : R;
        voffA[i] = (unsigned)(R * K + C) * 2u; voffB[i] = (unsigned)(Rb * K + C) * 2u; }
    const size_t kstep = (size_t)(BK * 2);
    const size_t hstep = (size_t)HALF * K * 2;
    const size_t tstep = 2 * hstep;
    const unsigned ldsw = (unsigned)wid * 1024u;
    const int aoff = lds_byte(wr * 64 + fr, fq * 8), boff = lds_byte(wc * 32 + fr, fq * 8);
#define PG8_SA(b, h) (((b) * 2 + (h)) * HTB)
#define PG8_SB(b, h) ((4 + (b) * 2 + (h)) * HTB)
#define PG8_STAGE(bufoff, gbase, voff) do { _Pragma("unroll") for (int _i = 0; _i < 2; ++_i) \
        __builtin_amdgcn_global_load_lds((const unsigned*)((const char*)(gbase) + (voff)[_i]), (PG8_LAS unsigned*)(lds + (bufoff) + ldsw + _i * 8192), 16, 0, 0); } while (0)
#define PG8_STAGE_A(bufoff, gbase, h, V) do { if constexpr (GATHER) { PG8_STAGE(bufoff, gbase, V[h]); } else { PG8_STAGE(bufoff, (gbase) + (h) * hstep, voffA); } } while (0)
#define PG8_LDA(dst, b, h) do { _Pragma("unroll") for (int m = 0; m < 4; ++m) _Pragma("unroll") for (int k = 0; k < 2; ++k) dst[m][k] = *(const PG8_LAS bf16x8*)(lds + PG8_SA(b, h) + aoff + m * 2048 + k * 1024); } while (0)
#define PG8_LDB(dst, b, h) do { _Pragma("unroll") for (int n = 0; n < 2; ++n) _Pragma("unroll") for (int k = 0; k < 2; ++k) dst[n][k] = *(const PG8_LAS bf16x8*)(lds + PG8_SB(b, h) + boff + n * 2048 + k * 1024); } while (0)
#define PG8_MMA(ai, bj, At, Bt) do { if constexpr (FP8) __builtin_amdgcn_sched_barrier(0); __builtin_amdgcn_s_setprio(1); _Pragma("unroll") for (int m = 0; m < 4; ++m) _Pragma("unroll") for (int n = 0; n < 2; ++n) { \
        if constexpr (FP8) { const v8i_t a8 = __builtin_shufflevector(__builtin_bit_cast(v4i_t, At[m][0]), __builtin_bit_cast(v4i_t, At[m][1]), 0, 1, 2, 3, 4, 5, 6, 7); \
            const v8i_t b8 = __builtin_shufflevector(__builtin_bit_cast(v4i_t, Bt[n][0]), __builtin_bit_cast(v4i_t, Bt[n][1]), 0, 1, 2, 3, 4, 5, 6, 7); \
            asm volatile("v_mfma_f32_16x16x128_f8f6f4 %0, %1, %2, %0" : "+v"(acc[ai][bj][m][n]) : "v"(b8), "v"(a8)); } \
        else { _Pragma("unroll") for (int k = 0; k < 2; ++k) acc[ai][bj][m][n] = __builtin_amdgcn_mfma_f32_16x16x32_bf16(Bt[n][k], At[m][k], acc[ai][bj][m][n], 0, 0, 0); } } \
        __builtin_amdgcn_s_setprio(0); if constexpr (FP8) __builtin_amdgcn_sched_barrier(0); } while (0)
#define PG8_WAIT_V(n) asm volatile("s_waitcnt vmcnt(" #n ")" ::: "memory")
#define PG8_WAIT_L(n) asm volatile("s_waitcnt lgkmcnt(" #n ")" ::: "memory")
#define PG8_BAR __builtin_amdgcn_s_barrier()
#define PG8_SCHED __builtin_amdgcn_sched_barrier(0)
#define PG8_ROWOFFS(V, u) do { _Pragma("unroll") for (int _i = 0; _i < 2; ++_i) { int _R, _C; stage_rc(tid * 16 + _i * 8192, _R, _C); _Pragma("unroll") for (int _h = 0; _h < 2; ++_h) V[_h][_i] = S.rowoff(u, _h * HALF + _R) + (unsigned)_C * 2u; } } while (0)
    Unit cur, nxt, nn; int ui = 0;
    if (!S.next(0, cur)) return;
    bool has_next = S.next(1, nxt);
    unsigned vc[2][2], vn[2][2], vnn[2][2];
    if constexpr (GATHER) { PG8_ROWOFFS(vc, cur); if (has_next) { PG8_ROWOFFS(vn, nxt); } else { PG8_ROWOFFS(vn, cur); } }
    f32x4 acc[2][2][4][2];
#pragma unroll
    for (int a = 0; a < 2; ++a)
#pragma unroll
        for (int b = 0; b < 2; ++b)
#pragma unroll
            for (int m = 0; m < 4; ++m)
#pragma unroll
                for (int n = 0; n < 2; ++n) acc[a][b][m][n] = (f32x4){0.f, 0.f, 0.f, 0.f};
    bf16x8 At[4][2], B0[2][2], B1[2][2];
    const char* cA = (const char*)g.A + (GATHER ? (size_t)0 : (size_t)cur.pm * tstep); const char* cB = (const char*)g.Bt + (size_t)cur.e * g.estride + (size_t)cur.pn * tstep;
    PG8_STAGE(PG8_SB(0, 0), cB, voffB); PG8_STAGE(PG8_SB(0, 1), cB + hstep, voffB); PG8_STAGE_A(PG8_SA(0, 0), cA, 0, vc); PG8_STAGE_A(PG8_SA(0, 1), cA, 1, vc);
    if (wr == 1) PG8_BAR;
    PG8_WAIT_V(2); PG8_BAR;
    PG8_STAGE(PG8_SB(1, 0), cB + kstep, voffB); PG8_STAGE_A(PG8_SA(1, 0), cA + kstep, 0, vc); PG8_STAGE(PG8_SB(1, 1), cB + hstep + kstep, voffB);
    PG8_WAIT_V(6); PG8_BAR;
    for (;;) {
        const char* nA = GATHER ? cA : (has_next ? (const char*)g.A + (size_t)nxt.pm * tstep : cA);
        const char* nB = has_next ? (const char*)g.Bt + (size_t)nxt.e * g.estride + (size_t)nxt.pn * tstep : cB;
#pragma unroll 1
        for (int t = 0; t < nt; t += 2) {
            const bool last = (t == nt - 2);
            if (t == 0) E.prefetch(cur, lds + EPI_TAB_OFF + (ui & 1) * EPI_TAB_BYTES, wid, lane);
            const char* a1 = cA + (size_t)(t + 1) * kstep;
            const char* a2 = last ? nA : cA + (size_t)(t + 2) * kstep; const char* b2 = last ? nB : cB + (size_t)(t + 2) * kstep;
            const char* a3 = a2 + kstep; const char* b3 = b2 + kstep;
            unsigned w2[2][2];
            if constexpr (GATHER) {
#pragma unroll
                for (int h = 0; h < 2; ++h)
#pragma unroll
                    for (int i = 0; i < 2; ++i) w2[h][i] = last ? vn[h][i] : vc[h][i];
            }
            PG8_LDB(B0, 0, 0); PG8_LDB(B1, 0, 1); PG8_SCHED; PG8_LDA(At, 0, 0); PG8_STAGE_A(PG8_SA(1, 1), a1, 1, vc);
            PG8_WAIT_V(8); PG8_WAIT_L(0); PG8_BAR; PG8_MMA(0, 0, At, B0); PG8_MMA(0, 1, At, B1); PG8_BAR; PG8_SCHED;
            PG8_LDA(At, 0, 1); PG8_STAGE(PG8_SB(0, 0), b2, voffB); PG8_STAGE(PG8_SB(0, 1), b2 + hstep, voffB); PG8_STAGE_A(PG8_SA(0, 0), a2, 0, w2);
            PG8_WAIT_V(8); PG8_WAIT_L(0); PG8_BAR; PG8_MMA(1, 0, At, B0); PG8_MMA(1, 1, At, B1); PG8_BAR; PG8_SCHED;
            PG8_LDB(B0, 1, 0); PG8_LDB(B1, 1, 1); PG8_SCHED; PG8_LDA(At, 1, 0); PG8_STAGE_A(PG8_SA(0, 1), a2, 1, w2);
            PG8_WAIT_V(8); PG8_WAIT_L(0); PG8_BAR; PG8_MMA(0, 0, At, B0); PG8_MMA(0, 1, At, B1); PG8_BAR; PG8_SCHED;
            PG8_LDA(At, 1, 1); PG8_STAGE(PG8_SB(1, 0), b3, voffB); PG8_STAGE(PG8_SB(1, 1), b3 + hstep, voffB); PG8_STAGE_A(PG8_SA(1, 0), a3, 0, w2);
            PG8_WAIT_V(8); PG8_WAIT_L(0); PG8_BAR; PG8_MMA(1, 0, At, B0); PG8_MMA(1, 1, At, B1); PG8_BAR; PG8_SCHED;
        }
        if constexpr (ALIGN_EPI) { if (wr == 0) PG8_BAR; }
        bool has_nn = false;
        if constexpr (GATHER) { has_nn = has_next && S.next(ui + 2, nn); if (has_nn) { PG8_ROWOFFS(vnn, nn); } else { PG8_ROWOFFS(vnn, cur); } }
        else { has_nn = has_next && S.next(ui + 2, nn); }
        if constexpr (FP8) asm volatile("s_nop 15\n\ts_nop 15" ::: "memory");
        E(acc, cur, wr, wc, fr, fq, lds + EPI_TAB_OFF + (ui & 1) * EPI_TAB_BYTES);
        if constexpr (GATHER) { asm volatile("" : "+v"(vnn[0][0]), "+v"(vnn[0][1]), "+v"(vnn[1][0]), "+v"(vnn[1][1])); }
        if (!has_next) break;
#pragma unroll
        for (int a = 0; a < 2; ++a)
#pragma unroll
            for (int b = 0; b < 2; ++b)
#pragma unroll
                for (int m = 0; m < 4; ++m)
#pragma unroll
                    for (int n = 0; n < 2; ++n) acc[a][b][m][n] = (f32x4){0.f, 0.f, 0.f, 0.f};
        cur = nxt; cA = nA; cB = nB; ++ui; nxt = nn; has_next = has_nn;
        if constexpr (GATHER) {
#pragma unroll
            for (int h = 0; h < 2; ++h)
#pragma unroll
                for (int i = 0; i < 2; ++i) { vc[h][i] = vn[h][i]; vn[h][i] = vnn[h][i]; }
        }
        if constexpr (ALIGN_EPI) { if (wr == 1) PG8_BAR; }
    }
    PG8_WAIT_V(0);
    if constexpr (!ALIGN_EPI) { if (wr == 0) PG8_BAR; }
    PG8_BAR;
#undef PG8_SA
#undef PG8_SB
#undef PG8_STAGE
#undef PG8_STAGE_A
#undef PG8_LDA
#undef PG8_LDB
#undef PG8_MMA
#undef PG8_WAIT_V
#undef PG8_WAIT_L
#undef PG8_BAR
#undef PG8_SCHED
#undef PG8_ROWOFFS
}
}
#define GAS __attribute__((address_space(1)))
#define LAS __attribute__((address_space(3)))
typedef unsigned v4u __attribute__((ext_vector_type(4)));
typedef unsigned v2u __attribute__((ext_vector_type(2)));
typedef float f32x4 __attribute__((ext_vector_type(4)));
typedef float f32x16 __attribute__((ext_vector_type(16)));
#define LDS_WAIT() asm volatile("s_waitcnt lgkmcnt(0)" ::: "memory")
#define VM_WAIT() asm volatile("s_waitcnt vmcnt(0)" ::: "memory")
constexpr int NWAVES = 8;
constexpr int RING_BYTES = 131072;
constexpr int LDSCTL_OFF = RING_BYTES, MISC_OFF = LDSCTL_OFF + 320;
constexpr int TILE_E_OFF = RING_BYTES + 1024;
constexpr int LDS_BYTES = 147456;
static_assert(TILE_E_OFF + (NTILES_MAX + 8) * 4 <= LDS_BYTES, "LDS map");
constexpr int CW_GCNT = 32768;
constexpr int TILE_S_OFF = TILE_E_OFF + (NTILES_MAX + 8) * 4;
static_assert(TILE_S_OFF + NTILES_MAX * 4 <= 138 * 1024, "LDS map");
constexpr int CW_BAR = 4096;

#define XB_TMO      128
#define XB_XCNT(j)  (256  + 64 * (j))
#define XB_XSUB(j)  (1280 + 64 * (j))
#define XB_XGEN(j)  (2304 + 64 * (j))
#define XB_TOP      3328
#define XB_TOPGEN   3392
#define XCD_BAR_WORDS 3456
#define XB_SPIN_CAP (1u << 18)
__device__ __forceinline__ unsigned xb_ld(unsigned* p)              { return __hip_atomic_load(p, __ATOMIC_RELAXED, __HIP_MEMORY_SCOPE_AGENT); }
__device__ __forceinline__ unsigned xb_add(unsigned* p, unsigned v) { return __hip_atomic_fetch_add(p, v, __ATOMIC_RELAXED, __HIP_MEMORY_SCOPE_AGENT); }
__device__ __forceinline__ unsigned xb_xcc_id() { return (unsigned)__builtin_amdgcn_s_getreg((3 << 11) | 20) & 0xFu; }
#define XB_SPIN(cond, bar) do { unsigned _sp = 0; while (cond) { __builtin_amdgcn_s_sleep(1); \
    if ((++_sp & 255u) == 0u) { if (xb_ld(&(bar)[XB_TMO])) break; if (_sp > XB_SPIN_CAP) { atomicAdd(&(bar)[XB_TMO], 1u); break; } } } } while (0)
struct XcdBarrier { unsigned* bar; unsigned x; volatile LAS unsigned* st; };
__device__ __forceinline__ XcdBarrier xcd_barrier_post(unsigned* bar, volatile LAS unsigned* st) {
    XcdBarrier b; b.bar = bar; b.x = xb_xcc_id(); b.st = st;
    if (threadIdx.x == 0) (void)xb_add(&bar[XB_XCNT(b.x)], 1u);
    return b;
}
__device__ __forceinline__ void xcd_barrier_complete(unsigned* bar, unsigned x, unsigned& nloc, unsigned& nx) {
    const unsigned G = gridDim.x * gridDim.y * gridDim.z;
    unsigned sum, cnt, mine, sp = 0u;
    for (;;) {
        sum = 0u; cnt = 0u; mine = 0u;
#pragma unroll
        for (unsigned j = 0; j < 16; ++j) { const unsigned c = xb_ld(&bar[XB_XCNT(j)]); sum += c; cnt += (c > 0u) ? 1u : 0u; mine = (j == x) ? c : mine; }
        if (sum == G) break;
        __builtin_amdgcn_s_sleep(1);
        if ((++sp & 255u) == 0u) { if (xb_ld(&bar[XB_TMO])) break; if (sp > XB_SPIN_CAP) { atomicAdd(&bar[XB_TMO], 1u); break; } }
    }
    nloc = mine > 0u ? mine : 1u; nx = cnt > 0u ? cnt : 1u;
}
__device__ __forceinline__ void xcd_barrier(const XcdBarrier& b) {
    asm volatile("s_waitcnt vmcnt(0)" ::: "memory");
    __syncthreads();
    if (threadIdx.x == 0) {
        unsigned* bar = b.bar;
        __builtin_amdgcn_s_waitcnt(0);
        unsigned nloc = b.st[0], nx = b.st[1];
        if (nloc == 0u) { xcd_barrier_complete(bar, b.x, nloc, nx); b.st[0] = nloc; b.st[1] = nx; }
        const unsigned old = xb_add(&bar[XB_XSUB(b.x)], 1u);
        const unsigned gen = old / nloc;
        if (old + 1u == (gen + 1u) * nloc) {
            __builtin_amdgcn_fence(__ATOMIC_RELEASE, "agent");
            asm volatile("s_waitcnt vmcnt(0)" ::: "memory");
            const unsigned og = xb_add(&bar[XB_TOP], 1u);
            const unsigned tg = og / nx;
            if (og + 1u == (tg + 1u) * nx) xb_add(&bar[XB_TOPGEN], 1u);
            else XB_SPIN(xb_ld(&bar[XB_TOPGEN]) == tg, bar);
            __builtin_amdgcn_fence(__ATOMIC_ACQUIRE, "agent");
            xb_add(&bar[XB_XGEN(b.x)], 1u);
            asm volatile("s_waitcnt vmcnt(0)" ::: "memory");
        } else {
            XB_SPIN(xb_ld(&bar[XB_XGEN(b.x)]) == gen, bar);
            __builtin_amdgcn_fence(__ATOMIC_ACQUIRE, "agent");
            asm volatile("s_waitcnt vmcnt(0)" ::: "memory");
        }
    }
    __syncthreads();
}

__device__ __forceinline__ void glds16_raw(const void* gsrc, unsigned lds_dst) { unsigned keep;
    asm volatile("s_mov_b32 %0, m0\n\ts_mov_b32 m0, %2\n\ts_nop 0\n\tglobal_load_lds_dwordx4 %1, off\n\ts_mov_b32 m0, %0" : "=&s"(keep) : "v"(gsrc), "s"(lds_dst) : "memory"); }
#define GLDS16R(gp, lp) glds16_raw((const void*)(gp), (unsigned)__builtin_amdgcn_readfirstlane((int)(unsigned)(size_t)(lp)))
struct Args { const float* in[15]; float* out; unsigned char* ws; int ph_lo, ph_hi, li, pad; };
struct Frame {
    LAS unsigned char* lds;
    int tid, lane, wave, vcu, G;
    const float *x, *meta, *attn_g, *w_in, *dlam, *subln, *w_out, *ffn_g, *w_router, *b_router, *w_up, *b_up, *w_down, *b_down, *final_g;
    float* out; unsigned char* ws;
};

template <class DestRow>
__device__ __forceinline__ void p0_transpose_item(const float* __restrict__ W, int K, int N, bf16* __restrict__ WT, LAS float* scr, int item, int lane, DestRow dest) {
    const int nblk = N / 32, kb = item / nblk, nb = item % nblk, k0 = 64 * kb, n0 = 32 * nb;
#pragma unroll 8
    for (int i = 0; i < 32; ++i) { const int kk = 2 * i + (lane >> 5); scr[kk * 33 + (lane & 31)] = __builtin_nontemporal_load(W + (size_t)(k0 + kk) * N + n0 + (lane & 31)); }
    LDS_WAIT(); asm volatile("" ::: "memory");
    const int c = lane & 7;
#pragma unroll
    for (int j = 0; j < 4; ++j) { const int n = (lane >> 3) + 8 * j; const LAS float* s = scr + (8 * c) * 33 + n;
        v4u o; o.x = pk2(s[0 * 33], s[1 * 33]); o.y = pk2(s[2 * 33], s[3 * 33]); o.z = pk2(s[4 * 33], s[5 * 33]); o.w = pk2(s[6 * 33], s[7 * 33]);
        *(v4u*)(WT + (size_t)dest(n0 + n) * K + k0 + 8 * c) = o; }
    LDS_WAIT(); asm volatile("" ::: "memory");
}

__device__ __forceinline__ unsigned pk_fp8x4(float a, float b, float c, float d) { int w = __builtin_amdgcn_cvt_pk_fp8_f32(a, b, 0, false); w = __builtin_amdgcn_cvt_pk_fp8_f32(c, d, w, true); return (unsigned)w; }
template <class DestRow>
__device__ __forceinline__ void p0_transpose_item_fp8(const float* __restrict__ W, int K, int N, unsigned char* __restrict__ WT, LAS float* scr, int item, int lane, DestRow dest, float scale) {
    const int nblk = N / 32, kb = item / nblk, nb = item % nblk, k0 = 64 * kb, n0 = 32 * nb;
#pragma unroll 8
    for (int i = 0; i < 32; ++i) { const int kk = 2 * i + (lane >> 5); scr[kk * 33 + (lane & 31)] = __builtin_nontemporal_load(W + (size_t)(k0 + kk) * N + n0 + (lane & 31)); }
    LDS_WAIT(); asm volatile("" ::: "memory");
    const int c = lane & 7;
#pragma unroll
    for (int j = 0; j < 4; ++j) { const int n = (lane >> 3) + 8 * j; const LAS float* s = scr + (8 * c) * 33 + n;
        v2u o; o.x = pk_fp8x4(s[0 * 33] * scale, s[1 * 33] * scale, s[2 * 33] * scale, s[3 * 33] * scale); o.y = pk_fp8x4(s[4 * 33] * scale, s[5 * 33] * scale, s[6 * 33] * scale, s[7 * 33] * scale);
        *(v2u*)(WT + (size_t)dest(n0 + n) * K + k0 + 8 * c) = o; }
    LDS_WAIT(); asm volatile("" ::: "memory");
}
struct DestId { __device__ __forceinline__ int operator()(int n) const { return n; } };
struct DestIn {
    __device__ __forceinline__ int operator()(int n) const { const int pn = n >> 8; const bool rope = (pn < 4) || pn == 6 || pn == 7; if (!rope) return n;
        const int w = n & 255, hh = w >> 6, bj = (w >> 5) & 1, dd = w & 31; return (pn << 8) + 128 * bj + 32 * hh + dd; }
};
struct DestUp {
    __device__ __forceinline__ int operator()(int c) const { return ((c >> 8) << 8) + 128 * (c & 1) + ((c >> 1) & 127); }
};

__device__ __forceinline__ float inv_freq_d(int i) { return exp2f(-(float)i / 32.0f * 13.287712379549449f); }
__device__ __forceinline__ float inv_freq_r(int i) { return exp2f(-(float)i / 31.0f * 13.287712379549449f); }

__device__ __forceinline__ void p0_meta(Frame& F, int j) {
    LAS float* hn = (LAS float*)F.lds;
    LAS float* part = (LAS float*)(F.lds + 65536);
    LAS float* fin = (LAS float*)(F.lds + 98304);
    for (int r = F.wave * 2; r < F.wave * 2 + 2; ++r) {
        const float* src = F.meta + (size_t)r * D;
        float4 v[4]; float ss = 0.f;
#pragma unroll
        for (int q = 0; q < 4; ++q) { v[q] = ((const float4*)src)[F.lane + 64 * q]; ss += v[q].x * v[q].x + v[q].y * v[q].y + v[q].z * v[q].z + v[q].w * v[q].w; }
        const float rs = rsqrtf(wave_sum(ss) * (1.f / D) + EPS);
#pragma unroll
        for (int q = 0; q < 4; ++q) { const float4 gg = ((const float4*)F.attn_g)[F.lane + 64 * q]; const int k = 4 * (F.lane + 64 * q);
            hn[r * D + k] = v[q].x * rs * gg.x; hn[r * D + k + 1] = v[q].y * rs * gg.y; hn[r * D + k + 2] = v[q].z * rs * gg.z; hn[r * D + k + 3] = v[q].w * rs * gg.w; }
    }
    __syncthreads();
    float acc[16];
#pragma unroll
    for (int r = 0; r < 16; ++r) acc[r] = 0.f;
    for (int k = 128 * F.wave; k < 128 * F.wave + 128; k += 4) {
        float wv[4];
#pragma unroll
        for (int q = 0; q < 4; ++q) wv[q] = F.w_in[(size_t)(k + q) * NPROJ + 64 * j + F.lane];
#pragma unroll
        for (int r = 0; r < 16; ++r) { const f32x4 h4 = *(const LAS f32x4*)(hn + r * D + k); acc[r] += h4[0] * wv[0] + h4[1] * wv[1] + h4[2] * wv[2] + h4[3] * wv[3]; }
    }
#pragma unroll
    for (int r = 0; r < 16; ++r) part[(F.wave * 16 + r) * 64 + F.lane] = acc[r];
    __syncthreads();
    for (int idx = F.tid; idx < 1024; idx += 512) { float s = 0.f;
#pragma unroll
        for (int w = 0; w < 8; ++w) s += part[w * 1024 + idx];
        fin[idx] = s; }
    __syncthreads();
    bf16* DK = (bf16*)(F.ws + WS_DK); bf16* DV = (bf16*)(F.ws + WS_DV); bf16* RK = (bf16*)(F.ws + WS_RK); bf16* RV = (bf16*)(F.ws + WS_RV);
    for (int idx = F.tid; idx < 1024; idx += 512) {
        const int r = idx >> 6, c = idx & 63; float val = fin[idx];
        const bool isdk = j >= 8 && j < 16, isrk = j >= 28 && j < 32;
        if (isdk || isrk) {
            const int i = c & 31; const float ang = (float)r * (isdk ? inv_freq_d(i) : inv_freq_r(i)); const float cs = cosf(ang), sn = sinf(ang);
            const float other = fin[idx ^ 32];
            val = c < 32 ? val * cs - other * sn : val * cs + other * sn;
            if (isrk) val *= 0.125f * exp2f(-(float)(112 + r) * log2f(1.f - exp2f(-5.f - (float)(j - 28))));
        }
        const bf16 o = (bf16)f2bf(val);
        for (int bb = 0; bb < NB; ++bb) {
            if (isdk) DK[((size_t)bb * KROWS + r) * 512 + 64 * (j - 8) + c] = o;
            else if (j >= 16 && j < 24) DV[((size_t)bb * KROWS + r) * 512 + 64 * (j - 16) + c] = o;
            else if (isrk) RK[((size_t)bb * RROWS + 112 + r) * 256 + 64 * (j - 28) + c] = o;
            else RV[((size_t)bb * RROWS + 112 + r) * 512 + 64 * (j - 32) + c] = o;
        }
    }
    __syncthreads();
}

__device__ __forceinline__ void p0_prologue(Frame& F) {
    if (F.vcu < 48) { const int j = F.vcu; const bool need = (j >= 8 && j < 24) || (j >= 28 && j < 40); if (need) p0_meta(F, j); }
    LAS float* scr = (LAS float*)(F.lds + F.wave * 16384);
    const int gw = F.vcu * NWAVES + F.wave, NGW = F.G * NWAVES;
    bf16* WinT = (bf16*)(F.ws + WS_WIN); bf16* WoutT = (bf16*)(F.ws + WS_WOUT); bf16* WupT = (bf16*)(F.ws + WS_WUP); bf16* WdnT = (bf16*)(F.ws + WS_WDN);
    constexpr int I_IN = (D / 64) * (NPROJ / 32), I_OUT = (D / 64) * (D / 32), I_UP = (D / 64) * (2048 / 32), I_DN = (D / 64) * (D / 32);
    constexpr int NITEMS = I_IN + I_OUT + NE * I_UP + NE * I_DN;
    for (int it = gw; it < NITEMS; it += NGW) {
        int r = it;
        if (r < I_IN) { p0_transpose_item(F.w_in, D, NPROJ, WinT, scr, r, F.lane, DestIn{}); continue; } r -= I_IN;
        if (r < I_OUT) { p0_transpose_item(F.w_out, D, D, WoutT, scr, r, F.lane, DestId{}); continue; } r -= I_OUT;
        if (r < NE * I_UP) { const int e = r / I_UP; p0_transpose_item_fp8(F.w_up + (size_t)e * D * 2048, D, 2048, (unsigned char*)WupT + (size_t)e * 2048 * D, scr, r % I_UP, F.lane, DestUp{}, WSCALE); continue; } r -= NE * I_UP;
        { const int e = r / I_DN; p0_transpose_item_fp8(F.w_down + (size_t)e * D * D, D, D, (unsigned char*)WdnT + (size_t)e * D * D, scr, r % I_DN, F.lane, DestId{}, WSCALE); }
    }
    bf16* HN = (bf16*)(F.ws + WS_HN);
#pragma unroll 2
    for (int m = gw; m < T; m += NGW) {
        const float* __restrict__ src = F.x + (size_t)m * D;
        float4 v[4]; float ss = 0.f;
#pragma unroll
        for (int q = 0; q < 4; ++q) { const f32x4 t4 = __builtin_nontemporal_load((const f32x4*)src + F.lane + 64 * q); v[q] = make_float4(t4[0], t4[1], t4[2], t4[3]); ss += v[q].x * v[q].x + v[q].y * v[q].y + v[q].z * v[q].z + v[q].w * v[q].w; }
        const float rs = rsqrtf(wave_sum(ss) * (1.f / D) + EPS);
#pragma unroll
        for (int q = 0; q < 4; ++q) { const float4 gg = ((const float4*)F.attn_g)[F.lane + 64 * q];
            uint2 o; o.x = pk2(v[q].x * rs * gg.x, v[q].y * rs * gg.y); o.y = pk2(v[q].z * rs * gg.z, v[q].w * rs * gg.w);
            ((uint2*)(HN + (size_t)m * D))[F.lane + 64 * q] = o; }
    }
    float2* tabD = (float2*)(F.ws + WS_ROPE_D); float2* tabR = (float2*)(F.ws + WS_ROPE_R);
    for (int idx = F.vcu * 512 + F.tid; idx < LTOT * 32; idx += F.G * 512) {
        const int pos = idx >> 5, i = idx & 31; const float aD = (float)pos * inv_freq_d(i), aR = (float)pos * inv_freq_r(i);
        tabD[idx] = make_float2(cosf(aD), sinf(aD)); tabR[idx] = make_float2(cosf(aR), sinf(aR));
    }
    { bf16* wrf = (bf16*)(F.ws + WS_WRF);
      for (int idx = F.vcu * 512 + F.tid; idx < 64 * 64; idx += F.G * 512) { const int s_ = idx >> 6, ln = idx & 63, n = ln & 31, hi = ln >> 5; unsigned h[4], l[4];
#pragma unroll
          for (int j = 0; j < 4; ++j) { const float w0 = F.w_router[(16 * s_ + 8 * hi + 2 * j) * NE + n], w1 = F.w_router[(16 * s_ + 8 * hi + 2 * j + 1) * NE + n];
              const unsigned h0 = f2bf(w0), h1 = f2bf(w1); h[j] = h0 | (h1 << 16); l[j] = f2bf(w0 - bf2f((bf16)h0)) | (f2bf(w1 - bf2f((bf16)h1)) << 16); }
          *(v4u*)(wrf + (size_t)idx * 8) = (v4u){h[0], h[1], h[2], h[3]}; *(v4u*)(wrf + (size_t)(4096 + idx) * 8) = (v4u){l[0], l[1], l[2], l[3]}; } }
    { v4u* rt = (v4u*)(F.ws + WS_ROWTOK_S); const v4u m1 = {0xffffffffu, 0xffffffffu, 0xffffffffu, 0xffffffffu};
      for (int idx = F.vcu * 512 + F.tid; idx < NE * CAP / 4; idx += F.G * 512) rt[idx] = m1; }
    { v4u* DK = (v4u*)(F.ws + WS_DK); v4u* DV = (v4u*)(F.ws + WS_DV); v4u* RK = (v4u*)(F.ws + WS_RK); v4u* RV = (v4u*)(F.ws + WS_RV); const v4u z = {0u, 0u, 0u, 0u};
      constexpr int nA = NB * 48 * 64, nB = NB * 112 * 32, nC = NB * 112 * 64;
      for (int idx = F.vcu * 512 + F.tid; idx < nC; idx += F.G * 512) {
          if (idx < nA) { const int b = idx / (48 * 64), r = idx % (48 * 64); DK[((size_t)b * KROWS + 16) * 64 + r] = z; DV[((size_t)b * KROWS + 16) * 64 + r] = z; }
          if (idx < nB) { const int b = idx / (112 * 32), r = idx % (112 * 32); RK[(size_t)b * RROWS * 32 + r] = z; }
          { const int b = idx / (112 * 64), r = idx % (112 * 64); RV[(size_t)b * RROWS * 64 + r] = z; }
      } }
}

struct EpiInProj {
    static constexpr bool PERM = true;
    bf16 *__restrict__ DQ, *__restrict__ DK, *__restrict__ DV, *__restrict__ RQ, *__restrict__ RK, *__restrict__ RV, *__restrict__ RG; const float2 *__restrict__ tabD;
    __device__ __forceinline__ void prefetch(const pg8::Unit&, LAS unsigned char*, int, int) const {}
    __device__ __forceinline__ void operator()(const pg8::f32x4 (&acc)[2][2][4][2], const pg8::Unit& u, int wr, int wc, int fr, int fq, const LAS unsigned char* tab) const {
        const int pn = u.pn;
        bf16* __restrict__ base; int ld, colb, rk, rope; float sc = 1.f;
        float dsgn = 0.f;
        if (pn < 2) { base = DQ; ld = 512; colb = 256 * pn; rk = 0; rope = 1; sc = C2; }
        else if (pn < 4) { base = DK; ld = 512; colb = 256 * (pn - 2); rk = 1; rope = 1; }
        else if (pn < 6) { base = DV; ld = 512; colb = 256 * (pn - 4); rk = 1; rope = 0; }
        else if (pn == 6) { base = RQ; ld = 256; colb = 0; rk = 0; rope = 2; dsgn = 1.f; }
        else if (pn == 7) { base = RK; ld = 256; colb = 0; rk = 2; rope = 2; sc = 0.125f; dsgn = -1.f; }
        else if (pn < 10) { base = RV; ld = 512; colb = 256 * (pn - 8); rk = 2; rope = 0; }
        else { base = RG; ld = 512; colb = 256 * (pn - 10); rk = 0; rope = 0; }
        const float l2g = dsgn * log2f(1.f - exp2f(-5.f - (float)wc));
        float fr8[8];
        { const LAS float* ft = (const LAS float*)tab + (rope == 2 ? 32 : 0) + 8 * fq; const pg8::f32x4 f0 = *(const LAS pg8::f32x4*)ft, f1 = *(const LAS pg8::f32x4*)(ft + 4);
#pragma unroll
          for (int p = 0; p < 4; ++p) { fr8[p] = f0[p]; fr8[4 + p] = f1[p]; } }
#pragma unroll
        for (int ai = 0; ai < 2; ++ai)
#pragma unroll
            for (int m = 0; m < 4; ++m) {
                const int tr = u.pm * 256 + ai * 128 + wr * 64 + m * 16 + fr; const int b = tr >> 12, t = tr & 4095;
                const size_t drow = rk == 0 ? (size_t)tr : rk == 1 ? ((size_t)b * KROWS + 64 + t) : ((size_t)b * RROWS + 128 + t);
                bf16* __restrict__ rowp = base + drow * ld + colb;
                if (rope) {
                    const float pos = (float)(t + NMETA);
                    pg8::f32x4 cs[4];
#pragma unroll
                    for (int p = 0; p < 8; ++p) { const float rev = __builtin_amdgcn_fractf(pos * fr8[p]); cs[p >> 1][2 * (p & 1)] = __builtin_amdgcn_cosf(rev); cs[p >> 1][2 * (p & 1) + 1] = __builtin_amdgcn_sinf(rev); }
                    pg8::u32x4 w1, w2;
                    const float scr_ = sc * __builtin_amdgcn_exp2f((float)(t & 127) * l2g);
#pragma unroll
                    for (int n = 0; n < 2; ++n) {
                        const pg8::f32x4 x1 = acc[ai][0][m][n], x2 = acc[ai][1][m][n]; float o1[4], o2[4];
#pragma unroll
                        for (int i = 0; i < 4; ++i) { const float c = cs[2 * n + (i >> 1)][2 * (i & 1)], s = cs[2 * n + (i >> 1)][2 * (i & 1) + 1];
                            o1[i] = (x1[i] * c - x2[i] * s) * scr_; o2[i] = (x2[i] * c + x1[i] * s) * scr_; }
                        w1[2 * n] = pg8::cvt_pk_bf16(o1[0], o1[1]); w1[2 * n + 1] = pg8::cvt_pk_bf16(o1[2], o1[3]);
                        w2[2 * n] = pg8::cvt_pk_bf16(o2[0], o2[1]); w2[2 * n + 1] = pg8::cvt_pk_bf16(o2[2], o2[3]);
                    }
                    *(pg8::u32x4*)(rowp + 64 * wc + 8 * fq) = w1; *(pg8::u32x4*)(rowp + 64 * wc + 32 + 8 * fq) = w2;
                } else {
#pragma unroll
                    for (int bj = 0; bj < 2; ++bj) { const pg8::f32x4 v0 = acc[ai][bj][m][0], v1 = acc[ai][bj][m][1]; pg8::u32x4 w;
                        w.x = pg8::cvt_pk_bf16(v0[0], v0[1]); w.y = pg8::cvt_pk_bf16(v0[2], v0[3]); w.z = pg8::cvt_pk_bf16(v1[0], v1[1]); w.w = pg8::cvt_pk_bf16(v1[2], v1[3]);
                        *(pg8::u32x4*)(rowp + 128 * bj + 32 * wc + 8 * fq) = w; }
                }
            }
    }
};


typedef short bf16x8_t __attribute__((ext_vector_type(8)));
typedef short s16x4_t __attribute__((ext_vector_type(4)));
typedef float f32x2_t __attribute__((ext_vector_type(2)));
typedef __bf16 bf16x2_t __attribute__((ext_vector_type(2)));
#define MFMA32(a, b, c) __builtin_amdgcn_mfma_f32_32x32x16_bf16((a), (b), (c), 0, 0, 0)
__device__ __forceinline__ int crow(int i, int hh) { return (i & 3) + 8 * (i >> 2) + 4 * hh; }
__device__ __forceinline__ unsigned cvtpk(float lo, float hi) { f32x2_t v = {lo, hi}; bf16x2_t b = __builtin_convertvector(v, bf16x2_t); return __builtin_bit_cast(unsigned, b); }
__device__ __forceinline__ s16x4_t vtr(const LAS unsigned char* p) { typedef short v4i16_t __attribute__((ext_vector_type(4))); return __builtin_bit_cast(s16x4_t, __builtin_amdgcn_ds_read_tr16_b64_v4i16((LAS v4i16_t*)p)); }
__device__ __forceinline__ bf16x8_t pack8(const f32x16& x, int s8) {
    v4u w; w.x = cvtpk(x[s8], x[s8 + 1]); w.y = cvtpk(x[s8 + 2], x[s8 + 3]); w.z = cvtpk(x[s8 + 4], x[s8 + 5]); w.w = cvtpk(x[s8 + 6], x[s8 + 7]); return __builtin_bit_cast(bf16x8_t, w);
}
__device__ __forceinline__ float vmax3(float a, float b, float c) { float r; asm("v_max3_f32 %0, %1, %2, %3" : "=v"(r) : "v"(a), "v"(b), "v"(c)); return r; }
__device__ __forceinline__ float vmax2(float a, float b) { float r; asm("v_max_f32 %0, %1, %2" : "=v"(r) : "v"(a), "v"(b)); return r; }
__device__ __forceinline__ float half_max(float v) { float a = v, b = v; asm("s_nop 1\n\tv_permlane32_swap_b32 %0, %1\n\ts_nop 1" : "+v"(a), "+v"(b)); return vmax2(a, b); }
__device__ __forceinline__ void swap32(unsigned& a, unsigned& b) { asm volatile("s_nop 1\n\tv_permlane32_swap_b32 %0, %1\n\ts_nop 1" : "+v"(a), "+v"(b)); }
__device__ __forceinline__ float half_swap(float v) { return __shfl_xor(v, 32); }
constexpr int AT_K = 0, AT_V = 3 * 8192, AT_ST = AT_V + 3 * 16384, AT_ST7 = RING_BYTES + 1024, AT_SCR = AT_ST7 + 8192;
static_assert(AT_ST + 7 * 8192 <= RING_BYTES && AT_SCR + 1024 <= 147456, "attention LDS map");
__device__ __forceinline__ LAS unsigned char* at_stage(LAS unsigned char* lds, int wave) { return lds + (wave < 7 ? AT_ST + wave * 8192 : AT_ST7); }
#define GLDS16(gp, lp) __builtin_amdgcn_global_load_lds((const unsigned*)(gp), (LAS unsigned*)(lp), 16, 0, 0)
__device__ __forceinline__ void glds16_asm(const void* gsrc, unsigned lds_dst) { unsigned keep;
    asm volatile("s_mov_b32 %0, m0\n\ts_mov_b32 m0, %2\n\ts_nop 0\n\tglobal_load_lds_dwordx4 %1, off\n\ts_mov_b32 m0, %0" : "=&s"(keep) : "v"(gsrc), "s"(lds_dst) : "memory"); }
__device__ __forceinline__ void glds16_sbase(const void* sbase, unsigned voff, const LAS unsigned char* lp) { unsigned keep;
    asm volatile("s_mov_b32 %0, m0\n\ts_mov_b32 m0, %3\n\ts_nop 0\n\tglobal_load_lds_dwordx4 %1, %2\n\ts_mov_b32 m0, %0" : "=&s"(keep) : "v"(voff), "s"(sbase), "s"((unsigned)(size_t)lp) : "memory"); }
#define GLDS16A(gp, lp) glds16_asm((const void*)(gp), (unsigned)__builtin_amdgcn_readfirstlane((int)(unsigned)(size_t)(lp)))

constexpr float AT_THR = 8.f;
constexpr int AT_SLOT = 8192;
#define SBAR() __builtin_amdgcn_sched_barrier(0)
#define PIN(x) asm volatile("" : "+v"(x))
#define WAIT_BAR(N) asm volatile("s_waitcnt vmcnt(" #N ") lgkmcnt(0)\n\ts_barrier" ::: "memory")
#define MX3(a, b, c) __builtin_elementwise_maximum(__builtin_elementwise_maximum((a), (b)), (c))
__device__ __forceinline__ float at_rowmax(const f32x16& p0, const f32x16& p1) {
    float a = MX3(p0[0], p0[1], p1[0]), b = MX3(p0[2], p0[3], p1[1]); a = MX3(a, p1[2], p1[3]);
#pragma unroll
    for (int r = 4; r < 16; r += 4) { a = MX3(a, p0[r], p0[r + 1]); b = MX3(b, p0[r + 2], p0[r + 3]); a = MX3(a, p1[r], p1[r + 1]); b = MX3(b, p1[r + 2], p1[r + 3]); }
    return half_max(__builtin_elementwise_maximum(a, b)); }
__device__ __forceinline__ void at_cmask(f32x16& p0, f32x16& p1, int jb, int qrel, int hi) {
    const int kb = 64 * jb + 4 * hi;
#pragma unroll
    for (int r = 0; r < 16; ++r) { const int kv = kb + (r & 3) + 8 * (r >> 2); if (kv > qrel) p0[r] = -INFINITY; if (kv + 32 > qrel) p1[r] = -INFINITY; } }
template <int MP, int VAR>
__device__ __forceinline__ void attn_pass(Frame& F, f32x16 (&o)[4], int b, int h, int qb, float lam) {
    int lane = F.lane; asm volatile("" : "+v"(lane));
    const int r = lane & 31, hh = lane >> 5, wave = F.wave;
    const bf16* DQ = (const bf16*)(F.ws + WS_DQ); const bf16* DK = (const bf16*)(F.ws + WS_DK); const bf16* DV = (const bf16*)(F.ws + WS_DV);
    const int tq = 32 * wave + r;
    const size_t trow = (size_t)b * SEQ + 256 * qb + tq;
    const int NT = 4 * qb + 5;
    const LAS unsigned char* kp0 = F.lds + AT_K + hh * 1024 + r * 16;
    const LAS unsigned char* vp0 = F.lds + AT_V + (4 * hh + ((lane & 15) >> 2)) * 64 + ((lane >> 4) & 1) * 32 + (lane & 3) * 8;
    const int kh = 2 * h + MP;
    bf16x8_t qr[4];
#pragma unroll
    for (int s_ = 0; s_ < 4; ++s_) qr[s_] = *(const bf16x8_t*)(DQ + trow * 512 + 64 * kh + 16 * s_ + 8 * hh);
    const int pc0 = 2 * wave, pc1 = 2 * wave + 1;
    const bf16* kbase = DK + (size_t)b * KROWS * 512 + 64 * kh + 8 * wave;
    const bf16* vbase0 = DV + ((size_t)b * KROWS + 16 * (pc0 & 3)) * 512 + 128 * h + 32 * (pc0 >> 2);
    const bf16* vbase1 = DV + ((size_t)b * KROWS + 16 * (pc1 & 3)) * 512 + 128 * h + 32 * (pc1 >> 2);
    const unsigned koff = (unsigned)lane * 1024u, voff = (unsigned)(lane >> 2) * 1024u + (unsigned)(lane & 3) * 16u;
    const int vd0 = (pc0 >> 2) * 4096 + (pc0 & 3) * 1024, vd1 = (pc1 >> 2) * 4096 + (pc1 & 3) * 1024;
#define DMA_K(t, sl) do { const int t_ = (t); const bool ex_ = t_ < NT; glds16_sbase(kbase + (size_t)(ex_ ? t_ : 0) * 64 * 512, koff, F.lds + (ex_ ? AT_K + (sl) + wave * 1024 : AT_SCR)); } while (0)
#define DMA_V0(t, sl) glds16_sbase(vbase0 + (size_t)(t) * 64 * 512, voff, F.lds + AT_V + 2 * (sl) + vd0)
#define DMA_V1(t, sl) glds16_sbase(vbase1 + (size_t)(t) * 64 * 512, voff, F.lds + AT_V + 2 * (sl) + vd1)
#define DMA_V(t, sl) do { DMA_V0(t, sl); DMA_V1(t, sl); } while (0)
    asm volatile("s_waitcnt lgkmcnt(0)\n\ts_barrier" ::: "memory");
    DMA_K(0, 0); DMA_V(0, 0); DMA_K(1, AT_SLOT); DMA_K(2, 2 * AT_SLOT);
    float mref = 0.f, l = 0.f, alpha = 1.f; bool resc = false;
    f32x16 negm;
#pragma unroll
    for (int i = 0; i < 16; ++i) negm[i] = 0.f;
    PIN(negm);
#pragma unroll
    for (int k = 0; k < 4; ++k)
#pragma unroll
        for (int i = 0; i < 16; ++i) o[k][i] = 0.f;
    f32x16 pA0, pA1, pB0, pB1; bf16x8_t kf[8]; s16x4_t vlo[16], vhi[16]; v4u pw0, pw1, pw2, pw3;
    int sl_prev = 0, sl_cur = 0, sl_next = AT_SLOT;
#define ROT() do { sl_prev = sl_cur; sl_cur = sl_next; sl_next = (sl_next == 2 * AT_SLOT) ? 0 : sl_next + AT_SLOT; } while (0)
#define KLOAD(i, base) kf[i] = *(const LAS bf16x8_t*)((base) + ((i) >> 1) * 2048 + ((i) & 1) * 512)
#define EX(v) __builtin_amdgcn_exp2f(v)
#define RESC() do { if (resc) { _Pragma("unroll") for (int k_ = 0; k_ < 4; ++k_) _Pragma("unroll") for (int i_ = 0; i_ < 16; ++i_) o[k_][i_] *= alpha; } } while (0)
    WAIT_BAR(0);
    _Pragma("unroll") for (int i = 0; i < 8; ++i) KLOAD(i, kp0);
    pA0 = MFMA32(kf[0], qr[0], negm); pA1 = MFMA32(kf[1], qr[0], negm); pA0 = MFMA32(kf[2], qr[1], pA0); pA1 = MFMA32(kf[3], qr[1], pA1);
    pA0 = MFMA32(kf[4], qr[2], pA0); pA1 = MFMA32(kf[5], qr[2], pA1); pA0 = MFMA32(kf[6], qr[3], pA0); pA1 = MFMA32(kf[7], qr[3], pA1);
#pragma unroll
    for (int i = 0; i < 16; ++i) { if (i >= 8) pA0[i] = -INFINITY; pA1[i] = -INFINITY; }
    { mref = at_rowmax(pA0, pA1);
#pragma unroll
      for (int i = 0; i < 16; ++i) { negm[i] = -mref; pA0[i] = EX(pA0[i] - mref); pA1[i] = EX(pA1[i] - mref); } }
    WAIT_BAR(0);
    DMA_K(3, 0); DMA_V(1, AT_SLOT); ROT();
    _Pragma("unroll") for (int i = 0; i < 8; ++i) KLOAD(i, kp0 + sl_cur);
    WAIT_BAR(3);
#define PKW(P, i) cvtpk(P[i], P[i + 1])
#define PAF(k) __builtin_bit_cast(bf16x8_t, pw##k)
#define VFR(j) __builtin_shufflevector(vlo[j], vhi[j], 0, 1, 2, 3, 4, 5, 6, 7)
#define VRD(j) do { vlo[j] = vtr(vp_ + (((j) & 3) * 4096 + ((j) >> 2) * 1024)); vhi[j] = vtr(vp_ + (((j) & 3) * 4096 + ((j) >> 2) * 1024 + 512)); } while (0)
#define KRD(G, i) do { if (G) { KLOAD(i, kp0 + sl_next); } } while (0)
#define GAPA(MF, a0, a1, a2, a3, W0, W1, PW) do { MF; sacc += a0; sacc += a1; sacc += a2; sacc += a3; W0; W1; PIN(PW); PIN(sacc); SBAR(); } while (0)
#define GAPB(MF, X, i) do { MF; X[i] = EX(X[i]); X[i + 1] = EX(X[i + 1]); PIN(X); SBAR(); } while (0)
#define GAPX(MF, R, X, i) do { MF; R = MX3(R, X[i], X[i + 1]); X[i] = EX(X[i]); X[i + 1] = EX(X[i + 1]); PIN(X); PIN(R); SBAR(); } while (0)
#define STEP(C0, C1, P0, P1, t, MASK, GK, GV, GL) do { SBAR(); \
    const LAS unsigned char* vp_ = vp0 + 2 * sl_prev; \
    float sacc = P0[0] + P0[1]; \
    if (GK) DMA_K((t) + 3, sl_cur);                                                                                      \
                    GAPA(C0 = MFMA32(kf[0], qr[0], negm), P0[2], P0[3], P0[4], P0[5],     pw0[0] = PKW(P0, 0),  pw0[1] = PKW(P0, 2),  pw0); \
    if (GV) DMA_V0((t) + 1, sl_next); \
                    GAPA(C1 = MFMA32(kf[1], qr[0], negm), P0[6], P0[7], P0[8], P0[9],     pw0[2] = PKW(P0, 4),  pw0[3] = PKW(P0, 6),  pw0); \
    if (GV) DMA_V1((t) + 1, sl_next); \
                    GAPA(C0 = MFMA32(kf[2], qr[1], C0),   P0[10], P0[11], P0[12], P0[13], pw1[0] = PKW(P0, 8),  pw1[1] = PKW(P0, 10), pw1); \
                    GAPA(C1 = MFMA32(kf[3], qr[1], C1),   P0[14], P0[15], P1[0], P1[1],   pw1[2] = PKW(P0, 12), pw1[3] = PKW(P0, 14), pw1); \
    VRD(0); SBAR(); GAPA(C0 = MFMA32(kf[4], qr[2], C0),   P1[2], P1[3], P1[4], P1[5],     pw2[0] = PKW(P1, 0),  pw2[1] = PKW(P1, 2),  pw2); \
    VRD(1); SBAR(); GAPA(C1 = MFMA32(kf[5], qr[2], C1),   P1[6], P1[7], P1[8], P1[9],     pw2[2] = PKW(P1, 4),  pw2[3] = PKW(P1, 6),  pw2); \
    VRD(2); SBAR(); GAPA(C0 = MFMA32(kf[6], qr[3], C0),   P1[10], P1[11], P1[12], P1[13], pw3[0] = PKW(P1, 8),  pw3[1] = PKW(P1, 10), pw3); \
    VRD(3); SBAR(); GAPA(C1 = MFMA32(kf[7], qr[3], C1),   P1[14], P1[15], 0.f, 0.f,       pw3[2] = PKW(P1, 12), pw3[3] = PKW(P1, 14), pw3); \
    l += sacc; \
    if (MASK) { int q_ = tq; asm volatile("" : "+v"(q_)); at_cmask(C0, C1, (t) - (NT - 4), q_, hh); }        \
      \
    float ra_ = C0[0], rb_ = C0[2]; \
    VRD(4);  KRD(GL, 0); SBAR();  GAPX(o[0] = MFMA32(VFR(0),  PAF(0), o[0]), ra_, C0, 0); \
    VRD(5);  SBAR();              GAPX(o[1] = MFMA32(VFR(1),  PAF(0), o[1]), rb_, C0, 2); \
    VRD(6);  KRD(GL, 1); SBAR();  GAPX(o[2] = MFMA32(VFR(2),  PAF(0), o[2]), ra_, C0, 4); \
    VRD(7);  SBAR();              GAPX(o[3] = MFMA32(VFR(3),  PAF(0), o[3]), rb_, C0, 6); \
    VRD(8);  KRD(GL, 2); SBAR();  GAPX(o[0] = MFMA32(VFR(4),  PAF(1), o[0]), ra_, C0, 8); \
    VRD(9);  SBAR();              GAPX(o[1] = MFMA32(VFR(5),  PAF(1), o[1]), rb_, C0, 10); \
    VRD(10); KRD(GL, 3); SBAR();  GAPX(o[2] = MFMA32(VFR(6),  PAF(1), o[2]), ra_, C0, 12); \
    VRD(11); SBAR();              GAPX(o[3] = MFMA32(VFR(7),  PAF(1), o[3]), rb_, C0, 14); \
    VRD(12); KRD(GL, 4); SBAR();  GAPX(o[0] = MFMA32(VFR(8),  PAF(2), o[0]), ra_, C1, 0); \
    VRD(13); SBAR();              GAPX(o[1] = MFMA32(VFR(9),  PAF(2), o[1]), rb_, C1, 2); \
    VRD(14); KRD(GL, 5); SBAR();  GAPX(o[2] = MFMA32(VFR(10), PAF(2), o[2]), ra_, C1, 4); \
    VRD(15); SBAR();              GAPX(o[3] = MFMA32(VFR(11), PAF(2), o[3]), rb_, C1, 6); \
             KRD(GL, 6); SBAR();  GAPX(o[0] = MFMA32(VFR(12), PAF(3), o[0]), ra_, C1, 8); \
                                  GAPX(o[1] = MFMA32(VFR(13), PAF(3), o[1]), rb_, C1, 10); \
             KRD(GL, 7); SBAR();  GAPX(o[2] = MFMA32(VFR(14), PAF(3), o[2]), ra_, C1, 12); \
                                  GAPX(o[3] = MFMA32(VFR(15), PAF(3), o[3]), rb_, C1, 14); \
    { const float rm = half_max(__builtin_elementwise_maximum(ra_, rb_));                                                 \
      if (__builtin_expect(__any(rm > AT_THR), 0)) { const float dl = fmaxf(rm, 0.f); mref += dl;                          \
          const float al_ = __builtin_amdgcn_exp2f(-dl), nm_ = -mref; l *= al_; \
          _Pragma("unroll") for (int i_ = 0; i_ < 16; ++i_) { float a_ = C0[i_], b_ = C1[i_], c_ = negm[i_];                \
              asm volatile("v_mul_f32 %0, %0, %3\n\tv_mul_f32 %1, %1, %3\n\tv_mov_b32 %2, %4" : "+v"(a_), "+v"(b_), "+v"(c_) : "v"(al_), "v"(nm_)); C0[i_] = a_; C1[i_] = b_; negm[i_] = c_; } \
          _Pragma("unroll") for (int k_ = 0; k_ < 4; ++k_) _Pragma("unroll") for (int i_ = 0; i_ < 16; ++i_) { float a_ = o[k_][i_]; asm volatile("v_mul_f32 %0, %0, %1" : "+v"(a_) : "v"(al_)); o[k_][i_] = a_; } } } \
    } while (0)
    int t = 1;
#pragma unroll 1
    do {
        STEP(pB0, pB1, pA0, pA1, t, (t >= NT - 4), true, true, true);         WAIT_BAR(3); ROT();
        STEP(pA0, pA1, pB0, pB1, t + 1, (t + 1 >= NT - 4), true, true, true); WAIT_BAR(3); ROT();
        t += 2;
    } while (t + 2 < NT);
    STEP(pB0, pB1, pA0, pA1, NT - 2, true, false, true, true); WAIT_BAR(0); ROT();
    STEP(pA0, pA1, pB0, pB1, NT - 1, true, false, false, false);
    { float sacc = pA0[0] + pA0[1];
#pragma unroll
      for (int i = 2; i < 16; ++i) sacc += pA0[i];
#pragma unroll
      for (int i = 0; i < 16; ++i) sacc += pA1[i];
      l += sacc;
      pw0 = (v4u){PKW(pA0, 0), PKW(pA0, 2), PKW(pA0, 4), PKW(pA0, 6)}; pw1 = (v4u){PKW(pA0, 8), PKW(pA0, 10), PKW(pA0, 12), PKW(pA0, 14)};
      pw2 = (v4u){PKW(pA1, 0), PKW(pA1, 2), PKW(pA1, 4), PKW(pA1, 6)}; pw3 = (v4u){PKW(pA1, 8), PKW(pA1, 10), PKW(pA1, 12), PKW(pA1, 14)};
      const LAS unsigned char* vp_ = vp0 + 2 * sl_cur;
#pragma unroll
      for (int ks = 0; ks < 4; ++ks)
#pragma unroll
          for (int k = 0; k < 4; ++k) { const s16x4_t lo = vtr(vp_ + k * 4096 + ks * 1024), hi = vtr(vp_ + k * 4096 + ks * 1024 + 512);
              const bf16x8_t vf = __builtin_shufflevector(lo, hi, 0, 1, 2, 3, 4, 5, 6, 7);
              o[k] = MFMA32(vf, ks == 0 ? PAF(0) : ks == 1 ? PAF(1) : ks == 2 ? PAF(2) : PAF(3), o[k]); } }
#undef DMA_K
#undef DMA_V
#undef DMA_V0
#undef DMA_V1
#undef ROT
#undef KLOAD
#undef EX
#undef RESC
#undef PKW
#undef PAF
#undef VFR
#undef VRD
#undef KRD
#undef GAPA
#undef GAPB
#undef GAPX
#undef STEP
    l += half_swap(l);
    const float linv = (MP == 1 ? lam : 1.f) / l;
    int lz_ = F.lane; asm volatile("" : "+v"(lz_));
    LAS v4u* st = (LAS v4u*)at_stage(F.lds, wave) + lz_;
#pragma unroll
    for (int q = 0; q < 8; ++q) { const int k = q >> 1, i0 = 8 * (q & 1);
        if constexpr (MP == 1) { v4u w; w.x = cvtpk(o[k][i0] * linv, o[k][i0 + 1] * linv); w.y = cvtpk(o[k][i0 + 2] * linv, o[k][i0 + 3] * linv);
            w.z = cvtpk(o[k][i0 + 4] * linv, o[k][i0 + 5] * linv); w.w = cvtpk(o[k][i0 + 6] * linv, o[k][i0 + 7] * linv); st[q * 64] = w; }
        else { const v4u w = st[q * 64];
#pragma unroll
            for (int j = 0; j < 4; ++j) { const unsigned u = w[j];
                o[k][i0 + 2 * j] = o[k][i0 + 2 * j] * linv - __builtin_bit_cast(float, u << 16); o[k][i0 + 2 * j + 1] = o[k][i0 + 2 * j + 1] * linv - __builtin_bit_cast(float, u & 0xffff0000u); } }
    }
}
template <int VAR>
__device__ __forceinline__ void attn_unit(Frame& F, int b, int h, int qb, float lam) {
    const int lane = F.lane, wave = F.wave;
    bf16* MIX = (bf16*)(F.ws + (VAR == 0 ? WS_MIX : WS_HN));
    f32x16 o[4];
    attn_pass<1, VAR>(F, o, b, h, qb, lam);
    attn_pass<0, VAR>(F, o, b, h, qb, lam);
    int lz = F.lane; asm volatile("" : "+v"(lz));
    const int r = lz & 31, hh = lz >> 5;
    float ss = 0.f;
#pragma unroll
    for (int k = 0; k < 4; ++k)
#pragma unroll
        for (int i = 0; i < 16; ++i) ss += o[k][i] * o[k][i];
    ss += half_swap(ss);
    const float rinv = rsqrtf(ss * (1.f / 128.f) + EPS) * (1.f - LAMBDA_INIT);
    LAS unsigned char* sg = at_stage(F.lds, wave);
    const float* __restrict__ gsub = F.subln + 4 * hh;
#pragma unroll
    for (int k = 0; k < 4; ++k)
#pragma unroll
        for (int g = 0; g < 4; ++g) { const f32x4 g4 = *(const f32x4*)(gsub + 32 * k + 8 * g); v2u w;
            w.x = cvtpk(o[k][4 * g] * rinv * g4[0], o[k][4 * g + 1] * rinv * g4[1]); w.y = cvtpk(o[k][4 * g + 2] * rinv * g4[2], o[k][4 * g + 3] * rinv * g4[3]);
            *(LAS v2u*)(sg + r * 256 + ((64 * k + 16 * g + 8 * hh) ^ ((r & 15) << 4))) = w; }
    bf16* __restrict__ obase = MIX + ((size_t)b * SEQ + 256 * qb + 32 * wave + (lz >> 4)) * 1024 + 128 * h + (lz & 15) * 8;
#pragma unroll
    for (int j = 0; j < 8; ++j) { const int row = 4 * j + (lz >> 4); const v4u x = *(const LAS v4u*)(sg + row * 256 + (((lz & 15) ^ (row & 15)) << 4)); *(v4u*)(obase + (size_t)(4 * j) * 1024) = x; }
}
template <int VAR>
__device__ __forceinline__ void p4_attention(Frame& F) {
    float lam;
    { float s01 = 0.f, s23 = 0.f; for (int i = 0; i < 64; ++i) { s01 += F.dlam[i] * F.dlam[64 + i]; s23 += F.dlam[128 + i] * F.dlam[192 + i]; } lam = __expf(s01) - __expf(s23) + LAMBDA_INIT; }
    for (int v = F.vcu; v < 256; v += F.G) {
        const int bh = v >> 2, j = v & 3;
#pragma unroll 1
        for (int u = 0; u < 4; ++u) { const int qb = u == 0 ? j : u == 1 ? 15 - j : u == 2 ? 7 - j : 8 + j; attn_unit<VAR>(F, bh >> 2, bh & 3, qb, lam); }
    }
}

__device__ __forceinline__ void p2_ret_kv(Frame& F) {
    const int lane = F.lane, r = lane & 31, hh = lane >> 5, wave = F.wave;
    const bf16* RK = (const bf16*)(F.ws + WS_RK); const bf16* RV = (const bf16*)(F.ws + WS_RV); float* KVC = (float*)(F.ws + WS_KVC);
    const int eblk = wave & 3, dblk = wave >> 2;
    const int trl = (8 * hh + ((lane & 15) >> 2)) * 64 + ((lane >> 4) & 1) * 32 + (lane & 3) * 8;
    int buf = 0; bool first = true;
    for (int u = F.vcu; u < 64 * 32; u += F.G) {
        const int bh = u >> 5, n = u & 31, b = bh >> 2, h = bh & 3;
        if (first) {
            const size_t row0 = (size_t)b * RROWS + 128 * n;
#pragma unroll
            for (int i = 0; i < 2; ++i) { const int p = 2 * wave + i; GLDS16R(RK + (row0 + 16 * (p & 7) + (lane >> 2)) * 256 + 64 * h + 32 * (p >> 3) + 8 * (lane & 3), F.lds + (p >> 3) * 8192 + (p & 7) * 1024); }
#pragma unroll
            for (int i = 0; i < 4; ++i) { const int p = 4 * wave + i; GLDS16R(RV + (row0 + 16 * (p & 7) + (lane >> 2)) * 512 + 128 * h + 32 * (p >> 3) + 8 * (lane & 3), F.lds + 16384 + (p >> 3) * 8192 + (p & 7) * 1024); }
            first = false;
        }
        asm volatile("s_waitcnt vmcnt(0) lgkmcnt(0)" ::: "memory"); __builtin_amdgcn_s_barrier(); asm volatile("" ::: "memory");
        const int un = u + F.G;
        if (un < 64 * 32) {
            const int bh2 = un >> 5, n2 = un & 31, b2 = bh2 >> 2, h2 = bh2 & 3; const size_t row0 = (size_t)b2 * RROWS + 128 * n2; LAS unsigned char* nb = F.lds + (buf ^ 1) * 49152;
#pragma unroll
            for (int i = 0; i < 2; ++i) { const int p = 2 * wave + i; GLDS16R(RK + (row0 + 16 * (p & 7) + (lane >> 2)) * 256 + 64 * h2 + 32 * (p >> 3) + 8 * (lane & 3), nb + (p >> 3) * 8192 + (p & 7) * 1024); }
#pragma unroll
            for (int i = 0; i < 4; ++i) { const int p = 4 * wave + i; GLDS16R(RV + (row0 + 16 * (p & 7) + (lane >> 2)) * 512 + 128 * h2 + 32 * (p >> 3) + 8 * (lane & 3), nb + 16384 + (p >> 3) * 8192 + (p & 7) * 1024); }
        }
        const LAS unsigned char* cb = F.lds + buf * 49152;
        const LAS unsigned char* ap = cb + 16384 + eblk * 8192 + trl; const LAS unsigned char* bp = cb + dblk * 8192 + trl;
        f32x16 acc;
#pragma unroll
        for (int i = 0; i < 16; ++i) acc[i] = 0.f;
#pragma unroll
        for (int s_ = 0; s_ < 8; ++s_) {
            const s16x4_t al = vtr(ap + s_ * 1024), ah = vtr(ap + s_ * 1024 + 256), bl = vtr(bp + s_ * 1024), bhh = vtr(bp + s_ * 1024 + 256);
            acc = MFMA32(__builtin_shufflevector(al, ah, 0, 1, 2, 3, 4, 5, 6, 7), __builtin_shufflevector(bl, bhh, 0, 1, 2, 3, 4, 5, 6, 7), acc);
        }
        float* dst = KVC + ((size_t)u * 128 + 32 * eblk + 4 * hh) * 64 + 32 * dblk + r;
#pragma unroll
        for (int i = 0; i < 16; ++i) dst[(size_t)((i & 3) + 8 * (i >> 2)) * 64] = acc[i];
        buf ^= 1;
    }
    asm volatile("s_waitcnt vmcnt(0) lgkmcnt(0)" ::: "memory"); __builtin_amdgcn_s_barrier(); asm volatile("" ::: "memory");
}
__device__ __forceinline__ void p3_ret_scan(Frame& F) {
    const float* KVC = (const float*)(F.ws + WS_KVC); bf16* ST = (bf16*)(F.ws + WS_ST);
    for (int gid = F.vcu * 512 + F.tid; gid < 64 * 2048; gid += F.G * 512) {
        const int bh = gid >> 11, i4 = gid & 2047, h = bh & 3;
        const float l2g = log2f(1.f - exp2f(-5.f - (float)h)); const float gam = exp2f(l2g), g127 = exp2f(127.f * l2g), g128 = exp2f(128.f * l2g);
        const f32x4* __restrict__ src = (const f32x4*)(KVC + (size_t)bh * 32 * 8192) + i4; v2u* __restrict__ dst = (v2u*)(ST + (size_t)bh * 32 * 8192) + i4;
        f32x4 st = {0.f, 0.f, 0.f, 0.f};
        f32x4 kvv[32];
#pragma unroll
        for (int n = 0; n < 32; ++n) kvv[n] = src[(size_t)n * 2048];
#pragma unroll
        for (int n = 0; n < 32; ++n) { const f32x4 kv = kvv[n]; st = st * g128 + kv * g127; const f32x4 o = st * gam;
            v2u w; w.x = cvtpk(o[0], o[1]); w.y = cvtpk(o[2], o[3]); dst[(size_t)n * 2048] = w; }
    }
}
__device__ __forceinline__ void p2_ret_state(Frame& F) {
    int lane = F.lane; asm volatile("" : "+v"(lane));
    const int r = lane & 31, hh = lane >> 5, wave = F.wave;
    const bf16* RK = (const bf16*)(F.ws + WS_RK); const bf16* RV = (const bf16*)(F.ws + WS_RV); bf16* ST = (bf16*)(F.ws + WS_ST);
    const int trl = (8 * hh + ((lane & 15) >> 2)) * 64 + ((lane >> 4) & 1) * 32 + (lane & 3) * 8;
    constexpr int RS_SLOT = 24576;
    for (int w = F.vcu; w < 256; w += F.G) {
        const int bh = w >> 2, q = w & 3, b = bh >> 2, h = bh & 3;
        const float g128 = exp2f(128.f * log2f(1.f - exp2f(-5.f - (float)h)));
#define RS_DMA(n_, s_) do { const int nn_ = (n_) < 32 ? (n_) : 31; const size_t row0_ = (size_t)b * RROWS + 128 * nn_; LAS unsigned char* sl_ = F.lds + (s_) * RS_SLOT; \
            _Pragma("unroll") for (int i_ = 0; i_ < 2; ++i_) { const int p_ = 2 * wave + i_; GLDS16R(RK + (row0_ + 16 * (p_ & 7) + (lane >> 2)) * 256 + 64 * h + 32 * (p_ >> 3) + 8 * (lane & 3), sl_ + (p_ >> 3) * 8192 + (p_ & 7) * 1024); } \
            GLDS16R(RV + (row0_ + 16 * wave + (lane >> 2)) * 512 + 128 * h + 32 * q + 8 * (lane & 3), sl_ + 16384 + wave * 1024); } while (0)
        asm volatile("s_waitcnt vmcnt(0) lgkmcnt(0)" ::: "memory"); __builtin_amdgcn_s_barrier(); asm volatile("" ::: "memory");
        RS_DMA(0, 0); RS_DMA(1, 1); RS_DMA(2, 2); RS_DMA(3, 3);
        f32x16 st;
#pragma unroll
        for (int i = 0; i < 16; ++i) st[i] = 0.f;
        bf16* dst = ST + ((size_t)bh * 32 * 128 + 32 * q + r) * 64 + 32 * wave + 4 * hh;
        int slot = 0;
#pragma unroll 1
        for (int n = 0; n < 32; ++n) {
            if (wave < 2) { if (n == 0) asm volatile("s_waitcnt vmcnt(9)" ::: "memory"); else if (n == 1) asm volatile("s_waitcnt vmcnt(13)" ::: "memory");
                            else if (n == 2) asm volatile("s_waitcnt vmcnt(17)" ::: "memory"); else if (n == 3) asm volatile("s_waitcnt vmcnt(21)" ::: "memory"); else asm volatile("s_waitcnt vmcnt(25)" ::: "memory"); }
            else asm volatile("s_waitcnt vmcnt(9)" ::: "memory");
            asm volatile("s_waitcnt lgkmcnt(0)" ::: "memory"); __builtin_amdgcn_s_barrier(); asm volatile("" ::: "memory");
            { const int ns_ = slot + 4 >= 5 ? slot - 1 : slot + 4; RS_DMA(n + 4, ns_); }
            if (wave < 2) {
                const LAS unsigned char* cb = F.lds + slot * RS_SLOT;
                const LAS unsigned char* ap = cb + 16384 + trl; const LAS unsigned char* bp = cb + wave * 8192 + trl;
                f32x16 s2;
#pragma unroll
                for (int i = 0; i < 16; ++i) s2[i] = 0.f;
#pragma unroll
                for (int s_ = 0; s_ < 8; ++s_) {
                    const s16x4_t al = vtr(ap + s_ * 1024), ah = vtr(ap + s_ * 1024 + 256), bl = vtr(bp + s_ * 1024), bhh = vtr(bp + s_ * 1024 + 256);
                    if (s_ & 1) s2 = MFMA32(__builtin_shufflevector(bl, bhh, 0, 1, 2, 3, 4, 5, 6, 7), __builtin_shufflevector(al, ah, 0, 1, 2, 3, 4, 5, 6, 7), s2);
                    else st = MFMA32(__builtin_shufflevector(bl, bhh, 0, 1, 2, 3, 4, 5, 6, 7), __builtin_shufflevector(al, ah, 0, 1, 2, 3, 4, 5, 6, 7), st);
                }
#pragma unroll
                for (int i = 0; i < 16; ++i) st[i] = (st[i] + s2[i]) * g128;
#pragma unroll
                for (int g = 0; g < 4; ++g) { v2u wv; wv.x = cvtpk(st[4 * g], st[4 * g + 1]); wv.y = cvtpk(st[4 * g + 2], st[4 * g + 3]); *(v2u*)(dst + (size_t)n * 8192 + 8 * g) = wv; }
            }
            slot = slot == 4 ? 0 : slot + 1;
        }
#undef RS_DMA
    }
    asm volatile("s_waitcnt vmcnt(0) lgkmcnt(0)" ::: "memory"); __builtin_amdgcn_s_barrier(); asm volatile("" ::: "memory");
}
__device__ __forceinline__ void p4_ret_out(Frame& F) {
    int lane = F.lane; asm volatile("" : "+v"(lane));
    const int r = lane & 31, hh = lane >> 5, wave = F.wave, qw = wave & 3, eh = wave >> 2;
    const bf16* RQ = (const bf16*)(F.ws + WS_RQ); const bf16* RK = (const bf16*)(F.ws + WS_RK); const bf16* RV = (const bf16*)(F.ws + WS_RV); const bf16* RG = (const bf16*)(F.ws + WS_RG);
    const bf16* ST = (const bf16*)(F.ws + WS_ST); bf16* MIX = (bf16*)(F.ws + WS_MIX);
    LAS float* ssx = (LAS float*)(F.lds + 98304);
    const int NU = 64 * 32;
#define RO_DMA(u_, buf_) do { const int bh_ = (u_) >> 5, c_ = ((u_) & 31) + 1, b_ = bh_ >> 2, h_ = bh_ & 3; const size_t row0_ = (size_t)b_ * RROWS + 128 * c_; LAS unsigned char* kim_ = F.lds + (buf_) * 49152; \
        _Pragma("unroll") for (int i_ = 0; i_ < 2; ++i_) { const int p_ = 2 * wave + i_; GLDS16R(RK + (row0_ + 64 * (p_ & 1) + lane) * 256 + 64 * h_ + 8 * (p_ >> 1), kim_ + (p_ >> 1) * 2048 + (p_ & 1) * 1024); } \
        _Pragma("unroll") for (int i_ = 0; i_ < 4; ++i_) { const int p_ = 4 * wave + i_; GLDS16R(RV + (row0_ + 16 * (p_ & 7) + (lane >> 2)) * 512 + 128 * h_ + 32 * (p_ >> 3) + 8 * (lane & 3), kim_ + 16384 + (p_ >> 3) * 8192 + (p_ & 7) * 1024); } } while (0)
#define RO_REGS(u_, QF, SB, GV) do { const int bh_ = (u_) >> 5, c_ = ((u_) & 31) + 1, b_ = bh_ >> 2, h_ = bh_ & 3; const size_t tok_ = (size_t)b_ * SEQ + 128 * (c_ - 1) + 32 * qw + r; \
        _Pragma("unroll") for (int s_ = 0; s_ < 4; ++s_) QF[s_] = *(const bf16x8_t*)(RQ + tok_ * 256 + 64 * h_ + 16 * s_ + 8 * hh); \
        const bf16* sp_ = ST + ((size_t)(bh_ * 32 + (c_ - 1)) * 128 + 64 * eh + r) * 64 + 8 * hh; \
        _Pragma("unroll") for (int k_ = 0; k_ < 2; ++k_) _Pragma("unroll") for (int s_ = 0; s_ < 4; ++s_) SB[k_][s_] = *(const bf16x8_t*)(sp_ + (size_t)k_ * 32 * 64 + 16 * s_); \
        const bf16* gp_ = RG + tok_ * 512 + 128 * h_ + 64 * eh + 8 * hh; \
        _Pragma("unroll") for (int k_ = 0; k_ < 2; ++k_) _Pragma("unroll") for (int g_ = 0; g_ < 2; ++g_) GV[k_][g_] = *(const v4u*)(gp_ + 32 * k_ + 16 * g_); } while (0)
    bf16x8_t qf[4], sb[2][4], nqf[4], nsb[2][4]; v4u gv[2][2], ngv[2][2];
    int u = F.vcu;
    if (u < NU) { RO_REGS(u, qf, sb, gv); RO_DMA(u, 0); }
    int buf = 0;
    for (; u < NU; u += F.G) {
        asm volatile("s_waitcnt vmcnt(0) lgkmcnt(0)" ::: "memory"); __builtin_amdgcn_s_barrier(); asm volatile("" ::: "memory");
        const int un = u + F.G;
        f32x16 y[2];
#pragma unroll
        for (int k = 0; k < 2; ++k)
#pragma unroll
            for (int i = 0; i < 16; ++i) y[k][i] = 0.f;
#pragma unroll
        for (int s_ = 0; s_ < 4; ++s_)
#pragma unroll
            for (int k = 0; k < 2; ++k) y[k] = MFMA32(sb[k][s_], qf[s_], y[k]);
        if (un < NU) { RO_REGS(un, nqf, nsb, ngv); RO_DMA(un, buf ^ 1); }
        const int bh = u >> 5, c = (u & 31) + 1, b = bh >> 2, h = bh & 3;
        const LAS unsigned char* kimg = F.lds + buf * 49152; const LAS unsigned char* vimg = kimg + 16384;
        const LAS unsigned char* kfb = kimg + hh * 2048 + r * 16;
        const LAS unsigned char* vfb = vimg + (2 * eh) * 8192 + (4 * hh + ((lane & 15) >> 2)) * 64 + ((lane >> 4) & 1) * 32 + (lane & 3) * 8;
#pragma unroll 1
        for (int kvb = 0; kvb <= qw; ++kvb) {
            f32x16 p;
#pragma unroll
            for (int i = 0; i < 16; ++i) p[i] = 0.f;
#pragma unroll
            for (int s_ = 0; s_ < 4; ++s_) { const bf16x8_t kf = *(const LAS bf16x8_t*)(kfb + s_ * 4096 + kvb * 512); p = MFMA32(kf, qf[s_], p); }
            if (kvb == qw) {
#pragma unroll
                for (int i = 0; i < 16; ++i) if (crow(i, hh) > r) p[i] = 0.f;
            }
            const bf16x8_t pa0 = pack8(p, 0), pa1 = pack8(p, 8);
#pragma unroll
            for (int k = 0; k < 2; ++k) {
                const LAS unsigned char* vp = vfb + k * 8192 + kvb * 2048;
                const s16x4_t l0 = vtr(vp), h0 = vtr(vp + 512), l1 = vtr(vp + 1024), h1 = vtr(vp + 1536);
                y[k] = MFMA32(__builtin_shufflevector(l0, h0, 0, 1, 2, 3, 4, 5, 6, 7), pa0, y[k]);
                y[k] = MFMA32(__builtin_shufflevector(l1, h1, 0, 1, 2, 3, 4, 5, 6, 7), pa1, y[k]);
            }
        }
        float ss = 0.f;
#pragma unroll
        for (int k = 0; k < 2; ++k)
#pragma unroll
            for (int i = 0; i < 16; ++i) ss += y[k][i] * y[k][i];
        ss += half_swap(ss);
        if (hh == 0) ssx[wave * 32 + r] = ss;
        asm volatile("s_waitcnt lgkmcnt(0)" ::: "memory"); __builtin_amdgcn_s_barrier(); asm volatile("" ::: "memory");
        const float rinv = rsqrtf((ss + ssx[(wave ^ 4) * 32 + r]) * (1.f / 128.f) + EPS);
        bf16* __restrict__ orow = MIX + ((size_t)b * SEQ + 128 * (c - 1) + 32 * qw + r) * 1024 + 512 + 128 * h + 64 * eh + 8 * hh;
#pragma unroll
        for (int k = 0; k < 2; ++k)
#pragma unroll
            for (int gp = 0; gp < 2; ++gp) {
                unsigned ga0 = gv[k][gp].x, ga1 = gv[k][gp].y, gb0 = gv[k][gp].z, gb1 = gv[k][gp].w;
                swap32(ga0, gb0); swap32(ga1, gb1);
                v2u wq[2];
#pragma unroll
                for (int gg = 0; gg < 2; ++gg) { const int g = 2 * gp + gg; float o4[4];
#pragma unroll
                    for (int j = 0; j < 4; ++j) { const unsigned gw_ = gg == 0 ? (j < 2 ? ga0 : ga1) : (j < 2 ? gb0 : gb1); const float gt = __builtin_bit_cast(float, (j & 1) ? (gw_ & 0xffff0000u) : (gw_ << 16));
                        const float sg = gt * __builtin_amdgcn_rcpf(1.f + __builtin_amdgcn_exp2f(-1.4426950408889634f * gt)); o4[j] = y[k][4 * g + j] * rinv * sg; }
                    wq[gg].x = cvtpk(o4[0], o4[1]); wq[gg].y = cvtpk(o4[2], o4[3]); }
                unsigned a0 = wq[0].x, a1 = wq[0].y, b0 = wq[1].x, b1 = wq[1].y;
                swap32(a0, b0); swap32(a1, b1);
                v4u w; w.x = a0; w.y = a1; w.z = b0; w.w = b1;
                *(v4u*)(orow + 32 * k + 16 * gp) = w; }
#pragma unroll
        for (int s_ = 0; s_ < 4; ++s_) { qf[s_] = nqf[s_]; sb[0][s_] = nsb[0][s_]; sb[1][s_] = nsb[1][s_]; }
#pragma unroll
        for (int k = 0; k < 2; ++k)
#pragma unroll
            for (int g = 0; g < 2; ++g) gv[k][g] = ngv[k][g];
        buf ^= 1;
    }
#undef RO_DMA
#undef RO_REGS
    asm volatile("s_waitcnt vmcnt(0) lgkmcnt(0)" ::: "memory"); __builtin_amdgcn_s_barrier(); asm volatile("" ::: "memory");
}

struct EpiOutProj {
    static constexpr bool PERM = true;
    const float* __restrict__ x; bf16* __restrict__ h1;
    __device__ __forceinline__ void prefetch(const pg8::Unit&, LAS unsigned char*, int, int) const {}
    __device__ __forceinline__ void operator()(const pg8::f32x4 (&acc)[2][2][4][2], const pg8::Unit& u, int wr, int wc, int fr, int fq, const LAS unsigned char* tab) const {
        const int row0 = u.pm * 256 + wr * 64 + fr, col0 = u.pn * 256 + wc * 32 + 8 * fq;
#pragma unroll
        for (int ai = 0; ai < 2; ++ai) {
            pg8::f32x4 xr[4][2][2];
#pragma unroll
            for (int m = 0; m < 4; ++m) { const size_t off = (size_t)(row0 + ai * 128 + m * 16) * D + col0;
#pragma unroll
                for (int bj = 0; bj < 2; ++bj)
#pragma unroll
                    for (int n = 0; n < 2; ++n) xr[m][bj][n] = *(const pg8::f32x4*)(x + off + bj * 128 + n * 4); }
#pragma unroll
            for (int m = 0; m < 4; ++m) { const size_t off = (size_t)(row0 + ai * 128 + m * 16) * D + col0;
#pragma unroll
                for (int bj = 0; bj < 2; ++bj) { const pg8::f32x4 v0 = xr[m][bj][0] + acc[ai][bj][m][0], v1 = xr[m][bj][1] + acc[ai][bj][m][1]; pg8::u32x4 w;
                    w.x = pg8::cvt_pk_bf16(v0[0], v0[1]); w.y = pg8::cvt_pk_bf16(v0[2], v0[3]); w.z = pg8::cvt_pk_bf16(v1[0], v1[1]); w.w = pg8::cvt_pk_bf16(v1[2], v1[3]);
                    *(pg8::u32x4*)(h1 + off + bj * 128) = w; } }
        }
    }
};

typedef float f32x16 __attribute__((ext_vector_type(16)));
typedef short s16x8 __attribute__((ext_vector_type(8)));
__device__ __forceinline__ void p6_router(Frame& F) {
    LAS int* hist = (LAS int*)(F.lds + RING_BYTES + 512);
    LAS unsigned char* xbw = F.lds + F.wave * 16384;
    LAS float* wl = (LAS float*)xbw;
    LAS float* rsb = wl + 32 * 36;
    const bf16* h1 = (const bf16*)(F.ws + WS_H1); bf16* XN2 = (bf16*)(F.ws + WS_XN2); const bf16* wrf = (const bf16*)(F.ws + WS_WRF);
    int* TOPE = (int*)(F.ws + WS_TOPE); float* TOPG = (float*)(F.ws + WS_TOPG); int* RANK = (int*)(F.ws + WS_RANK); float* RSTD = (float*)(F.ws + WS_RSTD);
    const int r = F.lane & 31, hi = F.lane >> 5;
    LAS float* gsh = (LAS float*)(F.lds + RING_BYTES + 1024);
    for (int i = F.tid; i < D; i += NWAVES * 64) gsh[i] = F.ffn_g[i];
    const LAS float* gl = gsh + 8 * hi;
    const int l4 = F.lane >> 4, l15 = F.lane & 15;
    for (int c = F.vcu; c < T / 256; c += F.G) {
        if (F.tid < NE) hist[F.tid] = 0;
        __syncthreads();
        const int row0 = c * 256 + F.wave * 32;
        const bf16* __restrict__ wrfp = wrf + (size_t)F.lane * 8;
        const bf16* xbase = h1 + (size_t)row0 * D;
        unsigned char* xo8 = (unsigned char*)XN2 + (size_t)row0 * D;
#define RT_DMA(cc, bufo) do { _Pragma("unroll") for (int i_ = 0; i_ < 8; ++i_) { const unsigned vo_ = (unsigned)l4 * (D * 2) + (unsigned)((l15 ^ ((4 * i_ + l4) & 15)) << 4); \
            glds16_sbase(xbase + (size_t)(4 * i_) * D + (cc) * 128, vo_, xbw + (bufo) + i_ * 1024); } } while (0)
        f32x16 acc;
#pragma unroll
        for (int i = 0; i < 16; ++i) acc[i] = 0.f;
        float ss = 0.f;
        const unsigned rdo = (unsigned)((r >> 2) * 1024 + ((r & 3) << 8)), rsw = (unsigned)(r & 15);
        v4u wa[8], wb[8];
#define RT_LOADW(W, s0) do { _Pragma("unroll") for (int q_ = 0; q_ < 4; ++q_) { \
            W[2 * q_] = *(const v4u*)(wrfp + (size_t)((s0) + q_) * 512); W[2 * q_ + 1] = *(const v4u*)(wrfp + (size_t)(4096 + ((s0) + q_) * 64) * 8); } } while (0)
#define RT_STEP(W, s0, xbuf) do { _Pragma("unroll") for (int q_ = 0; q_ < 4; ++q_) { const int sl_ = ((s0) + q_) & 7; \
            const v4u xw = *(const LAS v4u*)((xbuf) + rdo + (((unsigned)(2 * sl_ + hi) ^ rsw) << 4)); \
            const f32x4 x0 = {__builtin_bit_cast(float, xw.x << 16), __builtin_bit_cast(float, xw.x & 0xffff0000u), __builtin_bit_cast(float, xw.y << 16), __builtin_bit_cast(float, xw.y & 0xffff0000u)}; \
            const f32x4 x1 = {__builtin_bit_cast(float, xw.z << 16), __builtin_bit_cast(float, xw.z & 0xffff0000u), __builtin_bit_cast(float, xw.w << 16), __builtin_bit_cast(float, xw.w & 0xffff0000u)}; \
            ss += (x0[0] * x0[0] + x0[1] * x0[1]) + (x0[2] * x0[2] + x0[3] * x0[3]) + (x1[0] * x1[0] + x1[1] * x1[1]) + (x1[2] * x1[2] + x1[3] * x1[3]); \
            const f32x4 y0 = x0 * *(const LAS f32x4*)(gl + 16 * ((s0) + q_)), y1 = x1 * *(const LAS f32x4*)(gl + 16 * ((s0) + q_) + 4); v4u ah, al; \
            ah.x = pg8::cvt_pk_bf16(y0[0], y0[1]); ah.y = pg8::cvt_pk_bf16(y0[2], y0[3]); ah.z = pg8::cvt_pk_bf16(y1[0], y1[1]); ah.w = pg8::cvt_pk_bf16(y1[2], y1[3]); \
            al.x = pg8::cvt_pk_bf16(y0[0] - __builtin_bit_cast(float, ah.x << 16), y0[1] - __builtin_bit_cast(float, ah.x & 0xffff0000u)); \
            al.y = pg8::cvt_pk_bf16(y0[2] - __builtin_bit_cast(float, ah.y << 16), y0[3] - __builtin_bit_cast(float, ah.y & 0xffff0000u)); \
            al.z = pg8::cvt_pk_bf16(y1[0] - __builtin_bit_cast(float, ah.z << 16), y1[1] - __builtin_bit_cast(float, ah.z & 0xffff0000u)); \
            al.w = pg8::cvt_pk_bf16(y1[2] - __builtin_bit_cast(float, ah.w << 16), y1[3] - __builtin_bit_cast(float, ah.w & 0xffff0000u)); \
            const s16x8 Ah = __builtin_bit_cast(s16x8, ah), Al = __builtin_bit_cast(s16x8, al), Bh = __builtin_bit_cast(s16x8, W[2 * q_]), Bl = __builtin_bit_cast(s16x8, W[2 * q_ + 1]); \
            acc = __builtin_amdgcn_mfma_f32_32x32x16_bf16(Ah, Bh, acc, 0, 0, 0); acc = __builtin_amdgcn_mfma_f32_32x32x16_bf16(Al, Bh, acc, 0, 0, 0); acc = __builtin_amdgcn_mfma_f32_32x32x16_bf16(Ah, Bl, acc, 0, 0, 0); } } while (0)
#define RT_FP8(cc, xbuf) do { _Pragma("unroll") for (int i_ = 0; i_ < 8; ++i_) { const int row_ = 4 * i_ + l4, p_ = l15 ^ (row_ & 15); \
            const v4u xw = *(const LAS v4u*)((xbuf) + i_ * 1024 + F.lane * 16); const LAS float* g_ = gsh + (cc) * 128 + p_ * 8; const f32x4 g0 = *(const LAS f32x4*)g_, g1 = *(const LAS f32x4*)(g_ + 4); \
            v2u x8; x8.x = pk_fp8x4(__builtin_bit_cast(float, xw.x << 16) * g0[0], __builtin_bit_cast(float, xw.x & 0xffff0000u) * g0[1], __builtin_bit_cast(float, xw.y << 16) * g0[2], __builtin_bit_cast(float, xw.y & 0xffff0000u) * g0[3]); \
            x8.y = pk_fp8x4(__builtin_bit_cast(float, xw.z << 16) * g1[0], __builtin_bit_cast(float, xw.z & 0xffff0000u) * g1[1], __builtin_bit_cast(float, xw.w << 16) * g1[2], __builtin_bit_cast(float, xw.w & 0xffff0000u) * g1[3]); \
            *(v2u*)(xo8 + (size_t)row_ * D + (cc) * 128 + p_ * 8) = x8; } } while (0)
        asm volatile("s_waitcnt lgkmcnt(0)" ::: "memory");
        RT_DMA(0, 0);
        RT_LOADW(wa, 0);
#pragma unroll 1
        for (int cc = 0; cc < 8; ++cc) {
            const unsigned bo = (unsigned)(cc & 1) * 8192u;
            if (cc + 1 < 8) { RT_DMA(cc + 1, 8192u - bo); asm volatile("s_waitcnt vmcnt(8)" ::: "memory"); }
            else asm volatile("s_waitcnt vmcnt(0)" ::: "memory");
            const LAS unsigned char* xbuf = xbw + bo;
            RT_FP8(cc, xbuf);
            RT_LOADW(wb, 8 * cc + 4);
            RT_STEP(wa, 8 * cc, xbuf);
            if (cc + 1 < 8) { RT_LOADW(wa, 8 * cc + 8); }
            RT_STEP(wb, 8 * cc + 4, xbuf);
            asm volatile("s_waitcnt lgkmcnt(0)" ::: "memory");
        }
#undef RT_DMA
#undef RT_LOADW
#undef RT_STEP
#undef RT_FP8
        ss += __shfl_xor(ss, 32);
        const float rstd = rsqrtf(ss * (1.f / D) + EPS);
        if (hi == 0) { rsb[r] = rstd; RSTD[row0 + r] = rstd; }
        LDS_WAIT(); asm volatile("" ::: "memory");
        const float bias = F.b_router[r];
#pragma unroll
        for (int i = 0; i < 16; ++i) { const int row = (i & 3) + 8 * (i >> 2) + 4 * hi; wl[row * 36 + r] = acc[i] * rsb[row] + bias; }
        LDS_WAIT(); asm volatile("" ::: "memory");
        if (hi == 0) {
            float v0 = -INFINITY, v1 = -INFINITY, v2 = -INFINITY, v3 = -INFINITY; int i0 = 0, i1 = 0, i2 = 0, i3 = 0;
#pragma unroll
            for (int q = 0; q < 8; ++q) { const f32x4 lv = *(const LAS f32x4*)(wl + r * 36 + 4 * q);
#pragma unroll
                for (int jj = 0; jj < 4; ++jj) { const float xv = lv[jj]; const int e = 4 * q + jj;
                    if (xv > v3) {
                        if (xv > v0) { v3 = v2; i3 = i2; v2 = v1; i2 = i1; v1 = v0; i1 = i0; v0 = xv; i0 = e; }
                        else if (xv > v1) { v3 = v2; i3 = i2; v2 = v1; i2 = i1; v1 = xv; i1 = e; }
                        else if (xv > v2) { v3 = v2; i3 = i2; v2 = xv; i2 = e; }
                        else { v3 = xv; i3 = e; }
                    } } }
            const float e1 = __expf(v1 - v0), e2 = __expf(v2 - v0), e3 = __expf(v3 - v0); const float inv = 1.f / (1.f + e1 + e2 + e3);
            const int tok = row0 + r;
            *(int4*)(TOPE + tok * 4) = make_int4(i0, i1, i2, i3);
            *(float4*)(TOPG + tok * 4) = make_float4(inv, e1 * inv, e2 * inv, e3 * inv);
            const int r0 = __hip_atomic_fetch_add(&hist[i0], 1, __ATOMIC_RELAXED, __HIP_MEMORY_SCOPE_WORKGROUP), r1 = __hip_atomic_fetch_add(&hist[i1], 1, __ATOMIC_RELAXED, __HIP_MEMORY_SCOPE_WORKGROUP),
                      r2 = __hip_atomic_fetch_add(&hist[i2], 1, __ATOMIC_RELAXED, __HIP_MEMORY_SCOPE_WORKGROUP), r3 = __hip_atomic_fetch_add(&hist[i3], 1, __ATOMIC_RELAXED, __HIP_MEMORY_SCOPE_WORKGROUP);
            *(int4*)(RANK + tok * 4) = make_int4(r0, r1, r2, r3);
        }
        __syncthreads();
        if (F.tid < NE) hist[NE + F.tid] = (int)__hip_atomic_fetch_add((unsigned*)(F.ws + WS_CTL) + CW_GCNT + 64 * F.tid, (unsigned)hist[F.tid], __ATOMIC_RELAXED, __HIP_MEMORY_SCOPE_AGENT);
        __syncthreads();
        { int* RT = (int*)(F.ws + WS_ROWTOK_S); float* RR = (float*)(F.ws + WS_ROWRSTD_S); float* RGt = (float*)(F.ws + WS_ROWGATE_S);
          const int tok = c * 256 + (F.tid >> 1); const float rs = RSTD[tok];
#pragma unroll
          for (int kk = 0; kk < 2; ++kk) { const int k = (F.tid & 1) * 2 + kk; const int e = TOPE[tok * 4 + k]; const int dst = e * CAP + hist[NE + e] + RANK[tok * 4 + k];
              RT[dst] = tok * 4 + k; RR[dst] = rs; RGt[dst] = TOPG[tok * 4 + k]; } }
        __syncthreads();
    }
}

struct MoeOrder {
    const LAS int* te; const int* rowtok; int npn, G, c, Kb;
    __device__ __forceinline__ bool next(int i, pg8::Unit& u) const {
        const int L = i * G + c; const int nt = __builtin_amdgcn_readfirstlane(te[NTILES_MAX]);
        if (L >= nt * npn) return false;
        u.pm = L / npn; u.pn = L - u.pm * npn; u.e = __builtin_amdgcn_readfirstlane(te[u.pm]); u.sb = __builtin_amdgcn_readfirstlane(te[NTILES_MAX + 8 + u.pm]); return true;
    }
    __device__ __forceinline__ unsigned rowoff(const pg8::Unit& u, int r) const { const int v = rowtok[u.sb + r]; return (unsigned)(v < 0 ? 0 : (v >> 2)) * (unsigned)Kb; }
};
__device__ __forceinline__ void moe_tile_table(Frame& F) {
    LAS int* te = (LAS int*)(F.lds + TILE_E_OFF); LAS int* ts = te + NTILES_MAX + 8; LAS int* tb = (LAS int*)F.lds;
    const unsigned* gc = (const unsigned*)(F.ws + WS_CTL) + CW_GCNT;
    __syncthreads();
    if (F.tid == 0) { int p = 0; for (int e = 0; e < NE; ++e) { tb[e] = p; p += ((int)gc[64 * e] + 255) >> 8; } tb[NE] = p; te[NTILES_MAX] = p; }
    __syncthreads();
    for (int i = F.tid; i < NTILES_MAX; i += NWAVES * 64) { int e = 0;
#pragma unroll 1
        for (int q = 1; q < NE; ++q) e += (tb[q] <= i) ? 1 : 0;
        const bool ok = i < tb[NE]; te[i] = ok ? e : 0; ts[i] = ok ? e * CAP + 256 * (i - tb[e]) : 0; }
    __syncthreads();
}
__device__ __forceinline__ void swap16(unsigned& a, unsigned& b) { asm volatile("s_nop 1\n\tv_permlane16_swap_b32 %0, %1\n\ts_nop 1" : "+v"(a), "+v"(b)); }
#define SWAP16(A, B) do { unsigned a_ = (A), b_ = (B); swap16(a_, b_); (A) = a_; (B) = b_; } while (0)
struct EpiUp {
    static constexpr bool PERM = true;
    const float* __restrict__ bup; unsigned char* __restrict__ HB; const float* __restrict__ rowrstd;
    __device__ __forceinline__ void prefetch(const pg8::Unit& u, LAS unsigned char* tab, int wid, int lane) const {
        if (wid == 0) GLDS16R(bup + (size_t)u.e * 2048 + 256 * u.pn + 4 * lane, tab);
        else if (wid == 2) GLDS16R(rowrstd + (size_t)u.sb + 4 * lane, tab + 2048);
    }
    __device__ __forceinline__ void operator()(const pg8::f32x4 (&acc)[2][2][4][2], const pg8::Unit& u, int wr, int wc, int fr, int fq, const LAS unsigned char* tab) const {
        const int j0 = 128 * u.pn + 32 * wc + 8 * fq;
        const LAS float* tb = (const LAS float*)tab + 2 * (32 * wc + 8 * fq);
        pg8::f32x4 b4[4];
#pragma unroll
        for (int q = 0; q < 4; ++q) b4[q] = ((const LAS pg8::f32x4*)tb)[q];
        float rs8[2][4];
#pragma unroll
        for (int ai = 0; ai < 2; ++ai)
#pragma unroll
            for (int m = 0; m < 4; ++m) rs8[ai][m] = ((const LAS float*)(tab + 2048))[ai * 128 + wr * 64 + m * 16 + fr];
#pragma unroll
        for (int ai = 0; ai < 2; ++ai)
#pragma unroll
            for (int mp = 0; mp < 4; mp += 2) {
                v2u w2[2];
#pragma unroll
                for (int mm = 0; mm < 2; ++mm) { const int m = mp + mm; const float rsd = rs8[ai][m] * WDESCALE;
                    float o[8];
#pragma unroll
                    for (int n = 0; n < 2; ++n)
#pragma unroll
                        for (int i = 0; i < 4; ++i) {
                            float glu = acc[ai][0][m][n][i] * rsd + b4[2 * n + (i >> 1)][2 * (i & 1)], lin = acc[ai][1][m][n][i] * rsd + b4[2 * n + (i >> 1)][2 * (i & 1) + 1];
                            glu = fminf(glu, 7.f); lin = fminf(fmaxf(lin, -7.f), 7.f);
                            const float sg = __builtin_amdgcn_rcpf(1.f + __builtin_amdgcn_exp2f(-1.702f * 1.4426950408889634f * glu));
                            o[4 * n + i] = glu * sg * (lin + 1.f);
                        }
                    w2[mm].x = pk_fp8x4(o[0], o[1], o[2], o[3]); w2[mm].y = pk_fp8x4(o[4], o[5], o[6], o[7]); }
                SWAP16(w2[0].x, w2[1].x); SWAP16(w2[0].y, w2[1].y);
                const size_t row = (size_t)u.pm * 256 + ai * 128 + wr * 64 + (mp + (fq & 1)) * 16 + fr;
                v4u w; w.x = w2[0].x; w.y = w2[0].y; w.z = w2[1].x; w.w = w2[1].y;
                *(v4u*)(HB + row * D + j0 - 8 * (fq & 1)) = w;
            }
    }
};
struct EpiDown {
    static constexpr bool PERM = true;
    const int* __restrict__ rowtok; const float* __restrict__ rowgate; const float* __restrict__ bdn; unsigned char* __restrict__ ws;
    __device__ __forceinline__ void prefetch(const pg8::Unit& u, LAS unsigned char* tab, int wid, int lane) const {
        if (wid == 0) GLDS16R(bdn + (size_t)u.e * D + 256 * u.pn + 4 * lane, tab);
        else if (wid == 1) GLDS16R(rowtok + (size_t)u.sb + 4 * lane, tab + 1024);
        else if (wid == 2) GLDS16R(rowgate + (size_t)u.sb + 4 * lane, tab + 2048);
    }
    __device__ __forceinline__ void operator()(const pg8::f32x4 (&acc)[2][2][4][2], const pg8::Unit& u, int wr, int wc, int fr, int fq, const LAS unsigned char* tab) const {
        const int c0 = 256 * u.pn + 32 * wc + 8 * fq;
        const LAS float* bb = (const LAS float*)tab + 32 * wc + 8 * fq;
        pg8::f32x4 b4[2][2];
#pragma unroll
        for (int bj = 0; bj < 2; ++bj)
#pragma unroll
            for (int n = 0; n < 2; ++n) b4[bj][n] = *(const LAS pg8::f32x4*)(bb + 128 * bj + 4 * n);
        int tk8[2][4]; float gt8[2][4];
#pragma unroll
        for (int ai = 0; ai < 2; ++ai)
#pragma unroll
            for (int m = 0; m < 4; ++m) { tk8[ai][m] = ((const LAS int*)(tab + 1024))[ai * 128 + wr * 64 + m * 16 + fr]; gt8[ai][m] = ((const LAS float*)(tab + 2048))[ai * 128 + wr * 64 + m * 16 + fr]; }
#pragma unroll
        for (int ai = 0; ai < 2; ++ai)
#pragma unroll
            for (int m = 0; m < 4; ++m) {
                const int tk = tk8[ai][m];
                if (tk >= 0) {
                    const float gate = gt8[ai][m] * SLOT_SCALE; const float gsc = gate * WDESCALE; const int k = tk & 3;
                    const size_t soff = k == 0 ? WS_SLOT0 : (k == 1 ? WS_SLOT1 : (k == 2 ? WS_SLOT2 : WS_SLOT3));
                    unsigned char* p = (ws + soff) + (size_t)(tk >> 2) * D + c0;
                    v2u w2[2];
#pragma unroll
                    for (int bj = 0; bj < 2; ++bj) { const pg8::f32x4 v0 = acc[ai][bj][m][0] * gsc + b4[bj][0] * gate, v1 = acc[ai][bj][m][1] * gsc + b4[bj][1] * gate;
                        w2[bj].x = pk_fp8x4(v0[0], v0[1], v0[2], v0[3]); w2[bj].y = pk_fp8x4(v1[0], v1[1], v1[2], v1[3]); }
                    SWAP16(w2[0].x, w2[1].x); SWAP16(w2[0].y, w2[1].y);
                    v4u w; w.x = w2[0].x; w.y = w2[0].y; w.z = w2[1].x; w.w = w2[1].y;
                    *(v4u*)(p + 120 * (fq & 1)) = w;
                }
            }
    }
};
__device__ __forceinline__ void p10_final(Frame& F) {
    const int gw = F.vcu * NWAVES + F.wave, NGW = F.G * NWAVES;
    const unsigned char* s0 = F.ws + WS_SLOT0; const unsigned char* s1 = F.ws + WS_SLOT1; const unsigned char* s2 = F.ws + WS_SLOT2; const unsigned char* s3 = F.ws + WS_SLOT3;
    typedef float f32x2v __attribute__((ext_vector_type(2)));
#pragma unroll 2
    for (int m = gw; m < T; m += NGW) {
        const uint2* __restrict__ pin = (const uint2*)((const bf16*)(F.ws + WS_H1) + (size_t)m * D); float4* __restrict__ p = (float4*)(F.out + (size_t)m * D);
        float4 v[4]; float ss = 0.f;
#pragma unroll
        for (int q = 0; q < 4; ++q) { { const v2u hw_ = __builtin_nontemporal_load((const v2u*)pin + F.lane + 64 * q); const uint2 hw = make_uint2(hw_.x, hw_.y); v[q] = make_float4(__builtin_bit_cast(float, hw.x << 16), __builtin_bit_cast(float, hw.x & 0xffff0000u), __builtin_bit_cast(float, hw.y << 16), __builtin_bit_cast(float, hw.y & 0xffff0000u)); }
            const int z = __builtin_nontemporal_load((const int*)(s0 + (size_t)m * D) + F.lane + 64 * q), a = __builtin_nontemporal_load((const int*)(s1 + (size_t)m * D) + F.lane + 64 * q), b = __builtin_nontemporal_load((const int*)(s2 + (size_t)m * D) + F.lane + 64 * q), c = __builtin_nontemporal_load((const int*)(s3 + (size_t)m * D) + F.lane + 64 * q);
            const f32x2v zl = __builtin_amdgcn_cvt_pk_f32_fp8(z, false), zh = __builtin_amdgcn_cvt_pk_f32_fp8(z, true), al = __builtin_amdgcn_cvt_pk_f32_fp8(a, false), ah = __builtin_amdgcn_cvt_pk_f32_fp8(a, true);
            const f32x2v bl = __builtin_amdgcn_cvt_pk_f32_fp8(b, false), bh = __builtin_amdgcn_cvt_pk_f32_fp8(b, true), cl = __builtin_amdgcn_cvt_pk_f32_fp8(c, false), ch = __builtin_amdgcn_cvt_pk_f32_fp8(c, true);
            v[q].x += ((zl[0] + al[0]) + (bl[0] + cl[0])) * (1.f / SLOT_SCALE); v[q].y += ((zl[1] + al[1]) + (bl[1] + cl[1])) * (1.f / SLOT_SCALE);
            v[q].z += ((zh[0] + ah[0]) + (bh[0] + ch[0])) * (1.f / SLOT_SCALE); v[q].w += ((zh[1] + ah[1]) + (bh[1] + ch[1])) * (1.f / SLOT_SCALE);
            ss += v[q].x * v[q].x + v[q].y * v[q].y + v[q].z * v[q].z + v[q].w * v[q].w; }
        const float rs = rsqrtf(wave_sum(ss) * (1.f / D) + EPS);
#pragma unroll
        for (int q = 0; q < 4; ++q) { const float4 gg = ((const float4*)F.final_g)[F.lane + 64 * q]; { f32x4 ov = {v[q].x * rs * gg.x, v[q].y * rs * gg.y, v[q].z * rs * gg.z, v[q].w * rs * gg.w}; __builtin_nontemporal_store(ov, (f32x4*)p + F.lane + 64 * q); } }
    }
}

__global__ void __launch_bounds__(NWAVES * 64, 2) mk_fwd(Args args) {
    extern __shared__ __attribute__((aligned(16))) unsigned char lds[];
    Frame F;
    F.lds = (LAS unsigned char*)lds;
    F.tid = threadIdx.x; F.lane = F.tid & 63; F.wave = __builtin_amdgcn_readfirstlane(F.tid >> 6);
    F.G = gridDim.x; { const int bx = blockIdx.x; F.vcu = (F.G % 8 == 0) ? (bx % 8) * (F.G / 8) + bx / 8 : bx; }
    F.x = args.in[0]; F.meta = args.in[1]; F.attn_g = args.in[2]; F.w_in = args.in[3]; F.dlam = args.in[4]; F.subln = args.in[5]; F.w_out = args.in[6]; F.ffn_g = args.in[7];
    F.w_router = args.in[8]; F.b_router = args.in[9]; F.w_up = args.in[10]; F.b_up = args.in[11]; F.w_down = args.in[12]; F.b_down = args.in[13]; F.final_g = args.in[14];
    F.out = args.out; F.ws = args.ws;
    volatile LAS unsigned* MISC = (volatile LAS unsigned*)(F.lds + MISC_OFF);
    for (int u = F.tid; u < (TILE_E_OFF - LDSCTL_OFF) / 4; u += NWAVES * 64) ((LAS unsigned*)(F.lds + LDSCTL_OFF))[u] = 0u;
    __syncthreads();
    unsigned* ctl = (unsigned*)(F.ws + WS_CTL);
    XcdBarrier bar = xcd_barrier_post(ctl + CW_BAR + args.li * XCD_BAR_WORDS, MISC + 8);
    const int lo = args.ph_lo, hi = args.ph_hi;
#define IN(k) (lo <= (k) && (k) < hi)
#define BOTH(k) (IN(k) && IN((k) + 1))

    if (IN(0)) { p0_prologue(F); if (BOTH(0)) xcd_barrier(bar); }

    if (IN(1)) {
        pg8::Gemm g{(const bf16*)(F.ws + WS_HN), (const bf16*)(F.ws + WS_WIN), T, NPROJ, D, 0};
        pg8::StaticOrder S; S.init(T, NPROJ, F.G, (int)blockIdx.x);
        EpiInProj E{(bf16*)(F.ws + WS_DQ), (bf16*)(F.ws + WS_DK), (bf16*)(F.ws + WS_DV), (bf16*)(F.ws + WS_RQ), (bf16*)(F.ws + WS_RK), (bf16*)(F.ws + WS_RV), (bf16*)(F.ws + WS_RG),
                    (const float2*)(F.ws + WS_ROPE_D)};
        if (F.tid < 128) { const int par_ = F.tid >> 6, i_ = F.tid & 63;
            ((LAS float*)(F.lds + pg8::EPI_TAB_OFF + par_ * pg8::EPI_TAB_BYTES))[i_] = (i_ < 32 ? inv_freq_d(i_) : inv_freq_r(i_ - 32)) * 0.15915494309189535f; }
        __syncthreads();
        pg8::gemm_phase<EpiInProj, pg8::StaticOrder, true, false>(F.lds, g, S, E);
        if (BOTH(1)) xcd_barrier(bar);
    }

    if (IN(2)) { p2_ret_state(F); if (BOTH(2)) xcd_barrier(bar); }
    if (IN(4)) { p4_ret_out(F); p4_attention<0>(F); if (BOTH(4)) xcd_barrier(bar); }

    if (IN(5)) {
        pg8::Gemm g{(const bf16*)(F.ws + WS_MIX), (const bf16*)(F.ws + WS_WOUT), T, D, D, 0};
        pg8::StaticOrder S; S.init(T, D, F.G, (int)blockIdx.x);
        EpiOutProj E{F.x, (bf16*)(F.ws + WS_H1)};
        pg8::gemm_phase<EpiOutProj, pg8::StaticOrder, true, false>(F.lds, g, S, E);
        if (BOTH(5)) xcd_barrier(bar);
    }
    if (IN(6)) { p6_router(F); if (BOTH(6)) xcd_barrier(bar); }

    if (IN(8)) {
        moe_tile_table(F);
        pg8::Gemm g{(const bf16*)(F.ws + WS_XN2), (const bf16*)(F.ws + WS_WUP), NROWS_MAX, 2048, D / 2, (size_t)2048 * D};
        MoeOrder S{(const LAS int*)(F.lds + TILE_E_OFF), (const int*)(F.ws + WS_ROWTOK_S), 8, F.G, F.vcu, D};
        EpiUp E{F.b_up, (unsigned char*)(F.ws + WS_HB), (const float*)(F.ws + WS_ROWRSTD_S)};
        pg8::gemm_phase<EpiUp, MoeOrder, true, true, true>(F.lds, g, S, E);
        if (BOTH(8)) xcd_barrier(bar);
    }
    if (IN(9)) {
        moe_tile_table(F);
        pg8::Gemm g{(const bf16*)(F.ws + WS_HB), (const bf16*)(F.ws + WS_WDN), NROWS_MAX, D, D / 2, (size_t)D * D};
        MoeOrder S{(const LAS int*)(F.lds + TILE_E_OFF), (const int*)(F.ws + WS_ROWTOK_S), 4, F.G, F.vcu, D};
        EpiDown E{(const int*)(F.ws + WS_ROWTOK_S), (const float*)(F.ws + WS_ROWGATE_S), F.b_down, F.ws};
        pg8::gemm_phase<EpiDown, MoeOrder, true, false, true>(F.lds, g, S, E);
        if (BOTH(9)) xcd_barrier(bar);
    }
    if (IN(10)) { p10_final(F); }
#undef IN
#undef BOTH
}
static int g_grid = 0;
static void mk_launch(Args a, int lo, int hi, int li, hipStream_t stream) {
    a.ph_lo = lo; a.ph_hi = hi; a.li = li; a.pad = 0;
    hipLaunchKernelGGL(mk_fwd, dim3(g_grid), dim3(NWAVES * 64), LDS_BYTES, stream, a);
}
extern "C" void kernel_launch(void* const* d_in, const int* in_sizes, int n_in, void* d_out, int out_size, void* d_ws, size_t ws_size, hipStream_t stream) {
    float* out = (float*)d_out; unsigned char* ws = (unsigned char*)d_ws;
    if (g_grid == 0) {
        if (ws_size < WS_END) { fprintf(stderr, "kernel_launch: workspace too small (%zu < %zu)\n", ws_size, (size_t)WS_END); g_grid = -1; return; }
        int dev = 0, cus = 0;
        if (hipGetDevice(&dev) != hipSuccess || hipDeviceGetAttribute(&cus, hipDeviceAttributeMultiprocessorCount, dev) != hipSuccess) { g_grid = -1; return; }
        if (hipFuncSetAttribute((const void*)mk_fwd, hipFuncAttributeMaxDynamicSharedMemorySize, LDS_BYTES) != hipSuccess) { fprintf(stderr, "kernel_launch: hipFuncSetAttribute failed\n"); g_grid = -1; return; }
        int per_cu = 0;
        if (hipOccupancyMaxActiveBlocksPerMultiprocessor(&per_cu, (const void*)mk_fwd, NWAVES * 64, LDS_BYTES) != hipSuccess || per_cu < 1) fprintf(stderr, "kernel_launch: occupancy query says %d\n", per_cu);
        (void)hipGetLastError();
        g_grid = cus;
    }
    if (g_grid < 0) return;
    (void)hipMemsetAsync(ws + WS_CTL, 0, 1 * MiB, stream);
    Args a{};
    for (int i = 0; i < 15; ++i) a.in[i] = (const float*)d_in[i];
    a.out = out; a.ws = ws;
    mk_launch(a, 0, 11, 0, stream);
}
```

```cpp
#include <hip/hip_runtime.h>
#include <cstdint>
#include <cstdio>

typedef unsigned short bf16;
constexpr int D = 1024, NB = 16, SEQ = 4096, NMETA = 16, LTOT = SEQ + NMETA, T = NB * SEQ;
constexpr int NPROJ = 3072;
constexpr int KROWS = 64 + SEQ;
constexpr int RROWS = 128 + SEQ;
constexpr int NE = 32, TOPK = 4;
constexpr int NASSIGN = T * TOPK;
constexpr int NROWS_MAX = NASSIGN + NE * 256;
constexpr int NTILES_MAX = NROWS_MAX / 256;
constexpr float EPS = 1e-5f;
constexpr float C2 = 0.125f * 1.4426950408889634f;
constexpr float LAMBDA_INIT = 0.2f;
constexpr float SLOT_SCALE = 16.f;
constexpr float WSCALE = 32.f, WDESCALE = 1.f / 32.f;

constexpr size_t MiB = 1u << 20;
constexpr size_t WS_CTL = 0;
constexpr size_t WS_ROPE_D = 1 * MiB;
constexpr size_t WS_ROPE_R = 2 * MiB + 64 * 1024;
constexpr size_t WS_TOPE = 3 * MiB + 128 * 1024;
constexpr size_t WS_TOPG = 4 * MiB + 128 * 1024;
constexpr size_t WS_RANK = 5 * MiB + 128 * 1024;
constexpr size_t WS_ROWTOK = 6 * MiB + 128 * 1024;
constexpr size_t WS_MISC = 7 * MiB + 512 * 1024;
constexpr size_t WS_WDN = 8 * MiB;
constexpr size_t WS_WUP = 72 * MiB;
constexpr size_t WS_WIN = 200 * MiB;
constexpr size_t WS_WOUT = 206 * MiB;
constexpr size_t WS_HN = 208 * MiB;
constexpr size_t WS_XN2 = 208 * MiB;
constexpr size_t WS_HB = 336 * MiB;
constexpr size_t WS_DQ = 336 * MiB;
constexpr size_t WS_DK = 400 * MiB;
constexpr size_t WS_DV = 466 * MiB;
constexpr size_t WS_RQ = 532 * MiB;
constexpr size_t WS_RK = 564 * MiB;
constexpr size_t WS_RV = 598 * MiB;
constexpr size_t WS_RG = 664 * MiB;
constexpr size_t WS_KVC = 728 * MiB;
constexpr size_t WS_ST = 796 * MiB;
constexpr size_t WS_MIX = 864 * MiB;
constexpr size_t WS_SLOT0 = 600 * MiB, WS_SLOT1 = 72 * MiB, WS_SLOT2 = 208 * MiB, WS_SLOT3 = 864 * MiB;
constexpr size_t WS_WRF = 7 * MiB + 640 * 1024;
constexpr size_t WS_RSTD = 7 * MiB + 768 * 1024;
constexpr size_t WS_ROWRSTD = 992 * MiB;
constexpr size_t WS_ROWGATE = 994 * MiB;
constexpr size_t WS_H1 = 728 * MiB;
constexpr int CAP = 65536;
constexpr size_t WS_ROWTOK_S = 1000 * MiB;
constexpr size_t WS_ROWRSTD_S = 1008 * MiB;
constexpr size_t WS_ROWGATE_S = 1016 * MiB;
constexpr size_t WS_END = 1024 * MiB;


__device__ __forceinline__ unsigned f2bf(float f) { unsigned u = __builtin_bit_cast(unsigned, f); return (u + 0x7fffu + ((u >> 16) & 1u)) >> 16; }
__device__ __forceinline__ unsigned pk2(float lo, float hi) { return f2bf(lo) | (f2bf(hi) << 16); }
__device__ __forceinline__ float bf2f(bf16 h) { return __builtin_bit_cast(float, (unsigned)h << 16); }
__device__ __forceinline__ float wave_sum(float v) {
#pragma unroll
    for (int o = 1; o < 64; o <<= 1) v += __shfl_xor(v, o);
    return v;
}
namespace pg8 {
#define PG8_LAS __attribute__((address_space(3)))
typedef unsigned short bf16_t;
typedef short bf16x8 __attribute__((ext_vector_type(8)));
typedef float f32x4 __attribute__((ext_vector_type(4)));
typedef unsigned u32x4 __attribute__((ext_vector_type(4)));
typedef unsigned u32x2 __attribute__((ext_vector_type(2)));
constexpr int EPI_TAB_OFF = 138 * 1024, EPI_TAB_BYTES = 3072;
constexpr int BM = 256, BK = 64, HALF = 128, HTB = HALF * BK * 2  , STAGE_BYTES = 8 * HTB, NXCD = 8, WGM = 8;

__host__ __device__ __forceinline__ int lds_byte(int r, int c) { const int st = (r >> 4) * 2 + (c >> 5), rr = r & 15, cc = c & 31, ob = rr * 64 + cc * 2; return st * 1024 + (ob ^ (((ob >> 9) & 1) << 5)); }
__host__ __device__ __forceinline__ void stage_rc(int b, int& R, int& C) { const int st = b / 1024, sb = b % 1024, swz = sb ^ (((sb >> 9) & 1) << 5); R = (st >> 1) * 16 + swz / 64; C = (st & 1) * 32 + (swz % 64) / 2; }
__host__ __device__ __forceinline__ int perm32(int rho) { const int n = rho >> 4, i = rho & 15; return 8 * (i >> 2) + 4 * n + (i & 3); }

struct Unit { int pm, pn, e, sb; };
struct Gemm { const bf16_t* A; const bf16_t* Bt; int M, N, K; size_t estride; };

struct StaticOrder {
    int nM, nN, nwg, G, c;
    __host__ __device__ __forceinline__ void init(int M, int N, int G_, int c_) { nM = M / BM; nN = N / BM; nwg = nM * nN; G = G_; c = c_; }
    __host__ __device__ __forceinline__ bool next(int i, Unit& u) const {
        const long L = (long)i * G + c; if (L >= nwg) return false;
        int wgid = (int)L; { const int q = nwg / NXCD, r = nwg % NXCD, xcd = wgid % NXCD, off = wgid / NXCD; wgid = (xcd < r ? xcd * (q + 1) : r * (q + 1) + (xcd - r) * q) + off; }
        const int nig = WGM * nN, gid = wgid / nig, fm = gid * WGM, gsz = (nM - fm) < WGM ? (nM - fm) : WGM;
        u.pm = fm + ((wgid % nig) % gsz); u.pn = (wgid % nig) / gsz; u.e = 0; u.sb = 0; return true;
    }
    __device__ __forceinline__ unsigned rowoff(const Unit&, int) const { return 0u; }
};

__device__ __forceinline__ unsigned cvt_pk_bf16(float lo, float hi) { unsigned r; asm volatile("v_cvt_pk_bf16_f32 %0, %1, %2" : "=v"(r) : "v"(lo), "v"(hi)); return r; }

typedef int v8i_t __attribute__((ext_vector_type(8)));
typedef int v4i_t __attribute__((ext_vector_type(4)));
template <class Epi, class Sched, bool ALIGN_EPI, bool GATHER, bool FP8 = false>
__device__ __forceinline__ void gemm_phase(PG8_LAS unsigned char* lds, const Gemm g, const Sched& S, const Epi& E) {
    const int tid = threadIdx.x, wid = __builtin_amdgcn_readfirstlane(tid >> 6), lane = tid & 63, wr = wid >> 2, wc = wid & 3, fr = lane & 15, fq = lane >> 4;
    const int K = g.K, nt = K / BK;
    unsigned voffA[2], voffB[2];
#pragma unroll
    for (int i = 0; i < 2; ++i) { int R, C; stage_rc(tid * 16 + i * 8192, R, C); const int Rb = Epi::PERM ? ((R & ~31) + perm32(R & 31)) : R;
        voffA[i] = (unsigned)(R * K + C) * 2u; voffB[i] = (unsigned)(Rb * K + C) * 2u; }
    const size_t kstep = (size_t)(BK * 2);
    const size_t hstep = (size_t)HALF * K * 2;
    const size_t tstep = 2 * hstep;
    const unsigned ldsw = (unsigned)wid * 1024u;
    const int aoff = lds_byte(wr * 64 + fr, fq * 8), boff = lds_byte(wc * 32 + fr, fq * 8);
#define PG8_SA(b, h) (((b) * 2 + (h)) * HTB)
#define PG8_SB(b, h) ((4 + (b) * 2 + (h)) * HTB)
#define PG8_STAGE(bufoff, gbase, voff) do { _Pragma("unroll") for (int _i = 0; _i < 2; ++_i) \
        __builtin_amdgcn_global_load_lds((const unsigned*)((const char*)(gbase) + (voff)[_i]), (PG8_LAS unsigned*)(lds + (bufoff) + ldsw + _i * 8192), 16, 0, 0); } while (0)
#define PG8_STAGE_A(bufoff, gbase, h, V) do { if constexpr (GATHER) { PG8_STAGE(bufoff, gbase, V[h]); } else { PG8_STAGE(bufoff, (gbase) + (h) * hstep, voffA); } } while (0)
#define PG8_LDA(dst, b, h) do { _Pragma("unroll") for (int m = 0; m < 4; ++m) _Pragma("unroll") for (int k = 0; k < 2; ++k) dst[m][k] = *(const PG8_LAS bf16x8*)(lds + PG8_SA(b, h) + aoff + m * 2048 + k * 1024); } while (0)
#define PG8_LDB(dst, b, h) do { _Pragma("unroll") for (int n = 0; n < 2; ++n) _Pragma("unroll") for (int k = 0; k < 2; ++k) dst[n][k] = *(const PG8_LAS bf16x8*)(lds + PG8_SB(b, h) + boff + n * 2048 + k * 1024); } while (0)
#define PG8_MMA(ai, bj, At, Bt) do { if constexpr (FP8) __builtin_amdgcn_sched_barrier(0); __builtin_amdgcn_s_setprio(1); _Pragma("unroll") for (int m = 0; m < 4; ++m) _Pragma("unroll") for (int n = 0; n < 2; ++n) { \
        if constexpr (FP8) { const v8i_t a8 = __builtin_shufflevector(__builtin_bit_cast(v4i_t, At[m][0]), __builtin_bit_cast(v4i_t, At[m][1]), 0, 1, 2, 3, 4, 5, 6, 7); \
            const v8i_t b8 = __builtin_shufflevector(__builtin_bit_cast(v4i_t, Bt[n][0]), __builtin_bit_cast(v4i_t, Bt[n][1]), 0, 1, 2, 3, 4, 5, 6, 7); \
            asm volatile("v_mfma_f32_16x16x128_f8f6f4 %0, %1, %2, %0" : "+v"(acc[ai][bj][m][n]) : "v"(b8), "v"(a8)); } \
        else { _Pragma("unroll") for (int k = 0; k < 2; ++k) acc[ai][bj][m][n] = __builtin_amdgcn_mfma_f32_16x16x32_bf16(Bt[n][k], At[m][k], acc[ai][bj][m][n], 0, 0, 0); } } \
        __builtin_amdgcn_s_setprio(0); if constexpr (FP8) __builtin_amdgcn_sched_barrier(0); } while (0)
#define PG8_WAIT_V(n) asm volatile("s_waitcnt vmcnt(" #n ")" ::: "memory")
#define PG8_WAIT_L(n) asm volatile("s_waitcnt lgkmcnt(" #n ")" ::: "memory")
#define PG8_BAR __builtin_amdgcn_s_barrier()
#define PG8_SCHED __builtin_amdgcn_sched_barrier(0)
#define PG8_ROWOFFS(V, u) do { _Pragma("unroll") for (int _i = 0; _i < 2; ++_i) { int _R, _C; stage_rc(tid * 16 + _i * 8192, _R, _C); _Pragma("unroll") for (int _h = 0; _h < 2; ++_h) V[_h][_i] = S.rowoff(u, _h * HALF + _R) + (unsigned)_C * 2u; } } while (0)
    Unit cur, nxt, nn; int ui = 0;
    if (!S.next(0, cur)) return;
    bool has_next = S.next(1, nxt);
    unsigned vc[2][2], vn[2][2], vnn[2][2];
    if constexpr (GATHER) { PG8_ROWOFFS(vc, cur); if (has_next) { PG8_ROWOFFS(vn, nxt); } else { PG8_ROWOFFS(vn, cur); } }
    f32x4 acc[2][2][4][2];
#pragma unroll
    for (int a = 0; a < 2; ++a)
#pragma unroll
        for (int b = 0; b < 2; ++b)
#pragma unroll
            for (int m = 0; m < 4; ++m)
#pragma unroll
                for (int n = 0; n < 2; ++n) acc[a][b][m][n] = (f32x4){0.f, 0.f, 0.f, 0.f};
    bf16x8 At[4][2], B0[2][2], B1[2][2];
    const char* cA = (const char*)g.A + (GATHER ? (size_t)0 : (size_t)cur.pm * tstep); const char* cB = (const char*)g.Bt + (size_t)cur.e * g.estride + (size_t)cur.pn * tstep;
    PG8_STAGE(PG8_SB(0, 0), cB, voffB); PG8_STAGE(PG8_SB(0, 1), cB + hstep, voffB); PG8_STAGE_A(PG8_SA(0, 0), cA, 0, vc); PG8_STAGE_A(PG8_SA(0, 1), cA, 1, vc);
    if (wr == 1) PG8_BAR;
    PG8_WAIT_V(2); PG8_BAR;
    PG8_STAGE(PG8_SB(1, 0), cB + kstep, voffB); PG8_STAGE_A(PG8_SA(1, 0), cA + kstep, 0, vc); PG8_STAGE(PG8_SB(1, 1), cB + hstep + kstep, voffB);
    PG8_WAIT_V(6); PG8_BAR;
    for (;;) {
        const char* nA = GATHER ? cA : (has_next ? (const char*)g.A + (size_t)nxt.pm * tstep : cA);
        const char* nB = has_next ? (const char*)g.Bt + (size_t)nxt.e * g.estride + (size_t)nxt.pn * tstep : cB;
#pragma unroll 1
        for (int t = 0; t < nt; t += 2) {
            const bool last = (t == nt - 2);
            if (t == 0) E.prefetch(cur, lds + EPI_TAB_OFF + (ui & 1) * EPI_TAB_BYTES, wid, lane);
            const char* a1 = cA + (size_t)(t + 1) * kstep;
            const char* a2 = last ? nA : cA + (size_t)(t + 2) * kstep; const char* b2 = last ? nB : cB + (size_t)(t + 2) * kstep;
            const char* a3 = a2 + kstep; const char* b3 = b2 + kstep;
            unsigned w2[2][2];
            if constexpr (GATHER) {
#pragma unroll
                for (int h = 0; h < 2; ++h)
#pragma unroll
                    for (int i = 0; i < 2; ++i) w2[h][i] = last ? vn[h][i] : vc[h][i];
            }
            PG8_LDB(B0, 0, 0); PG8_LDB(B1, 0, 1); PG8_SCHED; PG8_LDA(At, 0, 0); PG8_STAGE_A(PG8_SA(1, 1), a1, 1, vc);
            PG8_WAIT_V(8); PG8_WAIT_L(0); PG8_BAR; PG8_MMA(0, 0, At, B0); PG8_MMA(0, 1, At, B1); PG8_BAR; PG8_SCHED;
            PG8_LDA(At, 0, 1); PG8_STAGE(PG8_SB(0, 0), b2, voffB); PG8_STAGE(PG8_SB(0, 1), b2 + hstep, voffB); PG8_STAGE_A(PG8_SA(0, 0), a2, 0, w2);
            PG8_WAIT_V(8); PG8_WAIT_L(0); PG8_BAR; PG8_MMA(1, 0, At, B0); PG8_MMA(1, 1, At, B1); PG8_BAR; PG8_SCHED;
            PG8_LDB(B0, 1, 0); PG8_LDB(B1, 1, 1); PG8_SCHED; PG8_LDA(At, 1, 0); PG8_STAGE_A(PG8_SA(0, 1), a2, 1, w2);
            PG8_WAIT_V(8); PG8_WAIT_L(0); PG8_BAR; PG8_MMA(0, 0, At, B0); PG8_MMA(0, 1, At, B1); PG8_BAR; PG8_SCHED;
            PG8_LDA(At, 1, 1); PG8_STAGE(PG8_SB(1, 0), b3, voffB); PG8_STAGE(PG8_SB(1, 1), b3 + hstep, voffB); PG8_STAGE_A(PG8_SA(1, 0), a3, 0, w2);
            PG8_WAIT_V(8); PG8_WAIT_L(0); PG8_BAR; PG8_MMA(1, 0, At, B0); PG8_MMA(1, 1, At, B1); PG8_BAR; PG8_SCHED;
        }
        if constexpr (ALIGN_EPI) { if (wr == 0) PG8_BAR; }
        bool has_nn = false;
        if constexpr (GATHER) { has_nn = has_next && S.next(ui + 2, nn); if (has_nn) { PG8_ROWOFFS(vnn, nn); } else { PG8_ROWOFFS(vnn, cur); } }
        else { has_nn = has_next && S.next(ui + 2, nn); }
        if constexpr (FP8) asm volatile("s_nop 15\n\ts_nop 15" ::: "memory");
        E(acc, cur, wr, wc, fr, fq, lds + EPI_TAB_OFF + (ui & 1) * EPI_TAB_BYTES);
        if constexpr (GATHER) { asm volatile("" : "+v"(vnn[0][0]), "+v"(vnn[0][1]), "+v"(vnn[1][0]), "+v"(vnn[1][1])); }
        if (!has_next) break;
#pragma unroll
        for (int a = 0; a < 2; ++a)
#pragma unroll
            for (int b = 0; b < 2; ++b)
#pragma unroll
                for (int m = 0; m < 4; ++m)
#pragma unroll
                    for (int n = 0; n < 2; ++n) acc[a][b][m][n] = (f32x4){0.f, 0.f, 0.f, 0.f};
        cur = nxt; cA = nA; cB = nB; ++ui; nxt = nn; has_next = has_nn;
        if constexpr (GATHER) {
#pragma unroll
            for (int h = 0; h < 2; ++h)
#pragma unroll
                for (int i = 0; i < 2; ++i) { vc[h][i] = vn[h][i]; vn[h][i] = vnn[h][i]; }
        }
        if constexpr (ALIGN_EPI) { if (wr == 1) PG8_BAR; }
    }
    PG8_WAIT_V(0);
    if constexpr (!ALIGN_EPI) { if (wr == 0) PG8_BAR; }
    PG8_BAR;
#undef PG8_SA
#undef PG8_SB
#undef PG8_STAGE
#undef PG8_STAGE_A
#undef PG8_LDA
#undef PG8_LDB
#undef PG8_MMA
#undef PG8_WAIT_V
#undef PG8_WAIT_L
#undef PG8_BAR
#undef PG8_SCHED
#undef PG8_ROWOFFS
}
}
#define GAS __attribute__((address_space(1)))
#define LAS __attribute__((address_space(3)))
typedef unsigned v4u __attribute__((ext_vector_type(4)));
typedef unsigned v2u __attribute__((ext_vector_type(2)));
typedef float f32x4 __attribute__((ext_vector_type(4)));
typedef float f32x16 __attribute__((ext_vector_type(16)));
#define LDS_WAIT() asm volatile("s_waitcnt lgkmcnt(0)" ::: "memory")
#define VM_WAIT() asm volatile("s_waitcnt vmcnt(0)" ::: "memory")
constexpr int NWAVES = 8;
constexpr int RING_BYTES = 131072;
constexpr int LDSCTL_OFF = RING_BYTES, MISC_OFF = LDSCTL_OFF + 320;
constexpr int TILE_E_OFF = RING_BYTES + 1024;
constexpr int LDS_BYTES = 163840;
static_assert(TILE_E_OFF + (NTILES_MAX + 8) * 4 <= LDS_BYTES, "LDS map");
constexpr int CW_GCNT = 32768;
constexpr int TILE_S_OFF = TILE_E_OFF + (NTILES_MAX + 8) * 4;
static_assert(TILE_S_OFF + NTILES_MAX * 4 <= 138 * 1024, "LDS map");
constexpr int CW_BAR = 4096;

#define XB_TMO      128
#define XB_XCNT(j)  (256  + 64 * (j))
#define XB_XSUB(j)  (1280 + 64 * (j))
#define XB_XGEN(j)  (2304 + 64 * (j))
#define XB_TOP      3328
#define XB_TOPGEN   3392
#define XCD_BAR_WORDS 3456
#define XB_SPIN_CAP (1u << 18)
__device__ __forceinline__ unsigned xb_ld(unsigned* p)              { return __hip_atomic_load(p, __ATOMIC_RELAXED, __HIP_MEMORY_SCOPE_AGENT); }
__device__ __forceinline__ unsigned xb_add(unsigned* p, unsigned v) { return __hip_atomic_fetch_add(p, v, __ATOMIC_RELAXED, __HIP_MEMORY_SCOPE_AGENT); }
__device__ __forceinline__ unsigned xb_xcc_id() { return (unsigned)__builtin_amdgcn_s_getreg((3 << 11) | 20) & 0xFu; }
#define XB_SPIN(cond, bar) do { unsigned _sp = 0; while (cond) { __builtin_amdgcn_s_sleep(1); \
    if ((++_sp & 255u) == 0u) { if (xb_ld(&(bar)[XB_TMO])) break; if (_sp > XB_SPIN_CAP) { atomicAdd(&(bar)[XB_TMO], 1u); break; } } } } while (0)
struct XcdBarrier { unsigned* bar; unsigned x; volatile LAS unsigned* st; };
__device__ __forceinline__ XcdBarrier xcd_barrier_post(unsigned* bar, volatile LAS unsigned* st) {
    XcdBarrier b; b.bar = bar; b.x = xb_xcc_id(); b.st = st;
    if (threadIdx.x == 0) (void)xb_add(&bar[XB_XCNT(b.x)], 1u);
    return b;
}
__device__ __forceinline__ void xcd_barrier_complete(unsigned* bar, unsigned x, unsigned& nloc, unsigned& nx) {
    const unsigned G = gridDim.x * gridDim.y * gridDim.z;
    unsigned sum, cnt, mine, sp = 0u;
    for (;;) {
        sum = 0u; cnt = 0u; mine = 0u;
#pragma unroll
        for (unsigned j = 0; j < 16; ++j) { const unsigned c = xb_ld(&bar[XB_XCNT(j)]); sum += c; cnt += (c > 0u) ? 1u : 0u; mine = (j == x) ? c : mine; }
        if (sum == G) break;
        __builtin_amdgcn_s_sleep(1);
        if ((++sp & 255u) == 0u) { if (xb_ld(&bar[XB_TMO])) break; if (sp > XB_SPIN_CAP) { atomicAdd(&bar[XB_TMO], 1u); break; } }
    }
    nloc = mine > 0u ? mine : 1u; nx = cnt > 0u ? cnt : 1u;
}
__device__ __forceinline__ void xcd_barrier(const XcdBarrier& b) {
    asm volatile("s_waitcnt vmcnt(0)" ::: "memory");
    __syncthreads();
    if (threadIdx.x == 0) {
        unsigned* bar = b.bar;
        __builtin_amdgcn_s_waitcnt(0);
        unsigned nloc = b.st[0], nx = b.st[1];
        if (nloc == 0u) { xcd_barrier_complete(bar, b.x, nloc, nx); b.st[0] = nloc; b.st[1] = nx; }
        const unsigned old = xb_add(&bar[XB_XSUB(b.x)], 1u);
        const unsigned gen = old / nloc;
        if (old + 1u == (gen + 1u) * nloc) {
            __builtin_amdgcn_fence(__ATOMIC_RELEASE, "agent");
            asm volatile("s_waitcnt vmcnt(0)" ::: "memory");
            const unsigned og = xb_add(&bar[XB_TOP], 1u);
            const unsigned tg = og / nx;
            if (og + 1u == (tg + 1u) * nx) xb_add(&bar[XB_TOPGEN], 1u);
            else XB_SPIN(xb_ld(&bar[XB_TOPGEN]) == tg, bar);
            __builtin_amdgcn_fence(__ATOMIC_ACQUIRE, "agent");
            xb_add(&bar[XB_XGEN(b.x)], 1u);
            asm volatile("s_waitcnt vmcnt(0)" ::: "memory");
        } else {
            XB_SPIN(xb_ld(&bar[XB_XGEN(b.x)]) == gen, bar);
            __builtin_amdgcn_fence(__ATOMIC_ACQUIRE, "agent");
            asm volatile("s_waitcnt vmcnt(0)" ::: "memory");
        }
    }
    __syncthreads();
}

__device__ __forceinline__ void glds16_raw(const void* gsrc, unsigned lds_dst) { unsigned keep;
    asm volatile("s_mov_b32 %0, m0\n\ts_mov_b32 m0, %2\n\ts_nop 0\n\tglobal_load_lds_dwordx4 %1, off\n\ts_mov_b32 m0, %0" : "=&s"(keep) : "v"(gsrc), "s"(lds_dst) : "memory"); }
#define GLDS16R(gp, lp) glds16_raw((const void*)(gp), (unsigned)__builtin_amdgcn_readfirstlane((int)(unsigned)(size_t)(lp)))
struct Args { const float* in[15]; float* out; unsigned char* ws; int ph_lo, ph_hi, li, pad; };
struct Frame {
    LAS unsigned char* lds;
    int tid, lane, wave, vcu, G;
    const float *x, *meta, *attn_g, *w_in, *dlam, *subln, *w_out, *ffn_g, *w_router, *b_router, *w_up, *b_up, *w_down, *b_down, *final_g;
    float* out; unsigned char* ws;
};

template <class DestRow>
__device__ __forceinline__ void p0_transpose_item(const float* __restrict__ W, int K, int N, bf16* __restrict__ WT, LAS float* scr, int item, int lane, DestRow dest, const float* __restrict__ kscale) {
    const int nblk = N / 32, kb = item / nblk, nb = item % nblk, k0 = 64 * kb, n0 = 32 * nb;
#pragma unroll 8
    for (int i = 0; i < 32; ++i) { const int kk = 2 * i + (lane >> 5); scr[kk * 33 + (lane & 31)] = __builtin_nontemporal_load(W + (size_t)(k0 + kk) * N + n0 + (lane & 31)) * (kscale ? kscale[k0 + kk] : 1.f); }
    LDS_WAIT(); asm volatile("" ::: "memory");
    const int c = lane & 7;
#pragma unroll
    for (int j = 0; j < 4; ++j) { const int n = (lane >> 3) + 8 * j; const LAS float* s = scr + (8 * c) * 33 + n;
        v4u o; o.x = pk2(s[0 * 33], s[1 * 33]); o.y = pk2(s[2 * 33], s[3 * 33]); o.z = pk2(s[4 * 33], s[5 * 33]); o.w = pk2(s[6 * 33], s[7 * 33]);
        *(v4u*)(WT + (size_t)dest(n0 + n) * K + k0 + 8 * c) = o; }
    LDS_WAIT(); asm volatile("" ::: "memory");
}

__device__ __forceinline__ unsigned pk_fp8x4(float a, float b, float c, float d) { int w = __builtin_amdgcn_cvt_pk_fp8_f32(a, b, 0, false); w = __builtin_amdgcn_cvt_pk_fp8_f32(c, d, w, true); return (unsigned)w; }
template <class DestRow>
__device__ __forceinline__ void p0_transpose_item_fp8(const float* __restrict__ W, int K, int N, unsigned char* __restrict__ WT, LAS float* scr, int item, int lane, DestRow dest, float scale) {
    const int nblk = N / 32, kb = item / nblk, nb = item % nblk, k0 = 64 * kb, n0 = 32 * nb;
#pragma unroll 8
    for (int i = 0; i < 32; ++i) { const int kk = 2 * i + (lane >> 5); scr[kk * 33 + (lane & 31)] = __builtin_nontemporal_load(W + (size_t)(k0 + kk) * N + n0 + (lane & 31)); }
    LDS_WAIT(); asm volatile("" ::: "memory");
    const int c = lane & 7;
#pragma unroll
    for (int j = 0; j < 4; ++j) { const int n = (lane >> 3) + 8 * j; const LAS float* s = scr + (8 * c) * 33 + n;
        v2u o; o.x = pk_fp8x4(s[0 * 33] * scale, s[1 * 33] * scale, s[2 * 33] * scale, s[3 * 33] * scale); o.y = pk_fp8x4(s[4 * 33] * scale, s[5 * 33] * scale, s[6 * 33] * scale, s[7 * 33] * scale);
        *(v2u*)(WT + (size_t)dest(n0 + n) * K + k0 + 8 * c) = o; }
    LDS_WAIT(); asm volatile("" ::: "memory");
}
struct DestId { __device__ __forceinline__ int operator()(int n) const { return n; } };
struct DestIn {
    __device__ __forceinline__ int operator()(int n) const { const int pn = n >> 8; const bool rope = (pn < 4) || pn == 6 || pn == 7; if (!rope) return n;
        const int w = n & 255, hh = w >> 6, bj = (w >> 5) & 1, dd = w & 31; return (pn << 8) + 128 * bj + 32 * hh + dd; }
};
struct DestUp {
    __device__ __forceinline__ int operator()(int c) const { return ((c >> 8) << 8) + 128 * (c & 1) + ((c >> 1) & 127); }
};

__device__ __forceinline__ float inv_freq_d(int i) { return exp2f(-(float)i / 32.0f * 13.287712379549449f); }
__device__ __forceinline__ float inv_freq_r(int i) { return exp2f(-(float)i / 31.0f * 13.287712379549449f); }

__device__ __forceinline__ void p0_meta(Frame& F, int j) {
    LAS float* hn = (LAS float*)F.lds;
    LAS float* part = (LAS float*)(F.lds + 65536);
    LAS float* fin = (LAS float*)(F.lds + 98304);
    for (int r = F.wave * 2; r < F.wave * 2 + 2; ++r) {
        const float* src = F.meta + (size_t)r * D;
        float4 v[4]; float ss = 0.f;
#pragma unroll
        for (int q = 0; q < 4; ++q) { v[q] = ((const float4*)src)[F.lane + 64 * q]; ss += v[q].x * v[q].x + v[q].y * v[q].y + v[q].z * v[q].z + v[q].w * v[q].w; }
        const float rs = rsqrtf(wave_sum(ss) * (1.f / D) + EPS);
#pragma unroll
        for (int q = 0; q < 4; ++q) { const float4 gg = ((const float4*)F.attn_g)[F.lane + 64 * q]; const int k = 4 * (F.lane + 64 * q);
            hn[r * D + k] = v[q].x * rs * gg.x; hn[r * D + k + 1] = v[q].y * rs * gg.y; hn[r * D + k + 2] = v[q].z * rs * gg.z; hn[r * D + k + 3] = v[q].w * rs * gg.w; }
    }
    __syncthreads();
    float acc[16];
#pragma unroll
    for (int r = 0; r < 16; ++r) acc[r] = 0.f;
    for (int k = 128 * F.wave; k < 128 * F.wave + 128; k += 4) {
        float wv[4];
#pragma unroll
        for (int q = 0; q < 4; ++q) wv[q] = F.w_in[(size_t)(k + q) * NPROJ + 64 * j + F.lane];
#pragma unroll
        for (int r = 0; r < 16; ++r) { const f32x4 h4 = *(const LAS f32x4*)(hn + r * D + k); acc[r] += h4[0] * wv[0] + h4[1] * wv[1] + h4[2] * wv[2] + h4[3] * wv[3]; }
    }
#pragma unroll
    for (int r = 0; r < 16; ++r) part[(F.wave * 16 + r) * 64 + F.lane] = acc[r];
    __syncthreads();
    for (int idx = F.tid; idx < 1024; idx += 512) { float s = 0.f;
#pragma unroll
        for (int w = 0; w < 8; ++w) s += part[w * 1024 + idx];
        fin[idx] = s; }
    __syncthreads();
    bf16* DK = (bf16*)(F.ws + WS_DK); bf16* DV = (bf16*)(F.ws + WS_DV); bf16* RK = (bf16*)(F.ws + WS_RK); bf16* RV = (bf16*)(F.ws + WS_RV);
    for (int idx = F.tid; idx < 1024; idx += 512) {
        const int r = idx >> 6, c = idx & 63; float val = fin[idx];
        const bool isdk = j >= 8 && j < 16, isrk = j >= 28 && j < 32;
        if (isdk || isrk) {
            const int i = c & 31; const float ang = (float)r * (isdk ? inv_freq_d(i) : inv_freq_r(i)); const float cs = cosf(ang), sn = sinf(ang);
            const float other = fin[idx ^ 32];
            val = c < 32 ? val * cs - other * sn : val * cs + other * sn;
            if (isrk) val *= 0.125f * exp2f(-(float)(112 + r) * log2f(1.f - exp2f(-5.f - (float)(j - 28))));
        }
        const bf16 o = (bf16)f2bf(val);
        for (int bb = 0; bb < NB; ++bb) {
            if (isdk) DK[((size_t)bb * KROWS + r) * 512 + 64 * (j - 8) + c] = o;
            else if (j >= 16 && j < 24) DV[((size_t)bb * KROWS + r) * 512 + 64 * (j - 16) + c] = o;
            else if (isrk) RK[((size_t)bb * RROWS + 112 + r) * 256 + 64 * (j - 28) + c] = o;
            else RV[((size_t)bb * RROWS + 112 + r) * 512 + 64 * (j - 32) + c] = o;
        }
    }
    __syncthreads();
}

__device__ __forceinline__ void p0_prologue(Frame& F) {
    if (F.vcu < 48) { const int j = F.vcu; const bool need = (j >= 8 && j < 24) || (j >= 28 && j < 40); if (need) p0_meta(F, j); }
    LAS float* scr = (LAS float*)(F.lds + F.wave * 16384);
    const int gw = F.vcu * NWAVES + F.wave, NGW = F.G * NWAVES;
    bf16* WinT = (bf16*)(F.ws + WS_WIN); bf16* WoutT = (bf16*)(F.ws + WS_WOUT); bf16* WupT = (bf16*)(F.ws + WS_WUP); bf16* WdnT = (bf16*)(F.ws + WS_WDN);
    constexpr int I_IN = (D / 64) * (NPROJ / 32), I_OUT = (D / 64) * (D / 32), I_UP = (D / 64) * (2048 / 32), I_DN = (D / 64) * (D / 32);
    constexpr int NITEMS = I_IN + I_OUT + NE * I_UP + NE * I_DN;
    for (int it = gw; it < NITEMS; it += NGW) {
        int r = it;
        if (r < I_IN) { p0_transpose_item(F.w_in, D, NPROJ, WinT, scr, r, F.lane, DestIn{}, F.attn_g); continue; } r -= I_IN;
        if (r < I_OUT) { p0_transpose_item_fp8(F.w_out, D, D, (unsigned char*)WoutT, scr, r, F.lane, DestId{}, WSCALE); continue; } r -= I_OUT;
        if (r < NE * I_UP) { const int e = r / I_UP; p0_transpose_item_fp8(F.w_up + (size_t)e * D * 2048, D, 2048, (unsigned char*)WupT + (size_t)e * 2048 * D, scr, r % I_UP, F.lane, DestUp{}, WSCALE); continue; } r -= NE * I_UP;
        { const int e = r / I_DN; p0_transpose_item_fp8(F.w_down + (size_t)e * D * D, D, D, (unsigned char*)WdnT + (size_t)e * D * D, scr, r % I_DN, F.lane, DestId{}, WSCALE); }
    }
    bf16* HN = (bf16*)(F.ws + WS_HN); float* rstd0 = (float*)(F.ws + WS_ROPE_D);
#pragma unroll 2
    for (int m = gw; m < T; m += NGW) {
        const float* __restrict__ src = F.x + (size_t)m * D;
        float4 v[4]; float ss = 0.f;
#pragma unroll
        for (int q = 0; q < 4; ++q) { const f32x4 t4 = __builtin_nontemporal_load((const f32x4*)src + F.lane + 64 * q); v[q] = make_float4(t4[0], t4[1], t4[2], t4[3]); ss += v[q].x * v[q].x + v[q].y * v[q].y + v[q].z * v[q].z + v[q].w * v[q].w; }
        const float rs = rsqrtf(wave_sum(ss) * (1.f / D) + EPS);
#pragma unroll
        for (int q = 0; q < 4; ++q) { uint2 o; o.x = pk2(v[q].x, v[q].y); o.y = pk2(v[q].z, v[q].w); ((uint2*)(HN + (size_t)m * D))[F.lane + 64 * q] = o; }
        if (F.lane == 0) rstd0[m] = rs;
    }
    { bf16* wrf = (bf16*)(F.ws + WS_WRF);
      for (int idx = F.vcu * 512 + F.tid; idx < 64 * 64; idx += F.G * 512) { const int s_ = idx >> 6, ln = idx & 63, n = ln & 31, hi = ln >> 5; unsigned h[4], l[4];
#pragma unroll
          for (int j = 0; j < 4; ++j) { const float w0 = F.w_router[(16 * s_ + 8 * hi + 2 * j) * NE + n], w1 = F.w_router[(16 * s_ + 8 * hi + 2 * j + 1) * NE + n];
              const unsigned h0 = f2bf(w0), h1 = f2bf(w1); h[j] = h0 | (h1 << 16); l[j] = f2bf(w0 - bf2f((bf16)h0)) | (f2bf(w1 - bf2f((bf16)h1)) << 16); }
          *(v4u*)(wrf + (size_t)idx * 8) = (v4u){h[0], h[1], h[2], h[3]}; *(v4u*)(wrf + (size_t)(4096 + idx) * 8) = (v4u){l[0], l[1], l[2], l[3]}; } }
    { v4u* rt = (v4u*)(F.ws + WS_ROWTOK_S); const v4u m1 = {0xffffffffu, 0xffffffffu, 0xffffffffu, 0xffffffffu};
      for (int idx = F.vcu * 512 + F.tid; idx < NE * CAP / 4; idx += F.G * 512) rt[idx] = m1; }
    { v4u* DK = (v4u*)(F.ws + WS_DK); v4u* DV = (v4u*)(F.ws + WS_DV); v4u* RK = (v4u*)(F.ws + WS_RK); v4u* RV = (v4u*)(F.ws + WS_RV); const v4u z = {0u, 0u, 0u, 0u};
      constexpr int nA = NB * 48 * 64, nB = NB * 112 * 32, nC = NB * 112 * 64;
      for (int idx = F.vcu * 512 + F.tid; idx < nC; idx += F.G * 512) {
          if (idx < nA) { const int b = idx / (48 * 64), r = idx % (48 * 64); DK[((size_t)b * KROWS + 16) * 64 + r] = z; DV[((size_t)b * KROWS + 16) * 64 + r] = z; }
          if (idx < nB) { const int b = idx / (112 * 32), r = idx % (112 * 32); RK[(size_t)b * RROWS * 32 + r] = z; }
          { const int b = idx / (112 * 64), r = idx % (112 * 64); RV[(size_t)b * RROWS * 64 + r] = z; }
      } }
}

struct EpiInProj {
    static constexpr bool PERM = true;
    bf16 *__restrict__ DQ, *__restrict__ DK, *__restrict__ DV, *__restrict__ RQ, *__restrict__ RK, *__restrict__ RV, *__restrict__ RG; const float *__restrict__ rstd;
    __device__ __forceinline__ void prefetch(const pg8::Unit& u, LAS unsigned char* tab, int wid, int lane) const { if (wid == 0) GLDS16R(rstd + (size_t)u.pm * 256 + 4 * lane, tab + 1024); }
    __device__ __forceinline__ void operator()(const pg8::f32x4 (&acc)[2][2][4][2], const pg8::Unit& u, int wr, int wc, int fr, int fq, const LAS unsigned char* tab) const {
        const int pn = u.pn;
        bf16* __restrict__ base; int ld, colb, rk, rope; float sc = 1.f;
        float dsgn = 0.f;
        if (pn < 2) { base = DQ; ld = 512; colb = 256 * pn; rk = 0; rope = 1; sc = C2; }
        else if (pn < 4) { base = DK; ld = 512; colb = 256 * (pn - 2); rk = 1; rope = 1; }
        else if (pn < 6) { base = DV; ld = 512; colb = 256 * (pn - 4); rk = 1; rope = 0; }
        else if (pn == 6) { base = RQ; ld = 256; colb = 0; rk = 0; rope = 2; dsgn = 1.f; }
        else if (pn == 7) { base = RK; ld = 256; colb = 0; rk = 2; rope = 2; sc = 0.125f; dsgn = -1.f; }
        else if (pn < 10) { base = RV; ld = 512; colb = 256 * (pn - 8); rk = 2; rope = 0; }
        else { base = RG; ld = 512; colb = 256 * (pn - 10); rk = 0; rope = 0; }
        const float l2g = dsgn * log2f(1.f - exp2f(-5.f - (float)wc));
        float fr8[8];
        { const LAS float* ft = (const LAS float*)tab + (rope == 2 ? 32 : 0) + 8 * fq; const pg8::f32x4 f0 = *(const LAS pg8::f32x4*)ft, f1 = *(const LAS pg8::f32x4*)(ft + 4);
#pragma unroll
          for (int p = 0; p < 4; ++p) { fr8[p] = f0[p]; fr8[4 + p] = f1[p]; } }
#pragma unroll
        for (int ai = 0; ai < 2; ++ai)
#pragma unroll
            for (int m = 0; m < 4; ++m) {
                const int tr = u.pm * 256 + ai * 128 + wr * 64 + m * 16 + fr; const int b = tr >> 12, t = tr & 4095;
                const size_t drow = rk == 0 ? (size_t)tr : rk == 1 ? ((size_t)b * KROWS + 64 + t) : ((size_t)b * RROWS + 128 + t);
                bf16* __restrict__ rowp = base + drow * ld + colb;
                const float rsr = ((const LAS float*)(tab + 1024))[ai * 128 + wr * 64 + m * 16 + fr];
                if (rope) {
                    const float pos = (float)(t + NMETA);
                    pg8::f32x4 cs[4];
#pragma unroll
                    for (int p = 0; p < 8; ++p) { const float rev = __builtin_amdgcn_fractf(pos * fr8[p]); cs[p >> 1][2 * (p & 1)] = __builtin_amdgcn_cosf(rev); cs[p >> 1][2 * (p & 1) + 1] = __builtin_amdgcn_sinf(rev); }
                    pg8::u32x4 w1, w2;
                    const float scr_ = sc * rsr * __builtin_amdgcn_exp2f((float)(t & 127) * l2g);
#pragma unroll
                    for (int n = 0; n < 2; ++n) {
                        const pg8::f32x4 x1 = acc[ai][0][m][n], x2 = acc[ai][1][m][n]; float o1[4], o2[4];
#pragma unroll
                        for (int i = 0; i < 4; ++i) { const float c = cs[2 * n + (i >> 1)][2 * (i & 1)], s = cs[2 * n + (i >> 1)][2 * (i & 1) + 1];
                            float a1 = x1[i] * c; asm("" : "+v"(a1)); a1 = __builtin_fmaf(-x2[i], s, a1); asm("" : "+v"(a1)); a1 *= scr_; asm("" : "+v"(a1)); o1[i] = a1;
                            float a2 = x2[i] * c; asm("" : "+v"(a2)); a2 = __builtin_fmaf(x1[i], s, a2); asm("" : "+v"(a2)); a2 *= scr_; asm("" : "+v"(a2)); o2[i] = a2; }
                        w1[2 * n] = pg8::cvt_pk_bf16(o1[0], o1[1]); w1[2 * n + 1] = pg8::cvt_pk_bf16(o1[2], o1[3]);
                        w2[2 * n] = pg8::cvt_pk_bf16(o2[0], o2[1]); w2[2 * n + 1] = pg8::cvt_pk_bf16(o2[2], o2[3]);
                    }
                    *(pg8::u32x4*)(rowp + 64 * wc + 8 * fq) = w1; *(pg8::u32x4*)(rowp + 64 * wc + 32 + 8 * fq) = w2;
                } else {
#pragma unroll
                    for (int bj = 0; bj < 2; ++bj) { pg8::f32x4 v0, v1; pg8::u32x4 w;
#pragma unroll
                        for (int j_ = 0; j_ < 4; ++j_) { float a_ = acc[ai][bj][m][0][j_] * rsr; asm("" : "+v"(a_)); v0[j_] = a_; float b_ = acc[ai][bj][m][1][j_] * rsr; asm("" : "+v"(b_)); v1[j_] = b_; }
                        w.x = pg8::cvt_pk_bf16(v0[0], v0[1]); w.y = pg8::cvt_pk_bf16(v0[2], v0[3]); w.z = pg8::cvt_pk_bf16(v1[0], v1[1]); w.w = pg8::cvt_pk_bf16(v1[2], v1[3]);
                        *(pg8::u32x4*)(rowp + 128 * bj + 32 * wc + 8 * fq) = w; }
                }
            }
    }
};


typedef short bf16x8_t __attribute__((ext_vector_type(8)));
typedef short s16x4_t __attribute__((ext_vector_type(4)));
typedef float f32x2_t __attribute__((ext_vector_type(2)));
typedef __bf16 bf16x2_t __attribute__((ext_vector_type(2)));
#define MFMA32(a, b, c) __builtin_amdgcn_mfma_f32_32x32x16_bf16((a), (b), (c), 0, 0, 0)
__device__ __forceinline__ int crow(int i, int hh) { return (i & 3) + 8 * (i >> 2) + 4 * hh; }
__device__ __forceinline__ unsigned cvtpk(float lo, float hi) { f32x2_t v = {lo, hi}; bf16x2_t b = __builtin_convertvector(v, bf16x2_t); return __builtin_bit_cast(unsigned, b); }
__device__ __forceinline__ s16x4_t vtr(const LAS unsigned char* p) { typedef short v4i16_t __attribute__((ext_vector_type(4))); return __builtin_bit_cast(s16x4_t, __builtin_amdgcn_ds_read_tr16_b64_v4i16((LAS v4i16_t*)p)); }
__device__ __forceinline__ bf16x8_t pack8(const f32x16& x, int s8) {
    v4u w; w.x = cvtpk(x[s8], x[s8 + 1]); w.y = cvtpk(x[s8 + 2], x[s8 + 3]); w.z = cvtpk(x[s8 + 4], x[s8 + 5]); w.w = cvtpk(x[s8 + 6], x[s8 + 7]); return __builtin_bit_cast(bf16x8_t, w);
}
__device__ __forceinline__ float vmax3(float a, float b, float c) { float r; asm("v_max3_f32 %0, %1, %2, %3" : "=v"(r) : "v"(a), "v"(b), "v"(c)); return r; }
__device__ __forceinline__ float vmax2(float a, float b) { float r; asm("v_max_f32 %0, %1, %2" : "=v"(r) : "v"(a), "v"(b)); return r; }
__device__ __forceinline__ float half_max(float v) { float a = v, b = v; asm("s_nop 1\n\tv_permlane32_swap_b32 %0, %1\n\ts_nop 1" : "+v"(a), "+v"(b)); return vmax2(a, b); }
__device__ __forceinline__ void swap32(unsigned& a, unsigned& b) { asm volatile("s_nop 1\n\tv_permlane32_swap_b32 %0, %1\n\ts_nop 1" : "+v"(a), "+v"(b)); }
__device__ __forceinline__ float half_swap(float v) { return __shfl_xor(v, 32); }
constexpr int AT_K = 0, AT_V = 3 * 8192, AT_ST = AT_V + 3 * 16384, AT_ST7 = RING_BYTES + 1024, AT_SCR = AT_ST7 + 8192, AT_GS = AT_SCR + 1024;
static_assert(AT_ST + 7 * 8192 <= RING_BYTES && AT_SCR + 1024 <= 147456, "attention LDS map");
__device__ __forceinline__ LAS unsigned char* at_stage(LAS unsigned char* lds, int wave) { return lds + (wave < 7 ? AT_ST + wave * 8192 : AT_ST7); }
#define GLDS16(gp, lp) __builtin_amdgcn_global_load_lds((const unsigned*)(gp), (LAS unsigned*)(lp), 16, 0, 0)
__device__ __forceinline__ void glds16_asm(const void* gsrc, unsigned lds_dst) { unsigned keep;
    asm volatile("s_mov_b32 %0, m0\n\ts_mov_b32 m0, %2\n\ts_nop 0\n\tglobal_load_lds_dwordx4 %1, off\n\ts_mov_b32 m0, %0" : "=&s"(keep) : "v"(gsrc), "s"(lds_dst) : "memory"); }
__device__ __forceinline__ void glds16_sbase(const void* sbase, unsigned voff, const LAS unsigned char* lp) { unsigned keep;
    asm volatile("s_mov_b32 %0, m0\n\ts_mov_b32 m0, %3\n\ts_nop 0\n\tglobal_load_lds_dwordx4 %1, %2\n\ts_mov_b32 m0, %0" : "=&s"(keep) : "v"(voff), "s"(sbase), "s"((unsigned)(size_t)lp) : "memory"); }
#define GLDS16A(gp, lp) glds16_asm((const void*)(gp), (unsigned)__builtin_amdgcn_readfirstlane((int)(unsigned)(size_t)(lp)))

constexpr float AT_THR = 8.f;
constexpr float MIX_SCALE = 16.f;
constexpr int AT_SLOT = 8192;
#define SBAR() __builtin_amdgcn_sched_barrier(0)
#define PIN(x) asm volatile("" : "+v"(x))
#define WAIT_BAR(N) asm volatile("s_waitcnt vmcnt(" #N ") lgkmcnt(0)\n\ts_barrier" ::: "memory")
#define MX3(a, b, c) __builtin_elementwise_maximum(__builtin_elementwise_maximum((a), (b)), (c))
__device__ __forceinline__ float at_rowmax(const f32x16& p0, const f32x16& p1) {
    float a = MX3(p0[0], p0[1], p1[0]), b = MX3(p0[2], p0[3], p1[1]); a = MX3(a, p1[2], p1[3]);
#pragma unroll
    for (int r = 4; r < 16; r += 4) { a = MX3(a, p0[r], p0[r + 1]); b = MX3(b, p0[r + 2], p0[r + 3]); a = MX3(a, p1[r], p1[r + 1]); b = MX3(b, p1[r + 2], p1[r + 3]); }
    return half_max(__builtin_elementwise_maximum(a, b)); }
__device__ __forceinline__ void at_cmask(f32x16& p0, f32x16& p1, int jb, int qrel, int hi) {
    const int kb = 64 * jb + 4 * hi;
#pragma unroll
    for (int r = 0; r < 16; ++r) { const int kv = kb + (r & 3) + 8 * (r >> 2); if (kv > qrel) p0[r] = -INFINITY; if (kv + 32 > qrel) p1[r] = -INFINITY; } }
template <int MP, int VAR>
__device__ __forceinline__ void attn_pass(Frame& F, f32x16 (&o)[4], int b, int h, int qb, float lam, int& s0, const bool pre, const bool issue_next) {
    int lane = F.lane; asm volatile("" : "+v"(lane));
    const int r = lane & 31, hh = lane >> 5, wave = F.wave;
    const bf16* DQ = (const bf16*)(F.ws + WS_DQ); const bf16* DK = (const bf16*)(F.ws + WS_DK); const bf16* DV = (const bf16*)(F.ws + WS_DV);
    const int tq = 32 * wave + r;
    const size_t trow = (size_t)b * SEQ + 256 * qb + tq;
    const int NT = 4 * qb + 5;
    const LAS unsigned char* kp0 = F.lds + AT_K + hh * 1024 + r * 16;
    const LAS unsigned char* vp0 = F.lds + AT_V + (4 * hh + ((lane & 15) >> 2)) * 64 + ((lane >> 4) & 1) * 32 + (lane & 3) * 8;
    const int kh = 2 * h + MP;
    bf16x8_t qr[4];
#pragma unroll
    for (int s_ = 0; s_ < 4; ++s_) qr[s_] = *(const bf16x8_t*)(DQ + trow * 512 + 64 * kh + 16 * s_ + 8 * hh);
    const int pc0 = 2 * wave, pc1 = 2 * wave + 1;
    const bf16* kbase = DK + (size_t)b * KROWS * 512 + 64 * kh + 8 * wave;
    const bf16* vbase0 = DV + ((size_t)b * KROWS + 16 * (pc0 & 3)) * 512 + 128 * h + 32 * (pc0 >> 2);
    const bf16* vbase1 = DV + ((size_t)b * KROWS + 16 * (pc1 & 3)) * 512 + 128 * h + 32 * (pc1 >> 2);
    const unsigned koff = (unsigned)lane * 1024u, voff = (unsigned)(lane >> 2) * 1024u + (unsigned)(lane & 3) * 16u;
    const int vd0 = (pc0 >> 2) * 4096 + (pc0 & 3) * 1024, vd1 = (pc1 >> 2) * 4096 + (pc1 & 3) * 1024;
#define DMA_K(t, sl) do { const int t_ = (t); const bool ex_ = t_ < NT; glds16_sbase(kbase + (size_t)(ex_ ? t_ : 0) * 64 * 512, koff, F.lds + (ex_ ? AT_K + (sl) + wave * 1024 : AT_SCR)); } while (0)
#define DMA_V0(t, sl) glds16_sbase(vbase0 + (size_t)(t) * 64 * 512, voff, F.lds + AT_V + 2 * (sl) + vd0)
#define DMA_V1(t, sl) glds16_sbase(vbase1 + (size_t)(t) * 64 * 512, voff, F.lds + AT_V + 2 * (sl) + vd1)
#define DMA_V(t, sl) do { DMA_V0(t, sl); DMA_V1(t, sl); } while (0)
    asm volatile("s_waitcnt lgkmcnt(0)\n\ts_barrier" ::: "memory");
    int sl_cur = s0, sl_next = (s0 == 2 * AT_SLOT) ? 0 : s0 + AT_SLOT, sl_prev = (s0 == 0) ? 2 * AT_SLOT : s0 - AT_SLOT;
    if (!pre) { DMA_K(0, sl_cur); DMA_V(0, sl_cur); DMA_K(1, sl_next); DMA_K(2, sl_prev); }
    float mref = 0.f, l = 0.f, alpha = 1.f; bool resc = false;
    f32x16 negm;
#pragma unroll
    for (int i = 0; i < 16; ++i) negm[i] = 0.f;
    PIN(negm);
#pragma unroll
    for (int k = 0; k < 4; ++k)
#pragma unroll
        for (int i = 0; i < 16; ++i) o[k][i] = 0.f;
    f32x16 pA0, pA1, pB0, pB1; bf16x8_t kf[8]; s16x4_t vlo[16], vhi[16]; v4u pw0, pw1, pw2, pw3;
#define ROT() do { sl_prev = sl_cur; sl_cur = sl_next; sl_next = (sl_next == 2 * AT_SLOT) ? 0 : sl_next + AT_SLOT; } while (0)
#define KLOAD(i, base) kf[i] = *(const LAS bf16x8_t*)((base) + ((i) >> 1) * 2048 + ((i) & 1) * 512)
#define EX(v) __builtin_amdgcn_exp2f(v)
#define RESC() do { if (resc) { _Pragma("unroll") for (int k_ = 0; k_ < 4; ++k_) _Pragma("unroll") for (int i_ = 0; i_ < 16; ++i_) o[k_][i_] *= alpha; } } while (0)
    WAIT_BAR(0);
    _Pragma("unroll") for (int i = 0; i < 8; ++i) KLOAD(i, kp0 + sl_cur);
    pA0 = MFMA32(kf[0], qr[0], negm); pA1 = MFMA32(kf[1], qr[0], negm); pA0 = MFMA32(kf[2], qr[1], pA0); pA1 = MFMA32(kf[3], qr[1], pA1);
    pA0 = MFMA32(kf[4], qr[2], pA0); pA1 = MFMA32(kf[5], qr[2], pA1); pA0 = MFMA32(kf[6], qr[3], pA0); pA1 = MFMA32(kf[7], qr[3], pA1);
#pragma unroll
    for (int i = 0; i < 16; ++i) { if (i >= 8) pA0[i] = -INFINITY; pA1[i] = -INFINITY; }
    { mref = at_rowmax(pA0, pA1);
#pragma unroll
      for (int i = 0; i < 16; ++i) { negm[i] = -mref; pA0[i] = EX(pA0[i] - mref); pA1[i] = EX(pA1[i] - mref); } }
    WAIT_BAR(0);
    DMA_K(3, sl_cur); DMA_V(1, sl_next); ROT();
    _Pragma("unroll") for (int i = 0; i < 8; ++i) KLOAD(i, kp0 + sl_cur);
    WAIT_BAR(3);
#define PKW(P, i) cvtpk(P[i], P[i + 1])
#define PAF(k) __builtin_bit_cast(bf16x8_t, pw##k)
#define VFR(j) __builtin_shufflevector(vlo[j], vhi[j], 0, 1, 2, 3, 4, 5, 6, 7)
#define VRD(j) do { vlo[j] = vtr(vp_ + (((j) & 3) * 4096 + ((j) >> 2) * 1024)); vhi[j] = vtr(vp_ + (((j) & 3) * 4096 + ((j) >> 2) * 1024 + 512)); } while (0)
#define KRD(G, i) do { if (G) { KLOAD(i, kp0 + sl_next); } } while (0)
#define GAPA(MF, a0, a1, a2, a3, W0, W1, PW) do { MF; sacc += a0; sacc += a1; sacc += a2; sacc += a3; W0; W1; PIN(PW); PIN(sacc); SBAR(); } while (0)
#define GAPB(MF, X, i) do { MF; X[i] = EX(X[i]); X[i + 1] = EX(X[i + 1]); PIN(X); SBAR(); } while (0)
#define GAPX(MF, R, X, i) do { MF; R = MX3(R, X[i], X[i + 1]); X[i] = EX(X[i]); X[i + 1] = EX(X[i + 1]); PIN(X); PIN(R); SBAR(); } while (0)
#define STEP(C0, C1, P0, P1, t, MASK, GK, GV, GL) do { SBAR(); \
    const LAS unsigned char* vp_ = vp0 + 2 * sl_prev; \
    float sacc = P0[0] + P0[1]; \
    if (GK) DMA_K((t) + 3, sl_cur);                                                                                      \
                    GAPA(C0 = MFMA32(kf[0], qr[0], negm), P0[2], P0[3], P0[4], P0[5],     pw0[0] = PKW(P0, 0),  pw0[1] = PKW(P0, 2),  pw0); \
    if (GV) DMA_V0((t) + 1, sl_next); \
                    GAPA(C1 = MFMA32(kf[1], qr[0], negm), P0[6], P0[7], P0[8], P0[9],     pw0[2] = PKW(P0, 4),  pw0[3] = PKW(P0, 6),  pw0); \
    if (GV) DMA_V1((t) + 1, sl_next); \
                    GAPA(C0 = MFMA32(kf[2], qr[1], C0),   P0[10], P0[11], P0[12], P0[13], pw1[0] = PKW(P0, 8),  pw1[1] = PKW(P0, 10), pw1); \
                    GAPA(C1 = MFMA32(kf[3], qr[1], C1),   P0[14], P0[15], P1[0], P1[1],   pw1[2] = PKW(P0, 12), pw1[3] = PKW(P0, 14), pw1); \
    VRD(0); SBAR(); GAPA(C0 = MFMA32(kf[4], qr[2], C0),   P1[2], P1[3], P1[4], P1[5],     pw2[0] = PKW(P1, 0),  pw2[1] = PKW(P1, 2),  pw2); \
    VRD(1); SBAR(); GAPA(C1 = MFMA32(kf[5], qr[2], C1),   P1[6], P1[7], P1[8], P1[9],     pw2[2] = PKW(P1, 4),  pw2[3] = PKW(P1, 6),  pw2); \
    VRD(2); SBAR(); GAPA(C0 = MFMA32(kf[6], qr[3], C0),   P1[10], P1[11], P1[12], P1[13], pw3[0] = PKW(P1, 8),  pw3[1] = PKW(P1, 10), pw3); \
    VRD(3); SBAR(); GAPA(C1 = MFMA32(kf[7], qr[3], C1),   P1[14], P1[15], 0.f, 0.f,       pw3[2] = PKW(P1, 12), pw3[3] = PKW(P1, 14), pw3); \
    l += sacc; \
    if (MASK) { int q_ = tq; asm volatile("" : "+v"(q_)); at_cmask(C0, C1, (t) - (NT - 4), q_, hh); }        \
      \
    float ra_ = C0[0], rb_ = C0[2]; \
    VRD(4);  KRD(GL, 0); SBAR();  GAPX(o[0] = MFMA32(VFR(0),  PAF(0), o[0]), ra_, C0, 0); \
    VRD(5);  SBAR();              GAPX(o[1] = MFMA32(VFR(1),  PAF(0), o[1]), rb_, C0, 2); \
    VRD(6);  KRD(GL, 1); SBAR();  GAPX(o[2] = MFMA32(VFR(2),  PAF(0), o[2]), ra_, C0, 4); \
    VRD(7);  SBAR();              GAPX(o[3] = MFMA32(VFR(3),  PAF(0), o[3]), rb_, C0, 6); \
    VRD(8);  KRD(GL, 2); SBAR();  GAPX(o[0] = MFMA32(VFR(4),  PAF(1), o[0]), ra_, C0, 8); \
    VRD(9);  SBAR();              GAPX(o[1] = MFMA32(VFR(5),  PAF(1), o[1]), rb_, C0, 10); \
    VRD(10); KRD(GL, 3); SBAR();  GAPX(o[2] = MFMA32(VFR(6),  PAF(1), o[2]), ra_, C0, 12); \
    VRD(11); SBAR();              GAPX(o[3] = MFMA32(VFR(7),  PAF(1), o[3]), rb_, C0, 14); \
    VRD(12); KRD(GL, 4); SBAR();  GAPX(o[0] = MFMA32(VFR(8),  PAF(2), o[0]), ra_, C1, 0); \
    VRD(13); SBAR();              GAPX(o[1] = MFMA32(VFR(9),  PAF(2), o[1]), rb_, C1, 2); \
    VRD(14); KRD(GL, 5); SBAR();  GAPX(o[2] = MFMA32(VFR(10), PAF(2), o[2]), ra_, C1, 4); \
    VRD(15); SBAR();              GAPX(o[3] = MFMA32(VFR(11), PAF(2), o[3]), rb_, C1, 6); \
             KRD(GL, 6); SBAR();  GAPX(o[0] = MFMA32(VFR(12), PAF(3), o[0]), ra_, C1, 8); \
                                  GAPX(o[1] = MFMA32(VFR(13), PAF(3), o[1]), rb_, C1, 10); \
             KRD(GL, 7); SBAR();  GAPX(o[2] = MFMA32(VFR(14), PAF(3), o[2]), ra_, C1, 12); \
                                  GAPX(o[3] = MFMA32(VFR(15), PAF(3), o[3]), rb_, C1, 14); \
    { const float rm = half_max(__builtin_elementwise_maximum(ra_, rb_));                                                 \
      if (__builtin_expect(__any(rm > AT_THR), 0)) { const float dl = fmaxf(rm, 0.f); mref += dl;                          \
          const float al_ = __builtin_amdgcn_exp2f(-dl), nm_ = -mref; l *= al_; \
          _Pragma("unroll") for (int i_ = 0; i_ < 16; ++i_) { float a_ = C0[i_], b_ = C1[i_], c_ = negm[i_];                \
              asm volatile("v_mul_f32 %0, %0, %3\n\tv_mul_f32 %1, %1, %3\n\tv_mov_b32 %2, %4" : "+v"(a_), "+v"(b_), "+v"(c_) : "v"(al_), "v"(nm_)); C0[i_] = a_; C1[i_] = b_; negm[i_] = c_; } \
          _Pragma("unroll") for (int k_ = 0; k_ < 4; ++k_) _Pragma("unroll") for (int i_ = 0; i_ < 16; ++i_) { float a_ = o[k_][i_]; asm volatile("v_mul_f32 %0, %0, %1" : "+v"(a_) : "v"(al_)); o[k_][i_] = a_; } } } \
    } while (0)
    int t = 1;
#pragma unroll 1
    do {
        STEP(pB0, pB1, pA0, pA1, t, (t >= NT - 4), true, true, true);         WAIT_BAR(3); ROT();
        STEP(pA0, pA1, pB0, pB1, t + 1, (t + 1 >= NT - 4), true, true, true); WAIT_BAR(3); ROT();
        t += 2;
    } while (t + 2 < NT);
    STEP(pB0, pB1, pA0, pA1, NT - 2, true, false, true, true); WAIT_BAR(0); ROT();
    if (issue_next) {
        const int n0 = sl_next, n1 = (n0 == 2 * AT_SLOT) ? 0 : n0 + AT_SLOT, n2 = (n1 == 2 * AT_SLOT) ? 0 : n1 + AT_SLOT;
        const bf16* kbn = DK + (size_t)b * KROWS * 512 + 64 * (2 * h + (MP ? 0 : 1)) + 8 * wave;
        glds16_sbase(kbn, koff, F.lds + AT_K + n0 + wave * 1024);
        glds16_sbase(vbase0, voff, F.lds + AT_V + 2 * n0 + vd0); glds16_sbase(vbase1, voff, F.lds + AT_V + 2 * n0 + vd1);
        glds16_sbase(kbn + (size_t)64 * 512, koff, F.lds + AT_K + n1 + wave * 1024);
        glds16_sbase(kbn + (size_t)2 * 64 * 512, koff, F.lds + AT_K + n2 + wave * 1024);
        s0 = n0; }
    STEP(pA0, pA1, pB0, pB1, NT - 1, true, false, false, false);
    { float sacc = pA0[0] + pA0[1];
#pragma unroll
      for (int i = 2; i < 16; ++i) sacc += pA0[i];
#pragma unroll
      for (int i = 0; i < 16; ++i) sacc += pA1[i];
      l += sacc;
      pw0 = (v4u){PKW(pA0, 0), PKW(pA0, 2), PKW(pA0, 4), PKW(pA0, 6)}; pw1 = (v4u){PKW(pA0, 8), PKW(pA0, 10), PKW(pA0, 12), PKW(pA0, 14)};
      pw2 = (v4u){PKW(pA1, 0), PKW(pA1, 2), PKW(pA1, 4), PKW(pA1, 6)}; pw3 = (v4u){PKW(pA1, 8), PKW(pA1, 10), PKW(pA1, 12), PKW(pA1, 14)};
      const LAS unsigned char* vp_ = vp0 + 2 * sl_cur;
#pragma unroll
      for (int ks = 0; ks < 4; ++ks)
#pragma unroll
          for (int k = 0; k < 4; ++k) { const s16x4_t lo = vtr(vp_ + k * 4096 + ks * 1024), hi = vtr(vp_ + k * 4096 + ks * 1024 + 512);
              const bf16x8_t vf = __builtin_shufflevector(lo, hi, 0, 1, 2, 3, 4, 5, 6, 7);
              o[k] = MFMA32(vf, ks == 0 ? PAF(0) : ks == 1 ? PAF(1) : ks == 2 ? PAF(2) : PAF(3), o[k]); } }
#undef DMA_K
#undef DMA_V
#undef DMA_V0
#undef DMA_V1
#undef ROT
#undef KLOAD
#undef EX
#undef RESC
#undef PKW
#undef PAF
#undef VFR
#undef VRD
#undef KRD
#undef GAPA
#undef GAPB
#undef GAPX
#undef STEP
    l += half_swap(l);
    const float linv = (MP == 1 ? lam : 1.f) / l;
    int lz_ = F.lane; asm volatile("" : "+v"(lz_));
    LAS v4u* st = (LAS v4u*)at_stage(F.lds, wave) + lz_;
#pragma unroll
    for (int q = 0; q < 8; ++q) { const int k = q >> 1, i0 = 8 * (q & 1);
        if constexpr (MP == 1) { v4u w; w.x = cvtpk(o[k][i0] * linv, o[k][i0 + 1] * linv); w.y = cvtpk(o[k][i0 + 2] * linv, o[k][i0 + 3] * linv);
            w.z = cvtpk(o[k][i0 + 4] * linv, o[k][i0 + 5] * linv); w.w = cvtpk(o[k][i0 + 6] * linv, o[k][i0 + 7] * linv); st[q * 64] = w; }
        else { const v4u w = st[q * 64];
#pragma unroll
            for (int j = 0; j < 4; ++j) { const unsigned u = w[j];
                o[k][i0 + 2 * j] = o[k][i0 + 2 * j] * linv - __builtin_bit_cast(float, u << 16); o[k][i0 + 2 * j + 1] = o[k][i0 + 2 * j + 1] * linv - __builtin_bit_cast(float, u & 0xffff0000u); } }
    }
}
template <int VAR>
__device__ __forceinline__ void attn_unit(Frame& F, int b, int h, int qb, float lam, int& s0, const bool first, const bool last) {
    const int lane = F.lane, wave = F.wave;
    unsigned char* MIX = F.ws + (VAR == 0 ? WS_MIX : WS_HN);
    f32x16 o[4];
    attn_pass<1, VAR>(F, o, b, h, qb, lam, s0, !first, true);
    attn_pass<0, VAR>(F, o, b, h, qb, lam, s0, true, !last);
    int lz = F.lane; asm volatile("" : "+v"(lz));
    const int r = lz & 31, hh = lz >> 5;
    float ss = 0.f;
#pragma unroll
    for (int k = 0; k < 4; ++k)
#pragma unroll
        for (int i = 0; i < 16; ++i) ss += o[k][i] * o[k][i];
    ss += half_swap(ss);
    const float rinv = rsqrtf(ss * (1.f / 128.f) + EPS) * ((1.f - LAMBDA_INIT) * MIX_SCALE);
    LAS unsigned char* sg = at_stage(F.lds, wave);
    const LAS float* gsub = (const LAS float*)(F.lds + AT_GS) + 4 * hh;
#pragma unroll
    for (int k = 0; k < 4; ++k)
#pragma unroll
        for (int g = 0; g < 4; ++g) { const f32x4 g4 = *(const LAS f32x4*)(gsub + 32 * k + 8 * g);
            const unsigned w = pk_fp8x4(o[k][4 * g] * rinv * g4[0], o[k][4 * g + 1] * rinv * g4[1], o[k][4 * g + 2] * rinv * g4[2], o[k][4 * g + 3] * rinv * g4[3]);
            *(LAS unsigned*)(sg + r * 128 + ((32 * k + 8 * g + 4 * hh) ^ ((r & 7) << 4))) = w; }
    unsigned char* __restrict__ obase = MIX + ((size_t)b * SEQ + 256 * qb + 32 * wave + (lz >> 3)) * 1024 + 128 * h + (lz & 7) * 16;
#pragma unroll
    for (int j = 0; j < 4; ++j) { const int row = 8 * j + (lz >> 3); const v4u x = *(const LAS v4u*)(sg + row * 128 + (((lz & 7) ^ (row & 7)) << 4)); *(v4u*)(obase + (size_t)(8 * j) * 1024) = x; }
}
template <int VAR>
__device__ __forceinline__ void p4_attention(Frame& F) {
    float lam;
    { float s01 = 0.f, s23 = 0.f; for (int i = 0; i < 64; ++i) { s01 += F.dlam[i] * F.dlam[64 + i]; s23 += F.dlam[128 + i] * F.dlam[192 + i]; } lam = __expf(s01) - __expf(s23) + LAMBDA_INIT; }
    __syncthreads(); if (F.tid < 128) ((LAS float*)(F.lds + AT_GS))[F.tid] = F.subln[F.tid]; __syncthreads();
    for (int v = F.vcu; v < 256; v += F.G) {
        const int bh = v >> 2, j = v & 3;
        int s0 = 0;
#pragma unroll 1
        for (int u = 0; u < 4; ++u) { const int qb = u == 0 ? j : u == 1 ? 15 - j : u == 2 ? 7 - j : 8 + j; attn_unit<VAR>(F, bh >> 2, bh & 3, qb, lam, s0, u == 0, u == 3); }
    }
}

__device__ __forceinline__ void p2_ret_kv(Frame& F) {
    const int lane = F.lane, r = lane & 31, hh = lane >> 5, wave = F.wave;
    const bf16* RK = (const bf16*)(F.ws + WS_RK); const bf16* RV = (const bf16*)(F.ws + WS_RV); float* KVC = (float*)(F.ws + WS_KVC);
    const int eblk = wave & 3, dblk = wave >> 2;
    const int trl = (8 * hh + ((lane & 15) >> 2)) * 64 + ((lane >> 4) & 1) * 32 + (lane & 3) * 8;
    int buf = 0; bool first = true;
    for (int u = F.vcu; u < 64 * 32; u += F.G) {
        const int bh = u >> 5, n = u & 31, b = bh >> 2, h = bh & 3;
        if (first) {
            const size_t row0 = (size_t)b * RROWS + 128 * n;
#pragma unroll
            for (int i = 0; i < 2; ++i) { const int p = 2 * wave + i; GLDS16R(RK + (row0 + 16 * (p & 7) + (lane >> 2)) * 256 + 64 * h + 32 * (p >> 3) + 8 * (lane & 3), F.lds + (p >> 3) * 8192 + (p & 7) * 1024); }
#pragma unroll
            for (int i = 0; i < 4; ++i) { const int p = 4 * wave + i; GLDS16R(RV + (row0 + 16 * (p & 7) + (lane >> 2)) * 512 + 128 * h + 32 * (p >> 3) + 8 * (lane & 3), F.lds + 16384 + (p >> 3) * 8192 + (p & 7) * 1024); }
            first = false;
        }
        asm volatile("s_waitcnt vmcnt(0) lgkmcnt(0)" ::: "memory"); __builtin_amdgcn_s_barrier(); asm volatile("" ::: "memory");
        const int un = u + F.G;
        if (un < 64 * 32) {
            const int bh2 = un >> 5, n2 = un & 31, b2 = bh2 >> 2, h2 = bh2 & 3; const size_t row0 = (size_t)b2 * RROWS + 128 * n2; LAS unsigned char* nb = F.lds + (buf ^ 1) * 49152;
#pragma unroll
            for (int i = 0; i < 2; ++i) { const int p = 2 * wave + i; GLDS16R(RK + (row0 + 16 * (p & 7) + (lane >> 2)) * 256 + 64 * h2 + 32 * (p >> 3) + 8 * (lane & 3), nb + (p >> 3) * 8192 + (p & 7) * 1024); }
#pragma unroll
            for (int i = 0; i < 4; ++i) { const int p = 4 * wave + i; GLDS16R(RV + (row0 + 16 * (p & 7) + (lane >> 2)) * 512 + 128 * h2 + 32 * (p >> 3) + 8 * (lane & 3), nb + 16384 + (p >> 3) * 8192 + (p & 7) * 1024); }
        }
        const LAS unsigned char* cb = F.lds + buf * 49152;
        const LAS unsigned char* ap = cb + 16384 + eblk * 8192 + trl; const LAS unsigned char* bp = cb + dblk * 8192 + trl;
        f32x16 acc;
#pragma unroll
        for (int i = 0; i < 16; ++i) acc[i] = 0.f;
#pragma unroll
        for (int s_ = 0; s_ < 8; ++s_) {
            const s16x4_t al = vtr(ap + s_ * 1024), ah = vtr(ap + s_ * 1024 + 256), bl = vtr(bp + s_ * 1024), bhh = vtr(bp + s_ * 1024 + 256);
            acc = MFMA32(__builtin_shufflevector(al, ah, 0, 1, 2, 3, 4, 5, 6, 7), __builtin_shufflevector(bl, bhh, 0, 1, 2, 3, 4, 5, 6, 7), acc);
        }
        float* dst = KVC + ((size_t)u * 128 + 32 * eblk + 4 * hh) * 64 + 32 * dblk + r;
#pragma unroll
        for (int i = 0; i < 16; ++i) dst[(size_t)((i & 3) + 8 * (i >> 2)) * 64] = acc[i];
        buf ^= 1;
    }
    asm volatile("s_waitcnt vmcnt(0) lgkmcnt(0)" ::: "memory"); __builtin_amdgcn_s_barrier(); asm volatile("" ::: "memory");
}
__device__ __forceinline__ void p3_ret_scan(Frame& F) {
    const float* KVC = (const float*)(F.ws + WS_KVC); bf16* ST = (bf16*)(F.ws + WS_ST);
    for (int gid = F.vcu * 512 + F.tid; gid < 64 * 2048; gid += F.G * 512) {
        const int bh = gid >> 11, i4 = gid & 2047, h = bh & 3;
        const float l2g = log2f(1.f - exp2f(-5.f - (float)h)); const float gam = exp2f(l2g), g127 = exp2f(127.f * l2g), g128 = exp2f(128.f * l2g);
        const f32x4* __restrict__ src = (const f32x4*)(KVC + (size_t)bh * 32 * 8192) + i4; v2u* __restrict__ dst = (v2u*)(ST + (size_t)bh * 32 * 8192) + i4;
        f32x4 st = {0.f, 0.f, 0.f, 0.f};
        f32x4 kvv[32];
#pragma unroll
        for (int n = 0; n < 32; ++n) kvv[n] = src[(size_t)n * 2048];
#pragma unroll
        for (int n = 0; n < 32; ++n) { const f32x4 kv = kvv[n]; st = st * g128 + kv * g127; const f32x4 o = st * gam;
            v2u w; w.x = cvtpk(o[0], o[1]); w.y = cvtpk(o[2], o[3]); dst[(size_t)n * 2048] = w; }
    }
}
__device__ __forceinline__ void p2_ret_state(Frame& F) {
    int lane = F.lane; asm volatile("" : "+v"(lane));
    const int r = lane & 31, hh = lane >> 5, wave = F.wave;
    const bf16* RK = (const bf16*)(F.ws + WS_RK); const bf16* RV = (const bf16*)(F.ws + WS_RV); bf16* ST = (bf16*)(F.ws + WS_ST);
    const int trl = (8 * hh + ((lane & 15) >> 2)) * 64 + ((lane >> 4) & 1) * 32 + (lane & 3) * 8;
    constexpr int RS_SLOT = 24576;
    for (int w = F.vcu; w < 256; w += F.G) {
        const int bh = w >> 2, q = w & 3, b = bh >> 2, h = bh & 3;
        const float g128 = exp2f(128.f * log2f(1.f - exp2f(-5.f - (float)h)));
#define RS_ADDR(s_) ((s_) < 5 ? (s_) * RS_SLOT : RING_BYTES + 1024)
#define RS_DMA(n_, s_) do { const int nn_ = (n_) < 32 ? (n_) : 31; const size_t row0_ = (size_t)b * RROWS + 128 * nn_; LAS unsigned char* sl_ = F.lds + RS_ADDR(s_); \
            _Pragma("unroll") for (int i_ = 0; i_ < 2; ++i_) { const int p_ = 2 * wave + i_; GLDS16R(RK + (row0_ + 16 * (p_ & 7) + (lane >> 2)) * 256 + 64 * h + 32 * (p_ >> 3) + 8 * (lane & 3), sl_ + (p_ >> 3) * 8192 + (p_ & 7) * 1024); } \
            GLDS16R(RV + (row0_ + 16 * wave + (lane >> 2)) * 512 + 128 * h + 32 * q + 8 * (lane & 3), sl_ + 16384 + wave * 1024); } while (0)
        asm volatile("s_waitcnt vmcnt(0) lgkmcnt(0)" ::: "memory"); __builtin_amdgcn_s_barrier(); asm volatile("" ::: "memory");
        RS_DMA(0, 0); RS_DMA(1, 1); RS_DMA(2, 2); RS_DMA(3, 3); RS_DMA(4, 4);
        f32x16 st;
#pragma unroll
        for (int i = 0; i < 16; ++i) st[i] = 0.f;
        bf16* dst = ST + ((size_t)bh * 32 * 128 + 32 * q + r) * 64 + 32 * wave + 4 * hh;
        int slot = 0;
#pragma unroll 1
        for (int n = 0; n < 32; ++n) {
            if (wave < 2) { if (n == 0) asm volatile("s_waitcnt vmcnt(12)" ::: "memory"); else if (n == 1) asm volatile("s_waitcnt vmcnt(16)" ::: "memory");
                            else if (n == 2) asm volatile("s_waitcnt vmcnt(20)" ::: "memory"); else if (n == 3) asm volatile("s_waitcnt vmcnt(24)" ::: "memory");
                            else if (n == 4) asm volatile("s_waitcnt vmcnt(28)" ::: "memory"); else asm volatile("s_waitcnt vmcnt(32)" ::: "memory"); }
            else asm volatile("s_waitcnt vmcnt(12)" ::: "memory");
            asm volatile("s_waitcnt lgkmcnt(0)" ::: "memory"); __builtin_amdgcn_s_barrier(); asm volatile("" ::: "memory");
            { const int ns_ = slot == 0 ? 5 : slot - 1; RS_DMA(n + 5, ns_); }
            if (wave < 2) {
                const LAS unsigned char* cb = F.lds + RS_ADDR(slot);
                const LAS unsigned char* ap = cb + 16384 + trl; const LAS unsigned char* bp = cb + wave * 8192 + trl;
                f32x16 s2;
#pragma unroll
                for (int i = 0; i < 16; ++i) s2[i] = 0.f;
#pragma unroll
                for (int s_ = 0; s_ < 8; ++s_) {
                    const s16x4_t al = vtr(ap + s_ * 1024), ah = vtr(ap + s_ * 1024 + 256), bl = vtr(bp + s_ * 1024), bhh = vtr(bp + s_ * 1024 + 256);
                    if (s_ & 1) s2 = MFMA32(__builtin_shufflevector(bl, bhh, 0, 1, 2, 3, 4, 5, 6, 7), __builtin_shufflevector(al, ah, 0, 1, 2, 3, 4, 5, 6, 7), s2);
                    else st = MFMA32(__builtin_shufflevector(bl, bhh, 0, 1, 2, 3, 4, 5, 6, 7), __builtin_shufflevector(al, ah, 0, 1, 2, 3, 4, 5, 6, 7), st);
                }
#pragma unroll
                for (int i = 0; i < 16; ++i) st[i] = (st[i] + s2[i]) * g128;
#pragma unroll
                for (int g = 0; g < 4; ++g) { v2u wv; wv.x = cvtpk(st[4 * g], st[4 * g + 1]); wv.y = cvtpk(st[4 * g + 2], st[4 * g + 3]); *(v2u*)(dst + (size_t)n * 8192 + 8 * g) = wv; }
            }
            slot = slot == 5 ? 0 : slot + 1;
        }
#undef RS_DMA
#undef RS_ADDR
    }
    asm volatile("s_waitcnt vmcnt(0) lgkmcnt(0)" ::: "memory"); __builtin_amdgcn_s_barrier(); asm volatile("" ::: "memory");
}
__device__ __forceinline__ void p4_ret_out(Frame& F) {
    int lane = F.lane; asm volatile("" : "+v"(lane));
    const int r = lane & 31, hh = lane >> 5, wave = F.wave, qw = wave & 3, eh = wave >> 2;
    const bf16* RQ = (const bf16*)(F.ws + WS_RQ); const bf16* RK = (const bf16*)(F.ws + WS_RK); const bf16* RV = (const bf16*)(F.ws + WS_RV); const bf16* RG = (const bf16*)(F.ws + WS_RG);
    const bf16* ST = (const bf16*)(F.ws + WS_ST); unsigned char* MIX = F.ws + WS_MIX;
    LAS float* ssx = (LAS float*)(F.lds + 98304);
    const int NU = 64 * 32;
#define RO_DMA(u_, buf_) do { const int bh_ = (u_) >> 5, c_ = ((u_) & 31) + 1, b_ = bh_ >> 2, h_ = bh_ & 3; const size_t row0_ = (size_t)b_ * RROWS + 128 * c_; LAS unsigned char* kim_ = F.lds + (buf_) * 49152; \
        _Pragma("unroll") for (int i_ = 0; i_ < 2; ++i_) { const int p_ = 2 * wave + i_; GLDS16R(RK + (row0_ + 64 * (p_ & 1) + lane) * 256 + 64 * h_ + 8 * (p_ >> 1), kim_ + (p_ >> 1) * 2048 + (p_ & 1) * 1024); } \
        _Pragma("unroll") for (int i_ = 0; i_ < 4; ++i_) { const int p_ = 4 * wave + i_; GLDS16R(RV + (row0_ + 16 * (p_ & 7) + (lane >> 2)) * 512 + 128 * h_ + 32 * (p_ >> 3) + 8 * (lane & 3), kim_ + 16384 + (p_ >> 3) * 8192 + (p_ & 7) * 1024); } } while (0)
#define RO_REGS(u_, QF, SB, GV) do { const int bh_ = (u_) >> 5, c_ = ((u_) & 31) + 1, b_ = bh_ >> 2, h_ = bh_ & 3; const size_t tok_ = (size_t)b_ * SEQ + 128 * (c_ - 1) + 32 * qw + r; \
        _Pragma("unroll") for (int s_ = 0; s_ < 4; ++s_) QF[s_] = *(const bf16x8_t*)(RQ + tok_ * 256 + 64 * h_ + 16 * s_ + 8 * hh); \
        const bf16* sp_ = ST + ((size_t)(bh_ * 32 + (c_ - 1)) * 128 + 64 * eh + r) * 64 + 8 * hh; \
        _Pragma("unroll") for (int k_ = 0; k_ < 2; ++k_) _Pragma("unroll") for (int s_ = 0; s_ < 4; ++s_) SB[k_][s_] = *(const bf16x8_t*)(sp_ + (size_t)k_ * 32 * 64 + 16 * s_); \
        const bf16* gp_ = RG + tok_ * 512 + 128 * h_ + 64 * eh + 8 * hh; \
        _Pragma("unroll") for (int k_ = 0; k_ < 2; ++k_) _Pragma("unroll") for (int g_ = 0; g_ < 2; ++g_) GV[k_][g_] = *(const v4u*)(gp_ + 32 * k_ + 16 * g_); } while (0)
    bf16x8_t qf[4], sb[2][4], nqf[4], nsb[2][4]; v4u gv[2][2], ngv[2][2];
    int u = F.vcu;
    if (u < NU) { RO_REGS(u, qf, sb, gv); RO_DMA(u, 0); }
    int buf = 0;
    for (; u < NU; u += F.G) {
        asm volatile("s_waitcnt vmcnt(0) lgkmcnt(0)" ::: "memory"); __builtin_amdgcn_s_barrier(); asm volatile("" ::: "memory");
        const int un = u + F.G;
        f32x16 y[2];
#pragma unroll
        for (int k = 0; k < 2; ++k)
#pragma unroll
            for (int i = 0; i < 16; ++i) y[k][i] = 0.f;
#pragma unroll
        for (int s_ = 0; s_ < 4; ++s_)
#pragma unroll
            for (int k = 0; k < 2; ++k) y[k] = MFMA32(sb[k][s_], qf[s_], y[k]);
        if (un < NU) { RO_REGS(un, nqf, nsb, ngv); RO_DMA(un, buf ^ 1); }
        const int bh = u >> 5, c = (u & 31) + 1, b = bh >> 2, h = bh & 3;
        const LAS unsigned char* kimg = F.lds + buf * 49152; const LAS unsigned char* vimg = kimg + 16384;
        const LAS unsigned char* kfb = kimg + hh * 2048 + r * 16;
        const LAS unsigned char* vfb = vimg + (2 * eh) * 8192 + (4 * hh + ((lane & 15) >> 2)) * 64 + ((lane >> 4) & 1) * 32 + (lane & 3) * 8;
#pragma unroll 1
        for (int kvb = 0; kvb <= qw; ++kvb) {
            f32x16 p;
#pragma unroll
            for (int i = 0; i < 16; ++i) p[i] = 0.f;
#pragma unroll
            for (int s_ = 0; s_ < 4; ++s_) { const bf16x8_t kf = *(const LAS bf16x8_t*)(kfb + s_ * 4096 + kvb * 512); p = MFMA32(kf, qf[s_], p); }
            if (kvb == qw) {
#pragma unroll
                for (int i = 0; i < 16; ++i) if (crow(i, hh) > r) p[i] = 0.f;
            }
            const bf16x8_t pa0 = pack8(p, 0), pa1 = pack8(p, 8);
#pragma unroll
            for (int k = 0; k < 2; ++k) {
                const LAS unsigned char* vp = vfb + k * 8192 + kvb * 2048;
                const s16x4_t l0 = vtr(vp), h0 = vtr(vp + 512), l1 = vtr(vp + 1024), h1 = vtr(vp + 1536);
                y[k] = MFMA32(__builtin_shufflevector(l0, h0, 0, 1, 2, 3, 4, 5, 6, 7), pa0, y[k]);
                y[k] = MFMA32(__builtin_shufflevector(l1, h1, 0, 1, 2, 3, 4, 5, 6, 7), pa1, y[k]);
            }
        }
        float ss = 0.f;
#pragma unroll
        for (int k = 0; k < 2; ++k)
#pragma unroll
            for (int i = 0; i < 16; ++i) ss += y[k][i] * y[k][i];
        ss += half_swap(ss);
        if (hh == 0) ssx[wave * 32 + r] = ss;
        asm volatile("s_waitcnt lgkmcnt(0)" ::: "memory"); __builtin_amdgcn_s_barrier(); asm volatile("" ::: "memory");
        const float rinv = rsqrtf((ss + ssx[(wave ^ 4) * 32 + r]) * (1.f / 128.f) + EPS) * MIX_SCALE;
        unsigned char* __restrict__ orow = MIX + ((size_t)b * SEQ + 128 * (c - 1) + 32 * qw + r) * 1024 + 512 + 128 * h + 64 * eh + 16 * hh;
#pragma unroll
        for (int k = 0; k < 2; ++k) {
            unsigned d[4];
#pragma unroll
            for (int gp = 0; gp < 2; ++gp) {
                unsigned ga0 = gv[k][gp].x, ga1 = gv[k][gp].y, gb0 = gv[k][gp].z, gb1 = gv[k][gp].w;
                swap32(ga0, gb0); swap32(ga1, gb1);
#pragma unroll
                for (int gg = 0; gg < 2; ++gg) { const int g = 2 * gp + gg; float o4[4];
#pragma unroll
                    for (int j = 0; j < 4; ++j) { const unsigned gw_ = gg == 0 ? (j < 2 ? ga0 : ga1) : (j < 2 ? gb0 : gb1); const float gt = __builtin_bit_cast(float, (j & 1) ? (gw_ & 0xffff0000u) : (gw_ << 16));
                        const float sg = gt * __builtin_amdgcn_rcpf(1.f + __builtin_amdgcn_exp2f(-1.4426950408889634f * gt)); o4[j] = __builtin_amdgcn_fmed3f(y[k][4 * g + j] * rinv * sg, -448.f, 448.f); }
                    d[g] = pk_fp8x4(o4[0], o4[1], o4[2], o4[3]); } }
            swap32(d[0], d[2]); swap32(d[1], d[3]);
            v4u w; w.x = d[0]; w.y = d[2]; w.z = d[1]; w.w = d[3];
            *(v4u*)(orow + 32 * k) = w; }
#pragma unroll
        for (int s_ = 0; s_ < 4; ++s_) { qf[s_] = nqf[s_]; sb[0][s_] = nsb[0][s_]; sb[1][s_] = nsb[1][s_]; }
#pragma unroll
        for (int k = 0; k < 2; ++k)
#pragma unroll
            for (int g = 0; g < 2; ++g) gv[k][g] = ngv[k][g];
        buf ^= 1;
    }
#undef RO_DMA
#undef RO_REGS
    asm volatile("s_waitcnt vmcnt(0) lgkmcnt(0)" ::: "memory"); __builtin_amdgcn_s_barrier(); asm volatile("" ::: "memory");
}

struct EpiOutProj {
    static constexpr bool PERM = true;
    const bf16* __restrict__ x; bf16* __restrict__ h1;
    __device__ __forceinline__ void prefetch(const pg8::Unit&, LAS unsigned char*, int, int) const {}
    __device__ __forceinline__ void operator()(const pg8::f32x4 (&acc)[2][2][4][2], const pg8::Unit& u, int wr, int wc, int fr, int fq, const LAS unsigned char* tab) const {
        const int row0 = u.pm * 256 + wr * 64 + fr, col0 = u.pn * 256 + wc * 32 + 8 * fq;
        pg8::u32x4 xr[2][4][2];
#pragma unroll
        for (int ai = 0; ai < 2; ++ai)
#pragma unroll
            for (int m = 0; m < 4; ++m) { const size_t off = (size_t)(row0 + ai * 128 + m * 16) * D + col0;
#pragma unroll
                for (int bj = 0; bj < 2; ++bj) xr[ai][m][bj] = __builtin_nontemporal_load((const pg8::u32x4*)(x + off + bj * 128)); }
#pragma unroll
        for (int ai = 0; ai < 2; ++ai)
#pragma unroll
            for (int m = 0; m < 4; ++m) { const size_t off = (size_t)(row0 + ai * 128 + m * 16) * D + col0;
#pragma unroll
                for (int bj = 0; bj < 2; ++bj) { pg8::f32x4 v0, v1; pg8::u32x4 w;
#pragma unroll
                    for (int j_ = 0; j_ < 4; ++j_) { const unsigned xa_ = xr[ai][m][bj][j_ >> 1], xb_ = xr[ai][m][bj][2 + (j_ >> 1)];
                        const float x0_ = __builtin_bit_cast(float, (j_ & 1) ? (xa_ & 0xffff0000u) : (xa_ << 16)), x1_ = __builtin_bit_cast(float, (j_ & 1) ? (xb_ & 0xffff0000u) : (xb_ << 16));
                        float t0_ = __builtin_fmaf(acc[ai][bj][m][0][j_], 1.f / (MIX_SCALE * WSCALE), x0_); asm("" : "+v"(t0_)); v0[j_] = t0_;
                        float t1_ = __builtin_fmaf(acc[ai][bj][m][1][j_], 1.f / (MIX_SCALE * WSCALE), x1_); asm("" : "+v"(t1_)); v1[j_] = t1_; }
                    w.x = pg8::cvt_pk_bf16(v0[0], v0[1]); w.y = pg8::cvt_pk_bf16(v0[2], v0[3]); w.z = pg8::cvt_pk_bf16(v1[0], v1[1]); w.w = pg8::cvt_pk_bf16(v1[2], v1[3]);
                    *(pg8::u32x4*)(h1 + off + bj * 128) = w; } }
    }
};

typedef float f32x16 __attribute__((ext_vector_type(16)));
typedef short s16x8 __attribute__((ext_vector_type(8)));
__device__ __forceinline__ void p6_router(Frame& F) {
    LAS int* hist = (LAS int*)(F.lds + RING_BYTES + 512);
    LAS unsigned char* xbw = F.lds + F.wave * 16384;
    LAS float* wl = (LAS float*)xbw;
    LAS float* rsb = wl + 32 * 36;
    const bf16* h1 = (const bf16*)(F.ws + WS_H1); bf16* XN2 = (bf16*)(F.ws + WS_XN2); const bf16* wrf = (const bf16*)(F.ws + WS_WRF);
    int* TOPE = (int*)(F.ws + WS_TOPE); float* TOPG = (float*)(F.ws + WS_TOPG); int* RANK = (int*)(F.ws + WS_RANK); float* RSTD = (float*)(F.ws + WS_RSTD);
    const int r = F.lane & 31, hi = F.lane >> 5;
    LAS float* gsh = (LAS float*)(F.lds + RING_BYTES + 1024);
    for (int i = F.tid; i < D; i += NWAVES * 64) gsh[i] = F.ffn_g[i];
    const LAS float* gl = gsh + 8 * hi;
    const int l4 = F.lane >> 4, l15 = F.lane & 15;
    for (int c = F.vcu; c < T / 256; c += F.G) {
        if (F.tid < NE) hist[F.tid] = 0;
        __syncthreads();
        const int row0 = c * 256 + F.wave * 32;
        const bf16* __restrict__ wrfp = wrf + (size_t)F.lane * 8;
        const bf16* xbase = h1 + (size_t)row0 * D;
        unsigned char* xo8 = (unsigned char*)XN2 + (size_t)row0 * D;
#define RT_DMA(cc, bufo) do { _Pragma("unroll") for (int i_ = 0; i_ < 8; ++i_) { const unsigned vo_ = (unsigned)l4 * (D * 2) + (unsigned)((l15 ^ ((4 * i_ + l4) & 15)) << 4); \
            glds16_sbase(xbase + (size_t)(4 * i_) * D + (cc) * 128, vo_, xbw + (bufo) + i_ * 1024); } } while (0)
        f32x16 acc;
#pragma unroll
        for (int i = 0; i < 16; ++i) acc[i] = 0.f;
        float ss = 0.f;
        const unsigned rdo = (unsigned)((r >> 2) * 1024 + ((r & 3) << 8)), rsw = (unsigned)(r & 15);
        v4u wa[8], wb[8];
#define RT_LOADW(W, s0) do { _Pragma("unroll") for (int q_ = 0; q_ < 4; ++q_) { \
            W[2 * q_] = *(const v4u*)(wrfp + (size_t)((s0) + q_) * 512); W[2 * q_ + 1] = *(const v4u*)(wrfp + (size_t)(4096 + ((s0) + q_) * 64) * 8); } } while (0)
#define RT_STEP(W, s0, xbuf) do { _Pragma("unroll") for (int q_ = 0; q_ < 4; ++q_) { const int sl_ = ((s0) + q_) & 7; \
            const v4u xw = *(const LAS v4u*)((xbuf) + rdo + (((unsigned)(2 * sl_ + hi) ^ rsw) << 4)); \
            const f32x4 x0 = {__builtin_bit_cast(float, xw.x << 16), __builtin_bit_cast(float, xw.x & 0xffff0000u), __builtin_bit_cast(float, xw.y << 16), __builtin_bit_cast(float, xw.y & 0xffff0000u)}; \
            const f32x4 x1 = {__builtin_bit_cast(float, xw.z << 16), __builtin_bit_cast(float, xw.z & 0xffff0000u), __builtin_bit_cast(float, xw.w << 16), __builtin_bit_cast(float, xw.w & 0xffff0000u)}; \
            ss += (x0[0] * x0[0] + x0[1] * x0[1]) + (x0[2] * x0[2] + x0[3] * x0[3]) + (x1[0] * x1[0] + x1[1] * x1[1]) + (x1[2] * x1[2] + x1[3] * x1[3]); \
            const f32x4 y0 = x0 * *(const LAS f32x4*)(gl + 16 * ((s0) + q_)), y1 = x1 * *(const LAS f32x4*)(gl + 16 * ((s0) + q_) + 4); v4u ah, al; \
            ah.x = pg8::cvt_pk_bf16(y0[0], y0[1]); ah.y = pg8::cvt_pk_bf16(y0[2], y0[3]); ah.z = pg8::cvt_pk_bf16(y1[0], y1[1]); ah.w = pg8::cvt_pk_bf16(y1[2], y1[3]); \
            al.x = pg8::cvt_pk_bf16(y0[0] - __builtin_bit_cast(float, ah.x << 16), y0[1] - __builtin_bit_cast(float, ah.x & 0xffff0000u)); \
            al.y = pg8::cvt_pk_bf16(y0[2] - __builtin_bit_cast(float, ah.y << 16), y0[3] - __builtin_bit_cast(float, ah.y & 0xffff0000u)); \
            al.z = pg8::cvt_pk_bf16(y1[0] - __builtin_bit_cast(float, ah.z << 16), y1[1] - __builtin_bit_cast(float, ah.z & 0xffff0000u)); \
            al.w = pg8::cvt_pk_bf16(y1[2] - __builtin_bit_cast(float, ah.w << 16), y1[3] - __builtin_bit_cast(float, ah.w & 0xffff0000u)); \
            const s16x8 Ah = __builtin_bit_cast(s16x8, ah), Al = __builtin_bit_cast(s16x8, al), Bh = __builtin_bit_cast(s16x8, W[2 * q_]), Bl = __builtin_bit_cast(s16x8, W[2 * q_ + 1]); \
            acc = __builtin_amdgcn_mfma_f32_32x32x16_bf16(Ah, Bh, acc, 0, 0, 0); acc = __builtin_amdgcn_mfma_f32_32x32x16_bf16(Al, Bh, acc, 0, 0, 0); acc = __builtin_amdgcn_mfma_f32_32x32x16_bf16(Ah, Bl, acc, 0, 0, 0); } } while (0)
#define RT_FP8(cc, xbuf) do { _Pragma("unroll") for (int i_ = 0; i_ < 8; ++i_) { const int row_ = 4 * i_ + l4, p_ = l15 ^ (row_ & 15); \
            const v4u xw = *(const LAS v4u*)((xbuf) + i_ * 1024 + F.lane * 16); const LAS float* g_ = gsh + (cc) * 128 + p_ * 8; const f32x4 g0 = *(const LAS f32x4*)g_, g1 = *(const LAS f32x4*)(g_ + 4); \
            v2u x8; x8.x = pk_fp8x4(__builtin_bit_cast(float, xw.x << 16) * g0[0], __builtin_bit_cast(float, xw.x & 0xffff0000u) * g0[1], __builtin_bit_cast(float, xw.y << 16) * g0[2], __builtin_bit_cast(float, xw.y & 0xffff0000u) * g0[3]); \
            x8.y = pk_fp8x4(__builtin_bit_cast(float, xw.z << 16) * g1[0], __builtin_bit_cast(float, xw.z & 0xffff0000u) * g1[1], __builtin_bit_cast(float, xw.w << 16) * g1[2], __builtin_bit_cast(float, xw.w & 0xffff0000u) * g1[3]); \
            *(v2u*)(xo8 + (size_t)row_ * D + (cc) * 128 + p_ * 8) = x8; } } while (0)
        asm volatile("s_waitcnt lgkmcnt(0)" ::: "memory");
        RT_DMA(0, 0);
        RT_LOADW(wa, 0);
#pragma unroll 1
        for (int cc = 0; cc < 8; ++cc) {
            const unsigned bo = (unsigned)(cc & 1) * 8192u;
            if (cc + 1 < 8) { RT_DMA(cc + 1, 8192u - bo); asm volatile("s_waitcnt vmcnt(8)" ::: "memory"); }
            else asm volatile("s_waitcnt vmcnt(0)" ::: "memory");
            const LAS unsigned char* xbuf = xbw + bo;
            RT_FP8(cc, xbuf);
            RT_LOADW(wb, 8 * cc + 4);
            RT_STEP(wa, 8 * cc, xbuf);
            if (cc + 1 < 8) { RT_LOADW(wa, 8 * cc + 8); }
            RT_STEP(wb, 8 * cc + 4, xbuf);
            asm volatile("s_waitcnt lgkmcnt(0)" ::: "memory");
        }
#undef RT_DMA
#undef RT_LOADW
#undef RT_STEP
#undef RT_FP8
        ss += __shfl_xor(ss, 32);
        const float rstd = rsqrtf(ss * (1.f / D) + EPS);
        if (hi == 0) { rsb[r] = rstd; RSTD[row0 + r] = rstd; }
        LDS_WAIT(); asm volatile("" ::: "memory");
        const float bias = F.b_router[r];
#pragma unroll
        for (int i = 0; i < 16; ++i) { const int row = (i & 3) + 8 * (i >> 2) + 4 * hi; wl[row * 36 + r] = acc[i] * rsb[row] + bias; }
        LDS_WAIT(); asm volatile("" ::: "memory");
        if (hi == 0) {
            float v0 = -INFINITY, v1 = -INFINITY, v2 = -INFINITY, v3 = -INFINITY; int i0 = 0, i1 = 0, i2 = 0, i3 = 0;
#pragma unroll
            for (int q = 0; q < 8; ++q) { const f32x4 lv = *(const LAS f32x4*)(wl + r * 36 + 4 * q);
#pragma unroll
                for (int jj = 0; jj < 4; ++jj) { const float xv = lv[jj]; const int e = 4 * q + jj;
                    if (xv > v3) {
                        if (xv > v0) { v3 = v2; i3 = i2; v2 = v1; i2 = i1; v1 = v0; i1 = i0; v0 = xv; i0 = e; }
                        else if (xv > v1) { v3 = v2; i3 = i2; v2 = v1; i2 = i1; v1 = xv; i1 = e; }
                        else if (xv > v2) { v3 = v2; i3 = i2; v2 = xv; i2 = e; }
                        else { v3 = xv; i3 = e; }
                    } } }
            const float e1 = __expf(v1 - v0), e2 = __expf(v2 - v0), e3 = __expf(v3 - v0); const float inv = 1.f / (1.f + e1 + e2 + e3);
            const int tok = row0 + r;
            *(int4*)(TOPE + tok * 4) = make_int4(i0, i1, i2, i3);
            *(float4*)(TOPG + tok * 4) = make_float4(inv, e1 * inv, e2 * inv, e3 * inv);
            const int r0 = __hip_atomic_fetch_add(&hist[i0], 1, __ATOMIC_RELAXED, __HIP_MEMORY_SCOPE_WORKGROUP), r1 = __hip_atomic_fetch_add(&hist[i1], 1, __ATOMIC_RELAXED, __HIP_MEMORY_SCOPE_WORKGROUP),
                      r2 = __hip_atomic_fetch_add(&hist[i2], 1, __ATOMIC_RELAXED, __HIP_MEMORY_SCOPE_WORKGROUP), r3 = __hip_atomic_fetch_add(&hist[i3], 1, __ATOMIC_RELAXED, __HIP_MEMORY_SCOPE_WORKGROUP);
            *(int4*)(RANK + tok * 4) = make_int4(r0, r1, r2, r3);
        }
        __syncthreads();
        if (F.tid < NE) hist[NE + F.tid] = (int)__hip_atomic_fetch_add((unsigned*)(F.ws + WS_CTL) + CW_GCNT + 64 * F.tid, (unsigned)hist[F.tid], __ATOMIC_RELAXED, __HIP_MEMORY_SCOPE_AGENT);
        __syncthreads();
        { int* RT = (int*)(F.ws + WS_ROWTOK_S); float* RR = (float*)(F.ws + WS_ROWRSTD_S); float* RGt = (float*)(F.ws + WS_ROWGATE_S);
          const int tok = c * 256 + (F.tid >> 1); const float rs = RSTD[tok];
#pragma unroll
          for (int kk = 0; kk < 2; ++kk) { const int k = (F.tid & 1) * 2 + kk; const int e = TOPE[tok * 4 + k]; const int dst = e * CAP + hist[NE + e] + RANK[tok * 4 + k];
              RT[dst] = tok * 4 + k; RR[dst] = rs; RGt[dst] = TOPG[tok * 4 + k]; } }
        __syncthreads();
    }
}

struct MoeOrder {
    const LAS int* te; const int* rowtok; int npn, G, c, Kb;
    __device__ __forceinline__ bool next(int i, pg8::Unit& u) const {
        const int L = i * G + c; const int nt = __builtin_amdgcn_readfirstlane(te[NTILES_MAX]);
        if (L >= nt * npn) return false;
        u.pm = L / npn; u.pn = L - u.pm * npn; u.e = __builtin_amdgcn_readfirstlane(te[u.pm]); u.sb = __builtin_amdgcn_readfirstlane(te[NTILES_MAX + 8 + u.pm]); return true;
    }
    __device__ __forceinline__ unsigned rowoff(const pg8::Unit& u, int r) const { const int v = rowtok[u.sb + r]; return (unsigned)(v < 0 ? 0 : (v >> 2)) * (unsigned)Kb; }
};
__device__ __forceinline__ void moe_tile_table(Frame& F) {
    LAS int* te = (LAS int*)(F.lds + TILE_E_OFF); LAS int* ts = te + NTILES_MAX + 8; LAS int* tb = (LAS int*)F.lds;
    const unsigned* gc = (const unsigned*)(F.ws + WS_CTL) + CW_GCNT;
    __syncthreads();
    if (F.tid == 0) { int p = 0; for (int e = 0; e < NE; ++e) { tb[e] = p; p += ((int)gc[64 * e] + 255) >> 8; } tb[NE] = p; te[NTILES_MAX] = p; }
    __syncthreads();
    for (int i = F.tid; i < NTILES_MAX; i += NWAVES * 64) { int e = 0;
#pragma unroll 1
        for (int q = 1; q < NE; ++q) e += (tb[q] <= i) ? 1 : 0;
        const bool ok = i < tb[NE]; te[i] = ok ? e : 0; ts[i] = ok ? e * CAP + 256 * (i - tb[e]) : 0; }
    __syncthreads();
}
__device__ __forceinline__ void swap16(unsigned& a, unsigned& b) { asm volatile("s_nop 1\n\tv_permlane16_swap_b32 %0, %1\n\ts_nop 1" : "+v"(a), "+v"(b)); }
#define SWAP16(A, B) do { unsigned a_ = (A), b_ = (B); swap16(a_, b_); (A) = a_; (B) = b_; } while (0)
struct EpiUp {
    static constexpr bool PERM = true;
    const float* __restrict__ bup; unsigned char* __restrict__ HB; const float* __restrict__ rowrstd;
    __device__ __forceinline__ void prefetch(const pg8::Unit& u, LAS unsigned char* tab, int wid, int lane) const {
        if (wid == 0) GLDS16R(bup + (size_t)u.e * 2048 + 256 * u.pn + 4 * lane, tab);
        else if (wid == 2) GLDS16R(rowrstd + (size_t)u.sb + 4 * lane, tab + 2048);
    }
    __device__ __forceinline__ void operator()(const pg8::f32x4 (&acc)[2][2][4][2], const pg8::Unit& u, int wr, int wc, int fr, int fq, const LAS unsigned char* tab) const {
        const int j0 = 128 * u.pn + 32 * wc + 8 * fq;
        const LAS float* tb = (const LAS float*)tab + 2 * (32 * wc + 8 * fq);
        pg8::f32x4 b4[4];
        constexpr float KS = -1.702f * 1.4426950408889634f, KI = 1.f / KS;
#pragma unroll
        for (int q = 0; q < 4; ++q) { b4[q] = ((const LAS pg8::f32x4*)tb)[q]; b4[q][0] *= KS; b4[q][2] *= KS; b4[q][1] = (b4[q][1] + 1.f) * KI; b4[q][3] = (b4[q][3] + 1.f) * KI; }
        float rs8[2][4];
#pragma unroll
        for (int ai = 0; ai < 2; ++ai)
#pragma unroll
            for (int m = 0; m < 4; ++m) rs8[ai][m] = ((const LAS float*)(tab + 2048))[ai * 128 + wr * 64 + m * 16 + fr];
#pragma unroll
        for (int ai = 0; ai < 2; ++ai)
#pragma unroll
            for (int mp = 0; mp < 4; mp += 2) {
                v2u w2[2];
#pragma unroll
                for (int mm = 0; mm < 2; ++mm) { const int m = mp + mm; const float rsg = rs8[ai][m] * (WDESCALE * KS), rsl = rs8[ai][m] * (WDESCALE * KI);
                    float o[8];
#pragma unroll
                    for (int n = 0; n < 2; ++n)
#pragma unroll
                        for (int i = 0; i < 4; ++i) {
                            float glu = acc[ai][0][m][n][i] * rsg + b4[2 * n + (i >> 1)][2 * (i & 1)], lin = acc[ai][1][m][n][i] * rsl + b4[2 * n + (i >> 1)][2 * (i & 1) + 1];
                            glu = fmaxf(glu, 7.f * KS); lin = fminf(fmaxf(lin, 8.f * KI), -6.f * KI);
                            const float sg = __builtin_amdgcn_rcpf(1.f + __builtin_amdgcn_exp2f(glu));
                            o[4 * n + i] = glu * sg * lin;
                        }
                    w2[mm].x = pk_fp8x4(o[0], o[1], o[2], o[3]); w2[mm].y = pk_fp8x4(o[4], o[5], o[6], o[7]); }
                SWAP16(w2[0].x, w2[1].x); SWAP16(w2[0].y, w2[1].y);
                const size_t row = (size_t)u.pm * 256 + ai * 128 + wr * 64 + (mp + (fq & 1)) * 16 + fr;
                v4u w; w.x = w2[0].x; w.y = w2[0].y; w.z = w2[1].x; w.w = w2[1].y;
                *(v4u*)(HB + row * D + j0 - 8 * (fq & 1)) = w;
            }
    }
};
struct EpiDown {
    static constexpr bool PERM = true;
    const int* __restrict__ rowtok; const float* __restrict__ rowgate; const float* __restrict__ bdn; unsigned char* __restrict__ ws;
    __device__ __forceinline__ void prefetch(const pg8::Unit& u, LAS unsigned char* tab, int wid, int lane) const {
        if (wid == 0) GLDS16R(bdn + (size_t)u.e * D + 256 * u.pn + 4 * lane, tab);
        else if (wid == 1) GLDS16R(rowtok + (size_t)u.sb + 4 * lane, tab + 1024);
        else if (wid == 2) GLDS16R(rowgate + (size_t)u.sb + 4 * lane, tab + 2048);
    }
    __device__ __forceinline__ void operator()(const pg8::f32x4 (&acc)[2][2][4][2], const pg8::Unit& u, int wr, int wc, int fr, int fq, const LAS unsigned char* tab) const {
        const int c0 = 256 * u.pn + 32 * wc + 8 * fq;
        const LAS float* bb = (const LAS float*)tab + 32 * wc + 8 * fq;
        pg8::f32x4 b4[2][2];
#pragma unroll
        for (int bj = 0; bj < 2; ++bj)
#pragma unroll
            for (int n = 0; n < 2; ++n) b4[bj][n] = *(const LAS pg8::f32x4*)(bb + 128 * bj + 4 * n);
        int tk8[2][4]; float gt8[2][4];
#pragma unroll
        for (int ai = 0; ai < 2; ++ai)
#pragma unroll
            for (int m = 0; m < 4; ++m) { tk8[ai][m] = ((const LAS int*)(tab + 1024))[ai * 128 + wr * 64 + m * 16 + fr]; gt8[ai][m] = ((const LAS float*)(tab + 2048))[ai * 128 + wr * 64 + m * 16 + fr]; }
#pragma unroll
        for (int ai = 0; ai < 2; ++ai)
#pragma unroll
            for (int m = 0; m < 4; ++m) {
                const int tk = tk8[ai][m];
                if (tk >= 0) {
                    const float gate = gt8[ai][m] * SLOT_SCALE; const float gsc = gate * WDESCALE; const int k = tk & 3;
                    const size_t soff = k == 0 ? WS_SLOT0 : (k == 1 ? WS_SLOT1 : (k == 2 ? WS_SLOT2 : WS_SLOT3));
                    unsigned char* p = (ws + soff) + (size_t)(tk >> 2) * D + c0;
                    v2u w2[2];
#pragma unroll
                    for (int bj = 0; bj < 2; ++bj) { float v_[8];
#pragma unroll
                        for (int i_ = 0; i_ < 8; ++i_) { float t_ = __builtin_fmaf(acc[ai][bj][m][i_ >> 2][i_ & 3], WDESCALE, b4[bj][i_ >> 2][i_ & 3]); asm("" : "+v"(t_)); float y_ = t_ * gate; asm("" : "+v"(y_)); v_[i_] = y_; }
                        w2[bj].x = pk_fp8x4(v_[0], v_[1], v_[2], v_[3]); w2[bj].y = pk_fp8x4(v_[4], v_[5], v_[6], v_[7]); }
                    SWAP16(w2[0].x, w2[1].x); SWAP16(w2[0].y, w2[1].y);
                    v4u w; w.x = w2[0].x; w.y = w2[0].y; w.z = w2[1].x; w.w = w2[1].y;
                    *(v4u*)(p + 120 * (fq & 1)) = w;
                }
            }
    }
};
__device__ __forceinline__ void p10_final(Frame& F) {
    const int gw = F.vcu * NWAVES + F.wave, NGW = F.G * NWAVES;
    const unsigned char* s0 = F.ws + WS_SLOT0; const unsigned char* s1 = F.ws + WS_SLOT1; const unsigned char* s2 = F.ws + WS_SLOT2; const unsigned char* s3 = F.ws + WS_SLOT3;
    typedef float f32x2v __attribute__((ext_vector_type(2)));
#pragma unroll 2
    for (int m = gw; m < T; m += NGW) {
        const uint2* __restrict__ pin = (const uint2*)((const bf16*)(F.ws + WS_H1) + (size_t)m * D); float4* __restrict__ p = (float4*)(F.out + (size_t)m * D);
        float4 v[4]; float ss = 0.f;
#pragma unroll
        for (int q = 0; q < 4; ++q) { { const v2u hw_ = __builtin_nontemporal_load((const v2u*)pin + F.lane + 64 * q); const uint2 hw = make_uint2(hw_.x, hw_.y); v[q] = make_float4(__builtin_bit_cast(float, hw.x << 16), __builtin_bit_cast(float, hw.x & 0xffff0000u), __builtin_bit_cast(float, hw.y << 16), __builtin_bit_cast(float, hw.y & 0xffff0000u)); }
            const int z = __builtin_nontemporal_load((const int*)(s0 + (size_t)m * D) + F.lane + 64 * q), a = __builtin_nontemporal_load((const int*)(s1 + (size_t)m * D) + F.lane + 64 * q), b = __builtin_nontemporal_load((const int*)(s2 + (size_t)m * D) + F.lane + 64 * q), c = __builtin_nontemporal_load((const int*)(s3 + (size_t)m * D) + F.lane + 64 * q);
            const f32x2v zl = __builtin_amdgcn_cvt_pk_f32_fp8(z, false), zh = __builtin_amdgcn_cvt_pk_f32_fp8(z, true), al = __builtin_amdgcn_cvt_pk_f32_fp8(a, false), ah = __builtin_amdgcn_cvt_pk_f32_fp8(a, true);
            const f32x2v bl = __builtin_amdgcn_cvt_pk_f32_fp8(b, false), bh = __builtin_amdgcn_cvt_pk_f32_fp8(b, true), cl = __builtin_amdgcn_cvt_pk_f32_fp8(c, false), ch = __builtin_amdgcn_cvt_pk_f32_fp8(c, true);
            v[q].x += ((zl[0] + al[0]) + (bl[0] + cl[0])) * (1.f / SLOT_SCALE); v[q].y += ((zl[1] + al[1]) + (bl[1] + cl[1])) * (1.f / SLOT_SCALE);
            v[q].z += ((zh[0] + ah[0]) + (bh[0] + ch[0])) * (1.f / SLOT_SCALE); v[q].w += ((zh[1] + ah[1]) + (bh[1] + ch[1])) * (1.f / SLOT_SCALE);
            ss += v[q].x * v[q].x + v[q].y * v[q].y + v[q].z * v[q].z + v[q].w * v[q].w; }
        const float rs = rsqrtf(wave_sum(ss) * (1.f / D) + EPS);
#pragma unroll
        for (int q = 0; q < 4; ++q) { const float4 gg = ((const float4*)F.final_g)[F.lane + 64 * q]; { f32x4 ov = {v[q].x * rs * gg.x, v[q].y * rs * gg.y, v[q].z * rs * gg.z, v[q].w * rs * gg.w}; *((f32x4*)p + F.lane + 64 * q) = ov; } }
    }
}

__global__ void __launch_bounds__(NWAVES * 64, 2) mk_fwd(Args args) {
    extern __shared__ __attribute__((aligned(16))) unsigned char lds[];
    Frame F;
    F.lds = (LAS unsigned char*)lds;
    F.tid = threadIdx.x; F.lane = F.tid & 63; F.wave = __builtin_amdgcn_readfirstlane(F.tid >> 6);
    F.G = gridDim.x; { const int bx = blockIdx.x; F.vcu = (F.G % 8 == 0) ? (bx % 8) * (F.G / 8) + bx / 8 : bx; }
    F.x = args.in[0]; F.meta = args.in[1]; F.attn_g = args.in[2]; F.w_in = args.in[3]; F.dlam = args.in[4]; F.subln = args.in[5]; F.w_out = args.in[6]; F.ffn_g = args.in[7];
    F.w_router = args.in[8]; F.b_router = args.in[9]; F.w_up = args.in[10]; F.b_up = args.in[11]; F.w_down = args.in[12]; F.b_down = args.in[13]; F.final_g = args.in[14];
    F.out = args.out; F.ws = args.ws;
    volatile LAS unsigned* MISC = (volatile LAS unsigned*)(F.lds + MISC_OFF);
    for (int u = F.tid; u < (TILE_E_OFF - LDSCTL_OFF) / 4; u += NWAVES * 64) ((LAS unsigned*)(F.lds + LDSCTL_OFF))[u] = 0u;
    __syncthreads();
    unsigned* ctl = (unsigned*)(F.ws + WS_CTL);
    XcdBarrier bar = xcd_barrier_post(ctl + CW_BAR + args.li * XCD_BAR_WORDS, MISC + 8);
    const int lo = args.ph_lo, hi = args.ph_hi;
#define IN(k) (lo <= (k) && (k) < hi)
#define BOTH(k) (IN(k) && IN((k) + 1))

    if (IN(0)) { p0_prologue(F); if (BOTH(0)) xcd_barrier(bar); }

    if (IN(1)) {
        pg8::Gemm g{(const bf16*)(F.ws + WS_HN), (const bf16*)(F.ws + WS_WIN), T, NPROJ, D, 0};
        pg8::StaticOrder S; S.init(T, NPROJ, F.G, (int)blockIdx.x);
        EpiInProj E{(bf16*)(F.ws + WS_DQ), (bf16*)(F.ws + WS_DK), (bf16*)(F.ws + WS_DV), (bf16*)(F.ws + WS_RQ), (bf16*)(F.ws + WS_RK), (bf16*)(F.ws + WS_RV), (bf16*)(F.ws + WS_RG),
                    (const float*)(F.ws + WS_ROPE_D)};
        if (F.tid < 128) { const int par_ = F.tid >> 6, i_ = F.tid & 63;
            ((LAS float*)(F.lds + pg8::EPI_TAB_OFF + par_ * pg8::EPI_TAB_BYTES))[i_] = (i_ < 32 ? inv_freq_d(i_) : inv_freq_r(i_ - 32)) * 0.15915494309189535f; }
        __syncthreads();
        pg8::gemm_phase<EpiInProj, pg8::StaticOrder, true, false>(F.lds, g, S, E);
        if (BOTH(1)) xcd_barrier(bar);
    }

    if (IN(2)) { p2_ret_state(F); if (BOTH(2)) xcd_barrier(bar); }
    if (IN(4)) { p4_ret_out(F); p4_attention<0>(F); if (BOTH(4)) xcd_barrier(bar); }

    if (IN(5)) {
        pg8::Gemm g{(const bf16*)(F.ws + WS_MIX), (const bf16*)(F.ws + WS_WOUT), T, D, D / 2, 0};
        pg8::StaticOrder S; S.init(T, D, F.G, (int)blockIdx.x);
        EpiOutProj E{(const bf16*)(F.ws + WS_HN), (bf16*)(F.ws + WS_H1)};
        pg8::gemm_phase<EpiOutProj, pg8::StaticOrder, true, false, true>(F.lds, g, S, E);
        if (BOTH(5)) xcd_barrier(bar);
    }
    if (IN(6)) { p6_router(F); if (BOTH(6)) xcd_barrier(bar); }

    if (IN(8)) {
        moe_tile_table(F);
        pg8::Gemm g{(const bf16*)(F.ws + WS_XN2), (const bf16*)(F.ws + WS_WUP), NROWS_MAX, 2048, D / 2, (size_t)2048 * D};
        MoeOrder S{(const LAS int*)(F.lds + TILE_E_OFF), (const int*)(F.ws + WS_ROWTOK_S), 8, F.G, F.vcu, D};
        EpiUp E{F.b_up, (unsigned char*)(F.ws + WS_HB), (const float*)(F.ws + WS_ROWRSTD_S)};
        pg8::gemm_phase<EpiUp, MoeOrder, true, true, true>(F.lds, g, S, E);
        if (BOTH(8)) xcd_barrier(bar);
    }
    if (IN(9)) {
        if (!IN(8)) moe_tile_table(F);
        pg8::Gemm g{(const bf16*)(F.ws + WS_HB), (const bf16*)(F.ws + WS_WDN), NROWS_MAX, D, D / 2, (size_t)D * D};
        MoeOrder S{(const LAS int*)(F.lds + TILE_E_OFF), (const int*)(F.ws + WS_ROWTOK_S), 4, F.G, F.vcu, D};
        EpiDown E{(const int*)(F.ws + WS_ROWTOK_S), (const float*)(F.ws + WS_ROWGATE_S), F.b_down, F.ws};
        pg8::gemm_phase<EpiDown, MoeOrder, true, false, true>(F.lds, g, S, E);
        if (BOTH(9)) xcd_barrier(bar);
    }
    if (IN(10)) { p10_final(F); }
#undef IN
#undef BOTH
}
static int g_grid = 0;
static void mk_launch(Args a, int lo, int hi, int li, hipStream_t stream) {
    a.ph_lo = lo; a.ph_hi = hi; a.li = li; a.pad = 0;
    hipLaunchKernelGGL(mk_fwd, dim3(g_grid), dim3(NWAVES * 64), LDS_BYTES, stream, a);
}
extern "C" void kernel_launch(void* const* d_in, const int* in_sizes, int n_in, void* d_out, int out_size, void* d_ws, size_t ws_size, hipStream_t stream) {
    float* out = (float*)d_out; unsigned char* ws = (unsigned char*)d_ws;
    if (g_grid == 0) {
        if (ws_size < WS_END) { fprintf(stderr, "kernel_launch: workspace too small (%zu < %zu)\n", ws_size, (size_t)WS_END); g_grid = -1; return; }
        int dev = 0, cus = 0;
        if (hipGetDevice(&dev) != hipSuccess || hipDeviceGetAttribute(&cus, hipDeviceAttributeMultiprocessorCount, dev) != hipSuccess) { g_grid = -1; return; }
        if (hipFuncSetAttribute((const void*)mk_fwd, hipFuncAttributeMaxDynamicSharedMemorySize, LDS_BYTES) != hipSuccess) { fprintf(stderr, "kernel_launch: hipFuncSetAttribute failed\n"); g_grid = -1; return; }
        int per_cu = 0;
        if (hipOccupancyMaxActiveBlocksPerMultiprocessor(&per_cu, (const void*)mk_fwd, NWAVES * 64, LDS_BYTES) != hipSuccess || per_cu < 1) fprintf(stderr, "kernel_launch: occupancy query says %d\n", per_cu);
        (void)hipGetLastError();
        g_grid = cus;
    }
    if (g_grid < 0) return;
    (void)hipMemsetAsync(ws + WS_CTL, 0, 1 * MiB, stream);
    Args a{};
    for (int i = 0; i < 15; ++i) a.in[i] = (const float*)d_in[i];
    a.out = out; a.ws = ws;
    mk_launch(a, 0, 11, 0, stream);
}
```
